# Optimizing an MI355X kernel written in HIP

```python
import math
import jax, jax.numpy as jnp
from jax import lax
import numpy as np

D_MODEL = 4096
BATCH = 4
SEQ = 4096
DEPTH = 1

HEAD_DIM = 128
N_HEADS = D_MODEL // HEAD_DIM
HEADS_A = N_HEADS // 2
HEADS_B = N_HEADS - HEADS_A
KV_GROUPS_B = 4
REP_B = HEADS_B // KV_GROUPS_B
WIDTH_A = HEADS_A * HEAD_DIM
WIDTH_B = HEADS_B * HEAD_DIM
KV_WIDTH_B = KV_GROUPS_B * HEAD_DIM
DILATED_CONFIGS = ((128, 1), (512, 4), (2048, 16))
BLK = 128
CMP_LEN = 32
CMP_STRIDE = 16
SLC_BLOCK = 64
N_SELECT = 16
WIN = 512
FORCE_SCORE = 1e6
ROPE_THETA = 500000.0
ROPE_DIM = HEAD_DIM // 4
D_FF = -(-8 * D_MODEL // (3 * 256)) * 256
EPS = 1e-5
IN_SIZES = (WIDTH_A, WIDTH_A, WIDTH_A,
            WIDTH_B,
            KV_WIDTH_B, KV_WIDTH_B,
            KV_WIDTH_B, KV_WIDTH_B,
            KV_WIDTH_B, KV_WIDTH_B,
            3 * HEADS_B)
D_IN = sum(IN_SIZES)
IN_SPLIT_POINTS = tuple(int(v) for v in np.cumsum(IN_SIZES)[:-1])

kernel_name = "hybrid_dilated_nsa_block"


def rmsnorm(x, g):
    xf = x.astype(jnp.float32)
    y = xf * lax.rsqrt(jnp.mean(xf * xf, axis=-1, keepdims=True) + EPS)
    return (y * g.astype(jnp.float32)).astype(x.dtype)


def rope_tables(s):
    inv = ROPE_THETA ** (-jnp.arange(0, ROPE_DIM, 2, dtype=jnp.float32) / ROPE_DIM)
    ang = jnp.arange(s, dtype=jnp.float32)[:, None] * inv[None, :]
    return jnp.cos(ang), jnp.sin(ang)


def apply_rope(x, cos, sin):
    half = ROPE_DIM // 2
    x1 = x[..., :half].astype(jnp.float32)
    x2 = x[..., half:ROPE_DIM].astype(jnp.float32)
    r = jnp.concatenate([x1 * cos - x2 * sin, x1 * sin + x2 * cos], axis=-1).astype(x.dtype)
    return jnp.concatenate([r, x[..., ROPE_DIM:]], axis=-1)


def heads(t, n):
    b, s, _ = t.shape
    return t.reshape(b, s, n, HEAD_DIM).transpose(0, 2, 1, 3)


def banded_attention(q, k, v, max_dist):
    b, g, r, l, dh = q.shape
    nb = l // BLK
    n_prev = -(-max_dist // BLK)
    nk = (n_prev + 1) * BLK
    starts = jnp.arange(nb) * BLK
    kidx = starts[:, None] + jnp.arange(nk)[None, :] - n_prev * BLK
    kcl = jnp.clip(kidx, 0, l - 1)
    kb = jnp.take(k, kcl, axis=2)
    vb = jnp.take(v, kcl, axis=2)
    qpos = starts[:, None] + jnp.arange(BLK)[None, :]
    dist = qpos[:, :, None] - kidx[:, None, :]
    mask = (kidx[:, None, :] >= 0) & (dist >= 0) & (dist <= max_dist)
    qb = q.reshape(b, g, r, nb, BLK, dh)
    s = jnp.einsum('bgrnqd,bgnkd->bgrnqk', qb, kb).astype(jnp.float32) * (HEAD_DIM ** -0.5)
    s = jnp.where(mask, s, -jnp.inf)
    lse = jax.nn.logsumexp(s, axis=-1)
    p = jnp.exp(s - lse[..., None])
    o = jnp.einsum('bgrnqk,bgnkd->bgrnqd', p.astype(v.dtype), vb)
    return o.reshape(b, g, r, l, dh), lse.reshape(b, g, r, l)


def dilated_attention(q, k, v):
    b, h, s, dh = q.shape
    outs, lses = [], []
    for window, dil in DILATED_CONFIGS:
        span = dil * BLK
        sp = -(-s // span) * span
        n_sub = sp // dil

        def strided(t):
            t = jnp.pad(t, ((0, 0), (0, 0), (0, sp - s), (0, 0)))
            return t.reshape(b, h, n_sub, dil, dh).transpose(0, 1, 3, 2, 4).reshape(b, h * dil, n_sub, dh)

        o, lse = banded_attention(strided(q)[:, :, None], strided(k), strided(v), window // dil)
        o = o[:, :, 0].reshape(b, h, dil, n_sub, dh).transpose(0, 1, 3, 2, 4).reshape(b, h, sp, dh)[:, :, :s]
        lse = lse[:, :, 0].reshape(b, h, dil, n_sub).transpose(0, 1, 3, 2).reshape(b, h, sp)[:, :, :s]
        outs.append(o)
        lses.append(lse)
    w = jax.nn.softmax(jnp.stack(lses), axis=0)
    return jnp.einsum('cbhs,cbhsd->bhsd', w.astype(q.dtype), jnp.stack(outs))


def compress(t, pe, w1, w2):
    s = t.shape[2]
    n_c = (s - CMP_LEN) // CMP_STRIDE + 1
    idx = jnp.arange(n_c)[:, None] * CMP_STRIDE + jnp.arange(CMP_LEN)[None, :]
    blocks = jnp.take(t, idx, axis=2) + pe.astype(t.dtype)
    flat = blocks.reshape(blocks.shape[:3] + (CMP_LEN * HEAD_DIM,))
    return jax.nn.gelu(flat @ w1) @ w2


def nsa_attention(q, k_cmp, v_cmp, k_slc, v_slc, k_win, v_win, gates,
                  ck_pe, ck_w1, ck_w2, cv_pe, cv_w1, cv_w2):
    b, g, r, s, dh = q.shape
    scale = HEAD_DIM ** -0.5
    pos = jnp.arange(s)

    kc = compress(k_cmp, ck_pe, ck_w1, ck_w2)
    vc = compress(v_cmp, cv_pe, cv_w1, cv_w2)
    n_c = kc.shape[2]
    c_start = jnp.arange(n_c) * CMP_STRIDE
    c_mask = (c_start + CMP_LEN - 1)[None, :] <= pos[:, None]
    sc = jnp.einsum('bgrsd,bgcd->bgrsc', q, kc).astype(jnp.float32) * scale
    sc = jnp.where(c_mask, sc, -jnp.inf)
    m = jnp.max(sc, axis=-1, keepdims=True)
    m = jnp.where(jnp.isfinite(m), m, 0.0)
    e = jnp.exp(sc - m)
    p_cmp = e / jnp.maximum(jnp.sum(e, axis=-1, keepdims=True), 1e-30)
    o_cmp = jnp.einsum('bgrsc,bgcd->bgrsd', p_cmp.astype(vc.dtype), vc)

    n_s = s // SLC_BLOCK
    s_start = jnp.arange(n_s) * SLC_BLOCK
    span_hits = ((c_start[:, None] < s_start[None, :] + SLC_BLOCK) &
                 (c_start[:, None] + CMP_LEN > s_start[None, :])).astype(jnp.float32)
    imp = jnp.einsum('bgrsc,cj->bgsj', p_cmp, span_hits)
    j = jnp.arange(n_s)[None, :]
    qblk = (pos // SLC_BLOCK)[:, None]
    valid = j * SLC_BLOCK <= pos[:, None]
    forced = (j == 0) | (j == qblk) | (j == qblk - 1)
    score = jnp.where(forced, FORCE_SCORE, jnp.where(valid, imp, -jnp.inf))
    n_top = min(N_SELECT, n_s)
    top_val, top_idx = lax.top_k(score, n_top)
    top_ok = jnp.isfinite(top_val)

    nb = s // BLK
    gather_bg = jax.vmap(jax.vmap(lambda table, idx: table[idx]))
    q_blocks = jnp.moveaxis(q.reshape(b, g, r, nb, BLK, dh), 3, 0)
    idx_blocks = jnp.moveaxis(top_idx.reshape(b, g, nb, BLK, n_top), 2, 0)
    ok_blocks = jnp.moveaxis(top_ok.reshape(b, g, nb, BLK, n_top), 2, 0)
    starts = jnp.arange(nb) * BLK

    def slc_block(args):
        qb, ib, okb, start = args
        tok = (ib[..., None] * SLC_BLOCK + jnp.arange(SLC_BLOCK)).reshape(b, g, BLK, n_top * SLC_BLOCK)
        tok_ok = jnp.broadcast_to(okb[..., None], ib.shape + (SLC_BLOCK,)).reshape(b, g, BLK, n_top * SLC_BLOCK)
        qpos = start + jnp.arange(BLK)
        mask = tok_ok & (tok <= qpos[:, None])
        kg = gather_bg(k_slc, tok)
        vg = gather_bg(v_slc, tok)
        ss = jnp.einsum('bgrqd,bgqtd->bgrqt', qb, kg).astype(jnp.float32) * scale
        ss = jnp.where(mask[:, :, None], ss, -jnp.inf)
        p = jax.nn.softmax(ss, axis=-1)
        return jnp.einsum('bgrqt,bgqtd->bgrqd', p.astype(vg.dtype), vg)

    o_slc = lax.map(slc_block, (q_blocks, idx_blocks, ok_blocks, starts))
    o_slc = jnp.moveaxis(o_slc, 0, 3).reshape(b, g, r, s, dh)

    o_win, _ = banded_attention(q, k_win, v_win, WIN - 1)

    return gates[..., 0:1] * o_cmp + gates[..., 1:2] * o_slc + gates[..., 2:3] * o_win


def setup_inputs(seed: int = 0) -> dict:
    key = jax.random.key(seed)
    ks = jax.random.split(key, 17)
    f32 = jnp.float32
    nrm = lambda k, shape, scale: jax.random.normal(k, shape, f32) * scale
    gain = lambda k, shape: 1.0 + 0.02 * jax.random.normal(k, shape, f32)
    return {
        "x": jax.random.normal(ks[0], (BATCH, SEQ, D_MODEL), f32),
        "norm_attn": gain(ks[1], (DEPTH, D_MODEL)),
        "w_in": nrm(ks[2], (DEPTH, D_MODEL, D_IN), D_MODEL ** -0.5),
        "ck_pe": nrm(ks[3], (DEPTH, CMP_LEN, HEAD_DIM), 0.1),
        "ck_w1": nrm(ks[4], (DEPTH, CMP_LEN * HEAD_DIM, HEAD_DIM), (CMP_LEN * HEAD_DIM) ** -0.5),
        "ck_w2": nrm(ks[5], (DEPTH, HEAD_DIM, HEAD_DIM), HEAD_DIM ** -0.5),
        "cv_pe": nrm(ks[6], (DEPTH, CMP_LEN, HEAD_DIM), 0.1),
        "cv_w1": nrm(ks[7], (DEPTH, CMP_LEN * HEAD_DIM, HEAD_DIM), (CMP_LEN * HEAD_DIM) ** -0.5),
        "cv_w2": nrm(ks[8], (DEPTH, HEAD_DIM, HEAD_DIM), HEAD_DIM ** -0.5),
        "out_norm_a": gain(ks[9], (DEPTH, WIDTH_A)),
        "out_norm_b": gain(ks[10], (DEPTH, WIDTH_B)),
        "w_out": nrm(ks[11], (DEPTH, D_MODEL, D_MODEL), D_MODEL ** -0.5),
        "norm_ffn": gain(ks[12], (DEPTH, D_MODEL)),
        "w_gate": nrm(ks[13], (DEPTH, D_MODEL, D_FF), D_MODEL ** -0.5),
        "w_up": nrm(ks[14], (DEPTH, D_MODEL, D_FF), D_MODEL ** -0.5),
        "w_down": nrm(ks[15], (DEPTH, D_FF, D_MODEL), D_FF ** -0.5),
        "norm_final": gain(ks[16], (D_MODEL,)),
    }


def reference(x, norm_attn, w_in, ck_pe, ck_w1, ck_w2, cv_pe, cv_w1, cv_w2,
              out_norm_a, out_norm_b, w_out, norm_ffn, w_gate, w_up, w_down, norm_final):
    b, s, _ = x.shape
    cos, sin = rope_tables(s)
    for l in range(DEPTH):
        h = rmsnorm(x, norm_attn[l])
        proj = h @ w_in[l]
        (qa, ka, va, qb, kbc, vbc, kbs, vbs, kbw, vbw, gl) = jnp.split(proj, IN_SPLIT_POINTS, axis=-1)

        qa = apply_rope(heads(qa, HEADS_A), cos, sin)
        ka = apply_rope(heads(ka, HEADS_A), cos, sin)
        o_a = dilated_attention(qa, ka, heads(va, HEADS_A))

        q_b = apply_rope(heads(qb, HEADS_B), cos, sin).reshape(b, KV_GROUPS_B, REP_B, s, HEAD_DIM)
        k_c = apply_rope(heads(kbc, KV_GROUPS_B), cos, sin)
        k_s = apply_rope(heads(kbs, KV_GROUPS_B), cos, sin)
        k_w = apply_rope(heads(kbw, KV_GROUPS_B), cos, sin)
        gates = jax.nn.sigmoid(gl.reshape(b, s, KV_GROUPS_B, REP_B, 3).transpose(0, 2, 3, 1, 4))
        o_b = nsa_attention(q_b, k_c, heads(vbc, KV_GROUPS_B), k_s, heads(vbs, KV_GROUPS_B),
                            k_w, heads(vbw, KV_GROUPS_B), gates,
                            ck_pe[l], ck_w1[l], ck_w2[l], cv_pe[l], cv_w1[l], cv_w2[l])

        o_a = o_a.transpose(0, 2, 1, 3).reshape(b, s, WIDTH_A)
        o_b = o_b.reshape(b, HEADS_B, s, HEAD_DIM).transpose(0, 2, 1, 3).reshape(b, s, WIDTH_B)
        mixed = jnp.concatenate([rmsnorm(o_a, out_norm_a[l]), rmsnorm(o_b, out_norm_b[l])], axis=-1)
        x = x + mixed @ w_out[l]

        h = rmsnorm(x, norm_ffn[l])
        x = x + (jax.nn.silu(h @ w_gate[l]) * (h @ w_up[l])) @ w_down[l]
    return rmsnorm(x, norm_final)
```

```cpp
#include <hip/hip_runtime.h>
#include <cstdio>
#include <cstdint>
#include <math.h>

#ifndef MK_BUILD
#define MK_BUILD 3
#endif
namespace pg8 {
#define PG8_LAS __attribute__((address_space(3)))
typedef unsigned short bf16_t;
typedef short bf16x8 __attribute__((ext_vector_type(8)));
typedef float f32x4 __attribute__((ext_vector_type(4)));
typedef unsigned u32x4 __attribute__((ext_vector_type(4)));
constexpr int BM = 256, BK = 64, HALF = 128, HTB = HALF * BK * 2  , STAGE_BYTES = 8 * HTB, NXCD = 8, WGM = 8;

__host__ __device__ __forceinline__ int lds_byte(int r, int c) { const int st = (r >> 4) * 2 + (c >> 5), rr = r & 15, cc = c & 31, ob = rr * 64 + cc * 2; return st * 1024 + (ob ^ (((ob >> 9) & 1) << 5)); }
__host__ __device__ __forceinline__ void stage_rc(int b, int& R, int& C) { const int st = b / 1024, sb = b % 1024, swz = sb ^ (((sb >> 9) & 1) << 5); R = (st >> 1) * 16 + swz / 64; C = (st & 1) * 32 + (swz % 64) / 2; }
__host__ __device__ __forceinline__ int perm32(int rho) { const int n = rho >> 4, i = rho & 15; return 8 * (i >> 2) + 4 * n + (i & 3); }

struct Unit { int pm, pn; };
struct Gemm { const bf16_t* A; const bf16_t* Bt; int M, N, K; };

struct StaticOrder {
    int nM, nN, nwg, G, c;
    __host__ __device__ void init(int M, int N, int G_, int c_) { nM = M / BM; nN = N / BM; nwg = nM * nN; G = G_; c = c_; }
    __host__ __device__ bool next(int i, Unit& u) const {
        const long L = (long)i * G + c; if (L >= nwg) return false;
        int wgid = (int)L; { const int q = nwg / NXCD, r = nwg % NXCD, xcd = wgid % NXCD, off = wgid / NXCD; wgid = (xcd < r ? xcd * (q + 1) : r * (q + 1) + (xcd - r) * q) + off; }
        const int nig = WGM * nN, gid = wgid / nig, fm = gid * WGM, gsz = (nM - fm) < WGM ? (nM - fm) : WGM;
        u.pm = fm + ((wgid % nig) % gsz); u.pn = (wgid % nig) / gsz; return true;
    }
    __device__ __forceinline__ void a_ready(const Unit&) const {}
    __device__ __forceinline__ void done(const Unit&) const {}
};
__device__ __forceinline__ unsigned cvt_pk_bf16(float lo, float hi) { unsigned r; asm volatile("v_cvt_pk_bf16_f32 %0, %1, %2" : "=v"(r) : "v"(lo), "v"(hi)); return r; }
typedef unsigned u32x4 __attribute__((ext_vector_type(4)));
struct EpiProj {
    static constexpr bool PERM = true, AFTER_DRAIN = false;
    bf16_t* O; int ldc; const float* cs; const float* rowsq; float inv_k, eps;
    __device__ __forceinline__ void operator()(const f32x4 (&acc)[2][2][4][2], const Unit& u, int wr, int wc, int fr, int fq) const {
        const int row0 = u.pm * BM + wr * 64 + fr;
        const int col0 = u.pn * BM + wc * 32 + 8 * fq;
#pragma unroll
        for (int bj = 0; bj < 2; ++bj) {
            const int hd = u.pn * 2 + bj;
            const bool rope = (wc == 0) && (hd < 32 || (hd >= 48 && hd < 68) || (hd >= 72 && hd < 76) || (hd >= 80 && hd < 84));
#pragma unroll
            for (int ai = 0; ai < 2; ++ai)
#pragma unroll
                for (int m = 0; m < 4; ++m) {
                    const int row = row0 + ai * HALF + m * 16;
                    const float rs = 1.f / sqrtf(rowsq[row] * inv_k + eps);
                    f32x4 v0 = acc[ai][bj][m][0] * rs, v1 = acc[ai][bj][m][1] * rs;
                    if (rope) {
                        f32x4 w0, w1;
#pragma unroll
                        for (int e = 0; e < 4; ++e) { w0[e] = __shfl_xor(v0[e], 32); w1[e] = __shfl_xor(v1[e], 32); }
                        const float* c = cs + ((size_t)(row & 4095) * 16 + 8 * (fq & 1)) * 2;
                        const f32x4 c0 = *(const f32x4*)c, c1 = *(const f32x4*)(c + 4), c2 = *(const f32x4*)(c + 8), c3 = *(const f32x4*)(c + 12);
                        const float cosv[8] = {c0[0], c0[2], c1[0], c1[2], c2[0], c2[2], c3[0], c3[2]};
                        const float sinv[8] = {c0[1], c0[3], c1[1], c1[3], c2[1], c2[3], c3[1], c3[3]};
                        if (fq < 2) {
#pragma unroll
                            for (int e = 0; e < 4; ++e) { v0[e] = v0[e] * cosv[e] - w0[e] * sinv[e]; v1[e] = v1[e] * cosv[4 + e] - w1[e] * sinv[4 + e]; }
                        } else {
#pragma unroll
                            for (int e = 0; e < 4; ++e) { v0[e] = w0[e] * sinv[e] + v0[e] * cosv[e]; v1[e] = w1[e] * sinv[4 + e] + v1[e] * cosv[4 + e]; }
                        }
                    }
                    u32x4 w; w.x = cvt_pk_bf16(v0[0], v0[1]); w.y = cvt_pk_bf16(v0[2], v0[3]); w.z = cvt_pk_bf16(v1[0], v1[1]); w.w = cvt_pk_bf16(v1[2], v1[3]);
                    *(u32x4*)(O + (size_t)row * ldc + col0 + bj * HALF) = w;
                }
        }
    }
};
template <bool R_BF16> struct EpiResid {
    static constexpr bool PERM = true, AFTER_DRAIN = false;
    const void* R; int ldc; bf16_t* Ob; float* rowsq; float ascale;
    __device__ __forceinline__ void operator()(const f32x4 (&acc)[2][2][4][2], const Unit& u, int wr, int wc, int fr, int fq) const {
        const int row0 = u.pm * BM + wr * 64 + fr;
        const int col0 = u.pn * BM + wc * 32 + 8 * fq;
#pragma unroll
        for (int ai = 0; ai < 2; ++ai)
#pragma unroll
            for (int m = 0; m < 4; ++m) {
                const size_t ro = (size_t)(row0 + ai * HALF + m * 16) * ldc + col0;
                float ss = 0.f;
#pragma unroll
                for (int bj = 0; bj < 2; ++bj) {
                    f32x4 r0, r1;
                    if constexpr (R_BF16) { const u32x4 rb = *(const u32x4*)((const bf16_t*)R + ro + bj * HALF);
                        r0 = (f32x4){__builtin_bit_cast(float, rb.x << 16), __builtin_bit_cast(float, rb.x & 0xffff0000u), __builtin_bit_cast(float, rb.y << 16), __builtin_bit_cast(float, rb.y & 0xffff0000u)};
                        r1 = (f32x4){__builtin_bit_cast(float, rb.z << 16), __builtin_bit_cast(float, rb.z & 0xffff0000u), __builtin_bit_cast(float, rb.w << 16), __builtin_bit_cast(float, rb.w & 0xffff0000u)}; }
                    else { r0 = *(const f32x4*)((const float*)R + ro + bj * HALF); r1 = *(const f32x4*)((const float*)R + ro + bj * HALF + 4); }
                    const f32x4 o0 = r0 + acc[ai][bj][m][0] * ascale, o1 = r1 + acc[ai][bj][m][1] * ascale;
                    u32x4 w; w.x = cvt_pk_bf16(o0[0], o0[1]); w.y = cvt_pk_bf16(o0[2], o0[3]); w.z = cvt_pk_bf16(o1[0], o1[1]); w.w = cvt_pk_bf16(o1[2], o1[3]);
                    *(u32x4*)(Ob + ro + bj * HALF) = w;
                    ss += (o0[0] * o0[0] + o0[1] * o0[1]) + (o0[2] * o0[2] + o0[3] * o0[3]) + (o1[0] * o1[0] + o1[1] * o1[1]) + (o1[2] * o1[2] + o1[3] * o1[3]);
                }
                ss += __shfl_xor(ss, 16); ss += __shfl_xor(ss, 32); if (fq == 0) atomicAdd(rowsq + (row0 + ai * HALF + m * 16), ss);
            }
    }
};
typedef unsigned u32x2 __attribute__((ext_vector_type(2)));
template <bool FP8OUT> struct EpiSwiglu {
    static constexpr bool PERM = true, AFTER_DRAIN = false;
    bf16_t* O; int ldc; const float* rowsq; float inv_k, eps;
    __device__ __forceinline__ static float silu_mul(float g, float uu) { return g * __builtin_amdgcn_rcpf(1.f + __builtin_amdgcn_exp2f(-1.4426950408889634f * g)) * uu; }
    __device__ __forceinline__ void operator()(const f32x4 (&acc)[2][2][4][2], const Unit& u, int wr, int wc, int fr, int fq) const {
        const int row0 = u.pm * BM + wr * 64 + fr;
        const int col0 = u.pn * HALF + wc * 32 + 8 * fq;
#pragma unroll
        for (int ai = 0; ai < 2; ++ai)
#pragma unroll
            for (int m = 0; m < 4; ++m) {
                const float rs = 1.f / sqrtf(rowsq[row0 + ai * HALF + m * 16] * inv_k + eps);
                const f32x4 g0 = acc[ai][0][m][0] * rs, g1 = acc[ai][0][m][1] * rs, u0 = acc[ai][1][m][0] * rs, u1 = acc[ai][1][m][1] * rs;
                if constexpr (FP8OUT) {
                    int w0 = __builtin_amdgcn_cvt_pk_fp8_f32(silu_mul(g0[0], u0[0]), silu_mul(g0[1], u0[1]), 0, false); w0 = __builtin_amdgcn_cvt_pk_fp8_f32(silu_mul(g0[2], u0[2]), silu_mul(g0[3], u0[3]), w0, true);
                    int w1 = __builtin_amdgcn_cvt_pk_fp8_f32(silu_mul(g1[0], u1[0]), silu_mul(g1[1], u1[1]), 0, false); w1 = __builtin_amdgcn_cvt_pk_fp8_f32(silu_mul(g1[2], u1[2]), silu_mul(g1[3], u1[3]), w1, true);
                    *(u32x2*)((unsigned char*)O + (size_t)(row0 + ai * HALF + m * 16) * ldc + col0) = (u32x2){(unsigned)w0, (unsigned)w1};
                } else {
                u32x4 w;
                w.x = cvt_pk_bf16(silu_mul(g0[0], u0[0]), silu_mul(g0[1], u0[1])); w.y = cvt_pk_bf16(silu_mul(g0[2], u0[2]), silu_mul(g0[3], u0[3]));
                w.z = cvt_pk_bf16(silu_mul(g1[0], u1[0]), silu_mul(g1[1], u1[1])); w.w = cvt_pk_bf16(silu_mul(g1[2], u1[2]), silu_mul(g1[3], u1[3]));
                *(u32x4*)(O + (size_t)(row0 + ai * HALF + m * 16) * ldc + col0) = w; }
            }
    }
};
typedef int v8i_t __attribute__((ext_vector_type(8)));
typedef int v4i_t __attribute__((ext_vector_type(4)));
__device__ __forceinline__ v8i_t cat8(bf16x8 lo, bf16x8 hi) { const v4i_t a = __builtin_bit_cast(v4i_t, lo), b = __builtin_bit_cast(v4i_t, hi); return __builtin_shufflevector(a, b, 0, 1, 2, 3, 4, 5, 6, 7); }
template <class Epi, class Sched, bool ALIGN_EPI = false, bool SP2 = false, bool FP8 = false>
__device__ __forceinline__ void gemm_phase(PG8_LAS unsigned char* lds, const Gemm g, const Sched& S, const Epi& E) {
    const int tid = threadIdx.x, wid = __builtin_amdgcn_readfirstlane(tid >> 6), lane = tid & 63, wr = wid >> 2, wc = wid & 3, fr = lane & 15, fq = lane >> 4;
    const int K = g.K, nt = K / BK;
    unsigned voffA[2], voffB[2];
#pragma unroll
    for (int i = 0; i < 2; ++i) { int R, C; stage_rc(tid * 16 + i * 8192, R, C); const int Rb = Epi::PERM ? ((R & ~31) + perm32(R & 31)) : R;
        voffA[i] = (unsigned)(R * K + C) * 2u; voffB[i] = (unsigned)(Rb * K + C) * 2u; }
    const size_t kstep = (size_t)(BK * 2);
    const size_t hstep = (size_t)HALF * K * 2;
    const size_t tstep = 2 * hstep;
    const unsigned ldsw = (unsigned)wid * 1024u;
    const int aoff = lds_byte(wr * 64 + fr, fq * 8), boff = lds_byte(wc * 32 + fr, fq * 8);
#define PG8_SA(b, h) (((b) * 2 + (h)) * HTB)
#define PG8_SB(b, h) ((4 + (b) * 2 + (h)) * HTB)
#define PG8_STAGE(bufoff, gbase, voff) do { _Pragma("unroll") for (int _i = 0; _i < 2; ++_i) \
        __builtin_amdgcn_global_load_lds((const unsigned*)((const char*)(gbase) + (voff)[_i]), (PG8_LAS unsigned*)(lds + (bufoff) + ldsw + _i * 8192), 16, 0, 0); } while (0)
#define PG8_LDA(dst, b, h) do { if constexpr (FP8) { _Pragma("unroll") for (int m = 0; m < 4; ++m) dst##8[m] = cat8(*(const PG8_LAS bf16x8*)(lds + PG8_SA(b, h) + aoff + m * 2048), *(const PG8_LAS bf16x8*)(lds + PG8_SA(b, h) + aoff + m * 2048 + 1024)); } else { \
        _Pragma("unroll") for (int m = 0; m < 4; ++m) _Pragma("unroll") for (int k = 0; k < 2; ++k) dst[m][k] = *(const PG8_LAS bf16x8*)(lds + PG8_SA(b, h) + aoff + m * 2048 + k * 1024); } } while (0)
#define PG8_LDB(dst, b, h) do { if constexpr (FP8) { _Pragma("unroll") for (int n = 0; n < 2; ++n) dst##8[n] = cat8(*(const PG8_LAS bf16x8*)(lds + PG8_SB(b, h) + boff + n * 2048), *(const PG8_LAS bf16x8*)(lds + PG8_SB(b, h) + boff + n * 2048 + 1024)); } else { \
        _Pragma("unroll") for (int n = 0; n < 2; ++n) _Pragma("unroll") for (int k = 0; k < 2; ++k) dst[n][k] = *(const PG8_LAS bf16x8*)(lds + PG8_SB(b, h) + boff + n * 2048 + k * 1024); } } while (0)
#define PG8_MMA(ai, bj, At, Bt) do { __builtin_amdgcn_s_setprio(1); if constexpr (FP8) { _Pragma("unroll") for (int m = 0; m < 4; ++m) _Pragma("unroll") for (int n = 0; n < 2; ++n) \
        asm volatile("v_mfma_scale_f32_16x16x128_f8f6f4 %0, %1, %2, %0, %3, %3 op_sel_hi:[0,0,0]" : "+v"(acc[ai][bj][m][n]) : "v"(Bt##8[n]), "v"(At##8[m]), "v"(fp8_unit_scale)); } else { \
        _Pragma("unroll") for (int m = 0; m < 4; ++m) _Pragma("unroll") for (int n = 0; n < 2; ++n) _Pragma("unroll") for (int k = 0; k < 2; ++k) \
        acc[ai][bj][m][n] = __builtin_amdgcn_mfma_f32_16x16x32_bf16(Bt[n][k], At[m][k], acc[ai][bj][m][n], 0, 0, 0); } __builtin_amdgcn_s_setprio(0); } while (0)
#define PG8_WAIT_V(n) asm volatile("s_waitcnt vmcnt(" #n ")" ::: "memory")
#define PG8_WAIT_L(n) asm volatile("s_waitcnt lgkmcnt(" #n ")" ::: "memory")
#define PG8_BAR __builtin_amdgcn_s_barrier()
#define PG8_SCHED __builtin_amdgcn_sched_barrier(0)
    Unit cur, nxt; int ui = 0;
    if (!S.next(0, cur)) return;
    f32x4 acc[2][2][4][2];
#pragma unroll
    for (int a = 0; a < 2; ++a)
#pragma unroll
        for (int b = 0; b < 2; ++b)
#pragma unroll
            for (int m = 0; m < 4; ++m)
#pragma unroll
                for (int n = 0; n < 2; ++n) acc[a][b][m][n] = (f32x4){0.f, 0.f, 0.f, 0.f};
    const int fp8_unit_scale = 0x7F7F7F7F;
    bf16x8 At[4][2], B0[2][2], B1[2][2]; v8i_t At8[4], B08[2], B18[2];
    const char* cA = (const char*)g.A + (size_t)cur.pm * tstep; const char* cB = (const char*)g.Bt + (size_t)cur.pn * tstep;
    S.a_ready(cur);
    if constexpr (SP2) {
        PG8_STAGE(PG8_SB(0, 0), cB, voffB); PG8_STAGE(PG8_SB(0, 1), cB + hstep, voffB); PG8_STAGE(PG8_SA(0, 0), cA, voffA); PG8_STAGE(PG8_SA(0, 1), cA + hstep, voffA);
        if (wr == 1) PG8_BAR;
        PG8_WAIT_V(2); PG8_BAR;
        PG8_STAGE(PG8_SB(1, 0), cB + kstep, voffB); PG8_STAGE(PG8_SA(1, 0), cA + kstep, voffA); PG8_STAGE(PG8_SB(1, 1), cB + hstep + kstep, voffB);
        PG8_WAIT_V(6); PG8_BAR;
    } else {
        PG8_STAGE(PG8_SB(0, 0), cB, voffB); PG8_STAGE(PG8_SA(0, 0), cA, voffA); PG8_STAGE(PG8_SB(0, 1), cB + hstep, voffB); PG8_STAGE(PG8_SA(0, 1), cA + hstep, voffA);
        if (wr == 1) PG8_BAR;
        PG8_WAIT_V(4); PG8_BAR;
        PG8_STAGE(PG8_SB(1, 0), cB + kstep, voffB); PG8_STAGE(PG8_SA(1, 0), cA + kstep, voffA); PG8_STAGE(PG8_SB(1, 1), cB + hstep + kstep, voffB);
        PG8_WAIT_V(6); PG8_BAR;
    }
    for (;;) {
        const bool has_next = S.next(ui + 1, nxt);
        const char* nA = has_next ? (const char*)g.A + (size_t)nxt.pm * tstep : cA; const char* nB = has_next ? (const char*)g.Bt + (size_t)nxt.pn * tstep : cB;
        for (int t = 0; t < nt; t += 2) {
            const bool last = (t == nt - 2);
            const char* a1 = cA + (size_t)(t + 1) * kstep;
            const char* a2 = last ? nA : cA + (size_t)(t + 2) * kstep; const char* b2 = last ? nB : cB + (size_t)(t + 2) * kstep;
            const char* a3 = a2 + kstep; const char* b3 = b2 + kstep;
            if (last && has_next) S.a_ready(nxt);
            if constexpr (SP2) {
            PG8_LDB(B0, 0, 0); PG8_LDB(B1, 0, 1); PG8_SCHED; PG8_LDA(At, 0, 0); PG8_STAGE(PG8_SA(1, 1), a1 + hstep, voffA);
            PG8_WAIT_V(8); PG8_WAIT_L(0); PG8_BAR; PG8_MMA(0, 0, At, B0); PG8_MMA(0, 1, At, B1); PG8_BAR; PG8_SCHED;
            PG8_LDA(At, 0, 1); PG8_STAGE(PG8_SB(0, 0), b2, voffB); PG8_STAGE(PG8_SB(0, 1), b2 + hstep, voffB); PG8_STAGE(PG8_SA(0, 0), a2, voffA);
            PG8_WAIT_V(8); PG8_WAIT_L(0); PG8_BAR; PG8_MMA(1, 0, At, B0); PG8_MMA(1, 1, At, B1); PG8_BAR; PG8_SCHED;
            PG8_LDB(B0, 1, 0); PG8_LDB(B1, 1, 1); PG8_SCHED; PG8_LDA(At, 1, 0); PG8_STAGE(PG8_SA(0, 1), a2 + hstep, voffA);
            PG8_WAIT_V(8); PG8_WAIT_L(0); PG8_BAR; PG8_MMA(0, 0, At, B0); PG8_MMA(0, 1, At, B1); PG8_BAR; PG8_SCHED;
            PG8_LDA(At, 1, 1); PG8_STAGE(PG8_SB(1, 0), b3, voffB); PG8_STAGE(PG8_SB(1, 1), b3 + hstep, voffB); PG8_STAGE(PG8_SA(1, 0), a3, voffA);
            PG8_WAIT_V(8); PG8_WAIT_L(0); PG8_BAR; PG8_MMA(1, 0, At, B0); PG8_MMA(1, 1, At, B1); PG8_BAR; PG8_SCHED;
            } else {
            PG8_LDB(B0, 0, 0); PG8_SCHED; PG8_LDA(At, 0, 0); PG8_STAGE(PG8_SA(1, 1), a1 + hstep, voffA);
            PG8_WAIT_L(8); PG8_BAR; PG8_WAIT_L(0); PG8_MMA(0, 0, At, B0); PG8_BAR; PG8_SCHED;
            PG8_LDB(B1, 0, 1); PG8_STAGE(PG8_SB(0, 0), b2, voffB);
            PG8_BAR; PG8_WAIT_L(0); PG8_MMA(0, 1, At, B1); PG8_BAR;
            PG8_LDA(At, 0, 1); PG8_STAGE(PG8_SA(0, 0), a2, voffA);
            PG8_BAR; PG8_WAIT_L(0); PG8_MMA(1, 0, At, B0); PG8_BAR; PG8_SCHED;
            PG8_STAGE(PG8_SB(0, 1), b2 + hstep, voffB);
            PG8_WAIT_V(6); PG8_BAR; PG8_MMA(1, 1, At, B1); PG8_BAR;
            PG8_LDB(B0, 1, 0); PG8_SCHED; PG8_LDA(At, 1, 0); PG8_STAGE(PG8_SA(0, 1), a2 + hstep, voffA);
            PG8_WAIT_L(8); PG8_BAR; PG8_WAIT_L(0); PG8_MMA(0, 0, At, B0); PG8_BAR; PG8_SCHED;
            PG8_LDB(B1, 1, 1); PG8_STAGE(PG8_SB(1, 0), b3, voffB);
            PG8_BAR; PG8_WAIT_L(0); PG8_MMA(0, 1, At, B1); PG8_BAR;
            PG8_LDA(At, 1, 1); PG8_STAGE(PG8_SA(1, 0), a3, voffA);
            PG8_BAR; PG8_WAIT_L(0); PG8_MMA(1, 0, At, B0); PG8_BAR; PG8_SCHED;
            PG8_STAGE(PG8_SB(1, 1), b3 + hstep, voffB);
            PG8_WAIT_V(6); PG8_BAR; PG8_MMA(1, 1, At, B1); PG8_BAR;
            }
        }
        if constexpr (ALIGN_EPI) { if (wr == 0) PG8_BAR; }
        if constexpr (FP8) asm volatile("s_nop 15\n\ts_nop 15\n\ts_nop 15" ::: "memory");
        if constexpr (!Epi::AFTER_DRAIN) { E(acc, cur, wr, wc, fr, fq); S.done(cur); }
        if (!has_next) break;
#pragma unroll
        for (int a = 0; a < 2; ++a)
#pragma unroll
            for (int b = 0; b < 2; ++b)
#pragma unroll
                for (int m = 0; m < 4; ++m)
#pragma unroll
                    for (int n = 0; n < 2; ++n) acc[a][b][m][n] = (f32x4){0.f, 0.f, 0.f, 0.f};
        if constexpr (FP8) asm volatile("s_nop 7" ::: "memory");
        cur = nxt; cA = nA; cB = nB; ++ui;
        if constexpr (ALIGN_EPI) { if (wr == 1) PG8_BAR; }
    }
    PG8_WAIT_V(0);
    if constexpr (!ALIGN_EPI) { if (wr == 0) PG8_BAR; }
    PG8_BAR;
    if constexpr (Epi::AFTER_DRAIN) { E.fused(acc, cur, wr, wc, fr, fq, lds, wid, lane); S.done(cur); }
#undef PG8_SA
#undef PG8_SB
#undef PG8_STAGE
#undef PG8_LDA
#undef PG8_LDB
#undef PG8_MMA
#undef PG8_WAIT_V
#undef PG8_WAIT_L
#undef PG8_BAR
#undef PG8_SCHED
}
}
constexpr int D_MODEL = 4096, BATCH = 4, SEQ = 4096, T = BATCH * SEQ;
constexpr int HA = 16, HB = 16, GB = 4, RB = 4;
constexpr int D_IN = 11312, LDP = 11520, D_FF = 11008, NGU = 2 * D_FF;
constexpr int OFF_QA = 0, OFF_KA = 2048, OFF_VA = 4096, OFF_QB = 6144, OFF_KC = 8192, OFF_VC = 8704,
              OFF_KS = 9216, OFF_VS = 9728, OFF_KW = 10240, OFF_VW = 10752, OFF_GL = 11264;
constexpr int NC = 255, NS = 64, CMP_LEN = 32, CMP_STRIDE = 16, NSEL = 16, WIN = 512;
constexpr float EPS = 1e-5f;
constexpr float QSCALE = 0.08838834764831845f;
constexpr int NWAVES = 8;
#ifndef PG8_FP8_SCALE
#define PG8_FP8_SCALE 0x7F7F7F7F
#endif
#ifndef PG_ALIGN
#define PG_ALIGN true
#endif
#ifndef P8_SP2
#define P8_SP2 true
#endif
constexpr float WDN_SCALE = 64.f;

constexpr size_t MiB = 1u << 20;
constexpr size_t WS_CTL = 0, CTL_ZERO_BYTES = 1 * MiB;
constexpr size_t WS_WIN = 1 * MiB;
constexpr size_t WS_WOUT = 91 * MiB;
constexpr size_t WS_WGU = 123 * MiB;
constexpr size_t WS_WDN = 295 * MiB;
constexpr size_t WS_BUFA = 381 * MiB;
constexpr size_t WS_PROJ = 509 * MiB;
constexpr size_t WS_SMALL = 869 * MiB;
constexpr size_t WS_CS = WS_SMALL;
constexpr size_t WS_KCF = WS_SMALL + 1 * MiB;
constexpr size_t WS_KCB = WS_SMALL + 5 * MiB;
constexpr size_t WS_W1T = WS_SMALL + 7 * MiB;
constexpr size_t WS_BIAS1 = WS_SMALL + 9 * MiB;
constexpr size_t WS_LSE = WS_SMALL + 10 * MiB;
constexpr size_t WS_GATES = WS_SMALL + 13 * MiB;
constexpr size_t WS_ROWSQ = WS_SMALL + 16 * MiB;
constexpr size_t WS_PART = 888 * MiB;
constexpr size_t WS_END = 1016 * MiB;
static_assert(WS_WIN + (size_t)LDP * 4096 * 2 <= WS_WOUT && WS_WOUT + (size_t)4096 * 4096 * 2 <= WS_WGU && WS_WGU + (size_t)NGU * 4096 * 2 <= WS_WDN &&
              WS_WDN + (size_t)4096 * D_FF * 2 <= WS_BUFA && WS_BUFA + (size_t)T * 4096 * 2 <= WS_PROJ && WS_PROJ + (size_t)T * LDP * 2 <= WS_SMALL, "d_ws map");
constexpr int CW_TMO = 0, CW_CODE = 1;
constexpr int CW_BAR = 4096;

constexpr int RING_OFF = 0, RING_BYTES = 131072;
constexpr int LDSCTL_OFF = RING_BYTES, MISC_OFF = LDSCTL_OFF + 320;
constexpr int LDS_BYTES = 155648;

#define GAS __attribute__((address_space(1)))
#define LAS __attribute__((address_space(3)))
typedef unsigned short bf16;
typedef unsigned v4u __attribute__((ext_vector_type(4)));
typedef unsigned v2u __attribute__((ext_vector_type(2)));
typedef float f32x4 __attribute__((ext_vector_type(4)));
typedef short bf16x8 __attribute__((ext_vector_type(8)));
typedef GAS unsigned gu32;
#define RLX_AGENT __ATOMIC_RELAXED, __HIP_MEMORY_SCOPE_AGENT
#define LDS_WAIT() asm volatile("s_waitcnt lgkmcnt(0)" ::: "memory")
#define VM_WAIT() asm volatile("s_waitcnt vmcnt(0)" ::: "memory")
__device__ __forceinline__ unsigned f2bf(float f) { unsigned u = __builtin_bit_cast(unsigned, f); return (u + 0x7fffu + ((u >> 16) & 1u)) >> 16; }
__device__ __forceinline__ unsigned pk2(float lo, float hi) { return f2bf(lo) | (f2bf(hi) << 16); }
__device__ __forceinline__ float bf2f(bf16 v) { return __builtin_bit_cast(float, (unsigned)v << 16); }
#define XB_TMO      128
#define XB_XCNT(j)  (256  + 64 * (j))
#define XB_XSUB(j)  (1280 + 64 * (j))
#define XB_XGEN(j)  (2304 + 64 * (j))
#define XB_TOP      3328
#define XB_TOPGEN   3392
#define XCD_BAR_WORDS 3456
#define XB_SPIN_CAP (1u << 18)

__device__ __forceinline__ unsigned xb_ld(unsigned* p)              { return __hip_atomic_load(p, __ATOMIC_RELAXED, __HIP_MEMORY_SCOPE_AGENT); }
__device__ __forceinline__ unsigned xb_add(unsigned* p, unsigned v) { return __hip_atomic_fetch_add(p, v, __ATOMIC_RELAXED, __HIP_MEMORY_SCOPE_AGENT); }
__device__ __forceinline__ unsigned xb_xcc_id() { return (unsigned)__builtin_amdgcn_s_getreg((3 << 11) | 20) & 0xFu; }
#define XB_SPIN(cond, bar) do { unsigned _sp = 0; while (cond) { __builtin_amdgcn_s_sleep(1); \
    if ((++_sp & 255u) == 0u) { if (xb_ld(&(bar)[XB_TMO])) break; if (_sp > XB_SPIN_CAP) { atomicAdd(&(bar)[XB_TMO], 1u); break; } } } } while (0)

struct XcdBarrier {
    unsigned* bar; unsigned x;
    volatile LAS unsigned* st;
};

__device__ __forceinline__ XcdBarrier xcd_barrier_post(unsigned* bar, volatile LAS unsigned* st) {
    XcdBarrier b; b.bar = bar; b.x = xb_xcc_id(); b.st = st;
    if (threadIdx.x == 0) (void)xb_add(&bar[XB_XCNT(b.x)], 1u);
    return b;
}
__device__ __forceinline__ void xcd_barrier_complete(unsigned* bar, unsigned x, unsigned& nloc, unsigned& nx) {
    const unsigned G = gridDim.x * gridDim.y * gridDim.z;
    unsigned sum, cnt, mine, sp = 0u;
    for (;;) {
        sum = 0u; cnt = 0u; mine = 0u;
#pragma unroll
        for (unsigned j = 0; j < 16; ++j) { const unsigned c = xb_ld(&bar[XB_XCNT(j)]); sum += c; cnt += (c > 0u) ? 1u : 0u; mine = (j == x) ? c : mine; }
        if (sum == G) break;
        __builtin_amdgcn_s_sleep(1);
        if ((++sp & 255u) == 0u) { if (xb_ld(&bar[XB_TMO])) break; if (sp > XB_SPIN_CAP) { atomicAdd(&bar[XB_TMO], 1u); break; } }
    }
    nloc = mine > 0u ? mine : 1u; nx = cnt > 0u ? cnt : 1u;
}

__device__ __forceinline__ void xcd_barrier(const XcdBarrier& b) {
    asm volatile("s_waitcnt vmcnt(0)" ::: "memory");
    __syncthreads();
    if (threadIdx.x == 0) {
        unsigned* bar = b.bar;
        __builtin_amdgcn_s_waitcnt(0);
        unsigned nloc = b.st[0], nx = b.st[1];
        if (nloc == 0u) { xcd_barrier_complete(bar, b.x, nloc, nx); b.st[0] = nloc; b.st[1] = nx; }
        const unsigned old = xb_add(&bar[XB_XSUB(b.x)], 1u);
        const unsigned gen = old / nloc;
        if (old + 1u == (gen + 1u) * nloc) {
            __builtin_amdgcn_fence(__ATOMIC_RELEASE, "agent");
            asm volatile("s_waitcnt vmcnt(0)" ::: "memory");
            const unsigned og = xb_add(&bar[XB_TOP], 1u);
            const unsigned tg = og / nx;
            if (og + 1u == (tg + 1u) * nx) xb_add(&bar[XB_TOPGEN], 1u);
            else XB_SPIN(xb_ld(&bar[XB_TOPGEN]) == tg, bar);
            __builtin_amdgcn_fence(__ATOMIC_ACQUIRE, "agent");
            xb_add(&bar[XB_XGEN(b.x)], 1u);
            asm volatile("s_waitcnt vmcnt(0)" ::: "memory");
        } else {
            XB_SPIN(xb_ld(&bar[XB_XGEN(b.x)]) == gen, bar);
            __builtin_amdgcn_fence(__ATOMIC_ACQUIRE, "agent");
            asm volatile("s_waitcnt vmcnt(0)" ::: "memory");
        }
    }
    __syncthreads();
}
namespace att {
typedef float f32x16 __attribute__((ext_vector_type(16)));
typedef short s16x4 __attribute__((ext_vector_type(4)));
constexpr int SHM_T = 16384;
constexpr int A_V = 0, A_K = 4 * SHM_T;
constexpr int A_KC = 0, A_VC = 4 * SHM_T;
constexpr int A_WS = 131072 + 1024;
constexpr int A_IMP = A_WS + 2048;
constexpr int A_SEL = A_IMP + 16384;
constexpr int A_END = A_SEL + 512;
constexpr float C2 = QSCALE * 1.4426950408889634f;
constexpr float THR_RAW = 8.f / QSCALE;
#define KSWZ(row, colB) ((row) * 256 + ((colB) ^ (((row) & 7) << 4)))
__device__ __forceinline__ int crow(int r, int hi) { return (r & 3) + 8 * (r >> 2) + 4 * hi; }
__device__ __forceinline__ unsigned cvtpk(float lo, float hi) { unsigned r; asm volatile("v_cvt_pk_bf16_f32 %0, %1, %2" : "=v"(r) : "v"(lo), "v"(hi)); return r; }
__device__ __forceinline__ int v_st(int k, int c) { const int kk = (k & ~0xC) | ((k & 4) << 1) | ((k & 8) >> 1); return ((kk >> 3) * 4 + (c >> 5)) * 512 + ((kk & 7) * 32 + (c & 31)) * 2; }
__device__ __forceinline__ int v_rd_base(int lane) { return ((lane & 3) << 3) | (((lane >> 2) & 3) << 6) | (((lane >> 4) & 1) << 5) | (((lane >> 5) & 1) << 8); }
constexpr int v_rd_off(int d0, int ks, int half) { return d0 * 512 + ks * 4096 + half * 2048; }
template <int OFF> __device__ __forceinline__ s16x4 tr_read(int vb) {
    s16x4 r; asm volatile("ds_read_b64_tr_b16 %0, %1 offset:%2" : "=&v"(r) : "v"(vb), "i"(OFF) : "memory"); return r;
}
struct VFrag { s16x4 l0, h0, l1, h1, l2, h2, l3, h3; };
template <int D0> __device__ __forceinline__ void v_reads(VFrag& f, int vb) {
    f.l0 = tr_read<v_rd_off(D0, 0, 0)>(vb); f.h0 = tr_read<v_rd_off(D0, 0, 1)>(vb); f.l1 = tr_read<v_rd_off(D0, 1, 0)>(vb); f.h1 = tr_read<v_rd_off(D0, 1, 1)>(vb);
    f.l2 = tr_read<v_rd_off(D0, 2, 0)>(vb); f.h2 = tr_read<v_rd_off(D0, 2, 1)>(vb); f.l3 = tr_read<v_rd_off(D0, 3, 0)>(vb); f.h3 = tr_read<v_rd_off(D0, 3, 1)>(vb);
}
#define ATT_PK(Lx, Hx) (bf16x8){Lx[0], Lx[1], Lx[2], Lx[3], Hx[0], Hx[1], Hx[2], Hx[3]}
__device__ __forceinline__ void pv_mma(f32x16& od, const VFrag& f, bf16x8 pa0, bf16x8 pa1, bf16x8 pa2, bf16x8 pa3) {
    od = __builtin_amdgcn_mfma_f32_32x32x16_bf16(pa0, ATT_PK(f.l0, f.h0), od, 0, 0, 0);
    od = __builtin_amdgcn_mfma_f32_32x32x16_bf16(pa1, ATT_PK(f.l1, f.h1), od, 0, 0, 0);
    od = __builtin_amdgcn_mfma_f32_32x32x16_bf16(pa2, ATT_PK(f.l2, f.h2), od, 0, 0, 0);
    od = __builtin_amdgcn_mfma_f32_32x32x16_bf16(pa3, ATT_PK(f.l3, f.h3), od, 0, 0, 0);
}
__device__ __forceinline__ void pv_d0(f32x16 (&o)[4], int vb, bf16x8 pa0, bf16x8 pa1, bf16x8 pa2, bf16x8 pa3) {
    VFrag fa, fb;
    v_reads<0>(fa, vb); v_reads<1>(fb, vb);
    asm volatile("s_waitcnt lgkmcnt(8)" ::: "memory"); __builtin_amdgcn_sched_barrier(0);
    pv_mma(o[0], fa, pa0, pa1, pa2, pa3); __builtin_amdgcn_sched_barrier(0);
    v_reads<2>(fa, vb);
    asm volatile("s_waitcnt lgkmcnt(8)" ::: "memory"); __builtin_amdgcn_sched_barrier(0);
    pv_mma(o[1], fb, pa0, pa1, pa2, pa3); __builtin_amdgcn_sched_barrier(0);
    v_reads<3>(fb, vb);
    asm volatile("s_waitcnt lgkmcnt(8)" ::: "memory"); __builtin_amdgcn_sched_barrier(0);
    pv_mma(o[2], fa, pa0, pa1, pa2, pa3); __builtin_amdgcn_sched_barrier(0);
    asm volatile("s_waitcnt lgkmcnt(0)" ::: "memory"); __builtin_amdgcn_sched_barrier(0);
    pv_mma(o[3], fb, pa0, pa1, pa2, pa3);
}
#undef ATT_PK
#define ATT_KRD(B, d0) do { const int cb_ = ((d0) * 16 + hi * 8) * 2; B##0 = *(const LAS bf16x8*)(Ks + KSWZ(r32, cb_)); B##1 = *(const LAS bf16x8*)(Ks + KSWZ(32 + r32, cb_)); } while (0)
#define ATT_KMM(B, d0) do { p0 = __builtin_amdgcn_mfma_f32_32x32x16_bf16(B##0, qr[d0], p0, 0, 0, 0); p1 = __builtin_amdgcn_mfma_f32_32x32x16_bf16(B##1, qr[d0], p1, 0, 0, 0); } while (0)
__device__ __forceinline__ void qkt(f32x16& p0, f32x16& p1, const LAS unsigned char* Ks, const bf16x8 (&qr)[8], int r32, int hi) {
    bf16x8 a0, a1, b0, b1, c0, c1, e0, e1;
    ATT_KRD(a, 0); ATT_KRD(b, 1); ATT_KRD(c, 2); ATT_KRD(e, 3);
#pragma unroll
    for (int r = 0; r < 16; ++r) { p0[r] = 0.f; p1[r] = 0.f; }
    __builtin_amdgcn_sched_barrier(0);
    ATT_KMM(a, 0); ATT_KMM(b, 1); __builtin_amdgcn_sched_barrier(0);
    ATT_KRD(a, 4); ATT_KRD(b, 5); __builtin_amdgcn_sched_barrier(0);
    ATT_KMM(c, 2); ATT_KMM(e, 3); __builtin_amdgcn_sched_barrier(0);
    ATT_KRD(c, 6); ATT_KRD(e, 7); __builtin_amdgcn_sched_barrier(0);
    ATT_KMM(a, 4); ATT_KMM(b, 5); __builtin_amdgcn_sched_barrier(0);
    ATT_KMM(c, 6); ATT_KMM(e, 7);
}
#undef ATT_KRD
#undef ATT_KMM
__device__ __forceinline__ float xhalf_max(float v) { auto rr = __builtin_amdgcn_permlane32_swap(__float_as_uint(v), __float_as_uint(v), false, false); return fmaxf(__uint_as_float(rr[0]), __uint_as_float(rr[1])); }
__device__ __forceinline__ float xhalf_sum(float v) { auto rr = __builtin_amdgcn_permlane32_swap(__float_as_uint(v), __float_as_uint(v), false, false); return __uint_as_float(rr[0]) + __uint_as_float(rr[1]); }
__device__ __forceinline__ bf16x8 pks(unsigned a0, unsigned a1, unsigned b0, unsigned b1) {
    auto r0 = __builtin_amdgcn_permlane32_swap(a0, b0, false, false); auto r1 = __builtin_amdgcn_permlane32_swap(a1, b1, false, false);
    v4u w = {r0[0], r1[0], r0[1], r1[1]}; return __builtin_bit_cast(bf16x8, w);
}
__device__ __forceinline__ void softmax_tile(f32x16& p0, f32x16& p1, float& m_reg, float& l_reg, float& alpha, bf16x8& pa0, bf16x8& pa1, bf16x8& pa2, bf16x8& pa3) {
    float pmax = fmaxf(p0[0], p1[0]);
#pragma unroll
    for (int r = 1; r < 16; ++r) pmax = fmaxf(fmaxf(pmax, p0[r]), p1[r]);
    pmax = xhalf_max(pmax);
    float mn;
    if (__all(pmax - m_reg <= THR_RAW)) { mn = m_reg; alpha = 1.f; }
    else { mn = fmaxf(m_reg, pmax); alpha = __builtin_amdgcn_exp2f((m_reg - mn) * C2); m_reg = mn; }
    const float mnC = -mn * C2;
    float ps = 0.f;
#pragma unroll
    for (int r = 0; r < 16; ++r) { p0[r] = __builtin_amdgcn_exp2f(fmaf(p0[r], C2, mnC)); p1[r] = __builtin_amdgcn_exp2f(fmaf(p1[r], C2, mnC)); ps += p0[r] + p1[r]; }
    ps = xhalf_sum(ps);
    l_reg = l_reg * alpha + ps;
    pa0 = pks(cvtpk(p0[0], p0[1]), cvtpk(p0[2], p0[3]), cvtpk(p0[4], p0[5]), cvtpk(p0[6], p0[7]));
    pa1 = pks(cvtpk(p0[8], p0[9]), cvtpk(p0[10], p0[11]), cvtpk(p0[12], p0[13]), cvtpk(p0[14], p0[15]));
    pa2 = pks(cvtpk(p1[0], p1[1]), cvtpk(p1[2], p1[3]), cvtpk(p1[4], p1[5]), cvtpk(p1[6], p1[7]));
    pa3 = pks(cvtpk(p1[8], p1[9]), cvtpk(p1[10], p1[11]), cvtpk(p1[12], p1[13]), cvtpk(p1[14], p1[15]));
}
template <bool ALWAYS> struct MaskBandT { int qi, W, amin, amax;
    __device__ __forceinline__ bool interior(int t) const { return !ALWAYS && (t * 64 + 63 <= amin) && (t * 64 >= amax - W); }
    __device__ __forceinline__ void operator()(f32x16& p0, f32x16& p1, int t, int hi) const {
        const int kb = t * 64 + 4 * hi;
#pragma unroll
        for (int r = 0; r < 16; ++r) { const int k = kb + (r & 3) + 8 * (r >> 2);
            p0[r] = ((unsigned)(qi - k) <= (unsigned)W) ? p0[r] : -INFINITY; p1[r] = ((unsigned)(qi - k - 32) <= (unsigned)W) ? p1[r] : -INFINITY; }
    } };
struct NeedBand { int a, W;
    __device__ __forceinline__ bool operator()(int t) const { return (t * 64 + 63 >= a - W) && (t * 64 <= a + 31); } };
struct NeedAll { __device__ __forceinline__ bool operator()(int) const { return true; } };
struct MaskSel { unsigned mlo, mhi; int s, qb;
    __device__ __forceinline__ bool interior(int t) const { const bool bit = ((t < 32 ? (mlo >> t) : (mhi >> (t - 32))) & 1u) != 0u; return (t < qb) && (__all(bit) != 0); }
    __device__ __forceinline__ void operator()(f32x16& p0, f32x16& p1, int t, int hi) const {
        const bool bit = ((t < 32 ? (mlo >> t) : (mhi >> (t - 32))) & 1u) != 0u;
        const int kb = t * 64 + 4 * hi;
#pragma unroll
        for (int r = 0; r < 16; ++r) { const int k = kb + (r & 3) + 8 * (r >> 2);
            p0[r] = (bit && k <= s) ? p0[r] : -INFINITY; p1[r] = (bit && k + 32 <= s) ? p1[r] : -INFINITY; }
    } };
struct NeedSel { unsigned mlo, mhi;
    __device__ __forceinline__ bool operator()(int t) const { const bool bit = ((t < 32 ? (mlo >> t) : (mhi >> (t - 32))) & 1u) != 0u; return __any(bit) != 0; } };

template <class Mask, class Need>
__device__ __forceinline__ void attn_stream(LAS unsigned char* L, const bf16* Kg, const bf16* Vg, size_t stride, int t_lo, int t_hi, const bf16x8 (&qr)[8],
                                            const Mask& mask, const Need& need, f32x16 (&o)[4], float& m_reg, float& l_reg, int tid, int lane, int wave) {
    asm volatile("" : "+v"(tid), "+v"(lane));
    const int r32 = lane & 31, hi = lane >> 5;
    const bool late = wave >= 4;
    LAS float* al_l = (LAS float*)(L + A_WS + wave * 256) + 32;
    const int vb0 = (int)(unsigned)(uintptr_t)(L + A_V) + v_rd_base(lane);
    const int krow = 4 * wave + (lane >> 4), kch = (lane & 15) ^ (krow & 7);
    const int vsub = 2 * wave + hi, vkk = 8 * (vsub >> 2) + (r32 >> 2), vk = (vkk & ~0xC) | ((vkk & 4) << 1) | ((vkk & 8) >> 1);
    const bf16* kp = Kg + ((size_t)t_lo * 64 + krow) * stride + kch * 8;
    const bf16* vp = Vg + ((size_t)t_lo * 64 + vk) * stride + (vsub & 3) * 32 + (lane & 3) * 8;
    const size_t s32 = 32 * stride, s64 = 64 * stride;
#define ATT_DMA(kslot, vslot) do { \
        __builtin_amdgcn_global_load_lds((const unsigned*)kp, (LAS unsigned*)(L + A_K + (kslot) * SHM_T + wave * 1024), 16, 0, 0); \
        __builtin_amdgcn_global_load_lds((const unsigned*)(kp + s32), (LAS unsigned*)(L + A_K + (kslot) * SHM_T + 8192 + wave * 1024), 16, 0, 0); \
        __builtin_amdgcn_global_load_lds((const unsigned*)vp, (LAS unsigned*)(L + A_V + (vslot) * SHM_T + wave * 1024), 16, 0, 0); \
        __builtin_amdgcn_global_load_lds((const unsigned*)(vp + s32), (LAS unsigned*)(L + A_V + (vslot) * SHM_T + 8192 + wave * 1024), 16, 0, 0); \
        kp += s64; vp += s64; } while (0)
#define ATT_RESC() do { if (__any(alpha < 1.f)) { if (hi == 0) al_l[r32] = alpha; asm volatile("s_waitcnt lgkmcnt(0)" ::: "memory"); \
        _Pragma("unroll") for (int d = 0; d < 4; ++d) _Pragma("unroll") for (int r = 0; r < 16; ++r) o[d][r] *= al_l[crow(r, hi)]; } } while (0)
    ATT_DMA(0, 0);
    if (t_lo + 1 < t_hi) ATT_DMA(1, 1);
    int ks = 0, vs = 0, vsp = 0; bool pend = false;
    bf16x8 pa0, pa1, pa2, pa3;
    for (int t = t_lo; t < t_hi; ++t) {
        if (t + 1 < t_hi) asm volatile("s_waitcnt vmcnt(4)" ::: "memory"); else asm volatile("s_waitcnt vmcnt(0)" ::: "memory");
        __builtin_amdgcn_s_barrier();
        asm volatile("" ::: "memory");
        if (t + 2 < t_hi) { const int k2 = ks >= 1 ? ks - 1 : 2, v2 = vs >= 2 ? vs - 2 : vs + 2; ATT_DMA(k2, v2); }
        if (pend) { pv_d0(o, vb0 + vsp * SHM_T, pa0, pa1, pa2, pa3); pend = false; }
        if (need(t)) {
            f32x16 p0, p1; qkt(p0, p1, L + A_K + ks * SHM_T, qr, r32, hi);
            if (!mask.interior(t)) mask(p0, p1, t, hi);
            float alpha;
            softmax_tile(p0, p1, m_reg, l_reg, alpha, pa0, pa1, pa2, pa3);
            ATT_RESC();
            if (late) { pend = true; vsp = vs; }
            else pv_d0(o, vb0 + vs * SHM_T, pa0, pa1, pa2, pa3);
        }
        ks = ks == 2 ? 0 : ks + 1; vs = (vs + 1) & 3;
    }
    if (pend) pv_d0(o, vb0 + vsp * SHM_T, pa0, pa1, pa2, pa3);
#undef ATT_DMA
#undef ATT_RESC
    asm volatile("s_waitcnt lgkmcnt(0)" ::: "memory");
    __builtin_amdgcn_s_barrier();
}
__device__ __forceinline__ int st_img(int wave) { return wave < 4 ? 2 * SHM_T + wave * 8192 : A_K + 2 * SHM_T + (wave - 4) * 8192; }
template <class RowPtr>
__device__ __forceinline__ void store_tile(LAS unsigned char* L, const f32x16 (&o)[4], const LAS float* sc_l, const RowPtr& rowptr, int lane, int wave) {
    const int r32 = lane & 31, hi = lane >> 5, odd = lane & 1;
    LAS unsigned char* img = L + st_img(wave);
#pragma unroll
    for (int rp = 0; rp < 8; ++rp) {
        const int r = 2 * rp;
        const float s0 = sc_l[crow(r, hi)], s1 = sc_l[crow(r + 1, hi)];
        const int row = crow(r + odd, hi);
#pragma unroll
        for (int d0 = 0; d0 < 4; ++d0) {
            const float a = o[d0][r] * s0, b = o[d0][r + 1] * s1;
            const float send = odd ? a : b;
            const float recv = __shfl_xor(send, 1);
            const unsigned w = cvtpk(odd ? recv : a, odd ? b : recv);
            *(LAS unsigned*)(img + row * 256 + (((32 * d0 + (r32 & ~1)) * 2) ^ ((row & 7) << 4))) = w;
        }
    }
    asm volatile("s_waitcnt lgkmcnt(0)" ::: "memory");
#pragma unroll
    for (int i = 0; i < 8; ++i) {
        const int row = 4 * i + (lane >> 4), ch = lane & 15;
        const v4u v = *(const LAS v4u*)(img + row * 256 + ((ch * 16) ^ ((row & 7) << 4)));
        *(v4u*)(rowptr(row) + ch * 8) = v;
    }
}
template <class RowPtr>
__device__ __forceinline__ void store_tile_direct(const f32x16 (&o)[4], const LAS float* sc_l, const RowPtr& rowptr, int lane) {
    const int r32 = lane & 31, hi = lane >> 5, odd = lane & 1;
#pragma unroll
    for (int rp = 0; rp < 8; ++rp) {
        const int r = 2 * rp;
        const float s0 = sc_l[crow(r, hi)], s1 = sc_l[crow(r + 1, hi)];
        bf16* prow = rowptr(crow(r + odd, hi)) + (r32 & ~1);
#pragma unroll
        for (int d0 = 0; d0 < 4; ++d0) {
            const float a = o[d0][r] * s0, b = o[d0][r + 1] * s1;
            const float send = odd ? a : b;
            const float recv = __shfl_xor(send, 1);
            *(unsigned*)(prow + 32 * d0) = cvtpk(odd ? recv : a, odd ? b : recv);
        }
    }
}
__device__ __forceinline__ float sigmoidf_(float v) { return 1.f / (1.f + __expf(-v)); }

__device__ __forceinline__ void dilated_unit(LAS unsigned char* L, const bf16* proj, bf16* outA, float* lse, int u, int tid, int lane, int wave) {
    const int r32 = lane & 31, hi = lane >> 5;
    const int cfg = u >> 10, r = u & 1023, sh = 2 * cfg, dil = 1 << sh;
    const int b = r >> 8, h = (r >> 4) & 15, rb = r & 15, res = rb & (dil - 1), blk = rb >> sh;
    const int i0 = blk * 256, a = i0 + 32 * wave, qi = a + r32;
    const bf16* base = proj + (size_t)(b * SEQ + res) * LDP + h * 128;
    const size_t stride = (size_t)dil * LDP;
    const bf16* qrow = base + OFF_QA + (size_t)qi * stride + hi * 8;
    bf16x8 qr[8];
#pragma unroll
    for (int d0 = 0; d0 < 8; ++d0) qr[d0] = *(const bf16x8*)(qrow + d0 * 16);
    f32x16 o[4];
#pragma unroll
    for (int d = 0; d < 4; ++d)
#pragma unroll
        for (int e = 0; e < 16; ++e) o[d][e] = 0.f;
    float m_reg = -1e30f, l_reg = 0.f;
    const int t_lo = (i0 >= 128) ? (i0 - 128) >> 6 : 0, t_hi = (i0 >> 6) + 4;
    attn_stream(L, base + OFF_KA, base + OFF_VA, stride, t_lo, t_hi, qr, MaskBandT<true>{qi, 128, a, a + 31}, NeedBand{a, 128}, o, m_reg, l_reg, tid, lane, wave);
    LAS float* sc_l = (LAS float*)(L + A_WS + wave * 256);
    const int tok = qi * dil + res;
    if (hi == 0) { sc_l[r32] = 1.f / l_reg; lse[((size_t)cfg * T + (size_t)b * SEQ + tok) * 16 + h] = m_reg * QSCALE + __logf(l_reg); }
    asm volatile("s_waitcnt lgkmcnt(0)" ::: "memory");
    bf16* obase = outA + (size_t)cfg * T * 2048 + (size_t)(b * SEQ + res) * 2048 + h * 128;
    const size_t ostride = (size_t)dil * 2048;
    store_tile(L, o, sc_l, [&](int row) { return obase + (size_t)(a + row) * ostride; }, lane, wave);
}
__device__ __forceinline__ void window_unit(LAS unsigned char* L, const bf16* proj, bf16* outB, int u, int tid, int lane, int wave) {
    const int r32 = lane & 31, hi = lane >> 5;
    const int b = u >> 8, g = (u >> 6) & 3, qb = u & 63, q0 = qb * 64;
    const int head = r32 >> 3, s = q0 + 8 * wave + (r32 & 7);
    const bf16* prow = proj + (size_t)(b * SEQ + s) * LDP;
    const bf16* qrow = prow + OFF_QB + (g * 4 + head) * 128 + hi * 8;
    bf16x8 qr[8];
#pragma unroll
    for (int d0 = 0; d0 < 8; ++d0) qr[d0] = *(const bf16x8*)(qrow + d0 * 16);
    f32x16 o[4];
#pragma unroll
    for (int d = 0; d < 4; ++d)
#pragma unroll
        for (int e = 0; e < 16; ++e) o[d][e] = 0.f;
    float m_reg = -1e30f, l_reg = 0.f;
    const bf16* kvb = proj + (size_t)(b * SEQ) * LDP + g * 128;
    attn_stream(L, kvb + OFF_KW, kvb + OFF_VW, (size_t)LDP, qb >= 8 ? qb - 8 : 0, qb + 1, qr, MaskBandT<false>{s, WIN - 1, q0 + 8 * wave, q0 + 8 * wave + 7}, NeedAll{}, o, m_reg, l_reg, tid, lane, wave);
    LAS float* sc_l = (LAS float*)(L + A_WS + wave * 256);
    if (hi == 0) sc_l[r32] = 1.f / l_reg;
    asm volatile("s_waitcnt lgkmcnt(0)" ::: "memory");
    bf16* obase = outB + (size_t)(b * SEQ + q0 + 8 * wave) * 2048 + g * 512;
    store_tile(L, o, sc_l, [&](int row) { return obase + (size_t)(row & 7) * 2048 + (row >> 3) * 128; }, lane, wave);
}
__device__ __forceinline__ bf16x8 hfrag(int c0, int j) {
    bf16x8 f; const int d = c0 - 4 * j;
#pragma unroll
    for (int jj = 0; jj < 8; ++jj) f[jj] = ((unsigned)(d + jj + 1) <= 4u) ? (short)0x3F80 : (short)0;
    return f;
}
__device__ __forceinline__ void nsa_unit(LAS unsigned char* L, const bf16* proj, const bf16* kc, const bf16* vc, bf16* outC, bf16* outS, int b, int g, int qb, int tid, int lane, int wave) {
    const int r32 = lane & 31, hi = lane >> 5;
    const int q0 = qb * 64, head = r32 >> 3, s = q0 + 8 * wave + (r32 & 7);
    const bf16* prow = proj + (size_t)(b * SEQ + s) * LDP;
    const bf16* qrow = prow + OFF_QB + (g * 4 + head) * 128 + hi * 8;
    bf16x8 qr[8];
#pragma unroll
    for (int d0 = 0; d0 < 8; ++d0) qr[d0] = *(const bf16x8*)(qrow + d0 * 16);
    {
        int tid_ = tid; asm volatile("" : "+v"(tid_));
        const int sr = tid_ >> 4, sc = (tid_ & 15) * 8;
        const bf16* kcb = kc + (size_t)(b * GB + g) * 256 * 128 + (size_t)sr * 128 + sc; const bf16* vcb = vc + (size_t)(b * GB + g) * 256 * 128 + (size_t)sr * 128 + sc;
#pragma unroll
        for (int tc = 0; tc < 4; ++tc) {
            const bf16x8 k0 = *(const bf16x8*)(kcb + tc * 8192), k1 = *(const bf16x8*)(kcb + tc * 8192 + 4096), v0 = *(const bf16x8*)(vcb + tc * 8192), v1 = *(const bf16x8*)(vcb + tc * 8192 + 4096);
            *(LAS bf16x8*)(L + A_KC + tc * SHM_T + KSWZ(sr, sc * 2)) = k0; *(LAS bf16x8*)(L + A_KC + tc * SHM_T + KSWZ(32 + sr, sc * 2)) = k1;
            *(LAS bf16x8*)(L + A_VC + tc * SHM_T + v_st(sr, sc)) = v0; *(LAS bf16x8*)(L + A_VC + tc * SHM_T + v_st(32 + sr, sc)) = v1;
        }
    }
    __syncthreads();
    LAS float* impw = (LAS float*)(L + A_IMP) + wave * 512;
    LAS float* sc_l = (LAS float*)(L + A_WS + wave * 256);
    f32x16 o[4];
    float m = -1e30f, l = 0.f;
#pragma unroll 1
    for (int tc = 0; tc < 4; ++tc) {
        f32x16 p0, p1; qkt(p0, p1, L + A_KC + tc * SHM_T, qr, r32, hi);
        const int kb = tc * 64 + 4 * hi; float pmax = -INFINITY;
#pragma unroll
        for (int r = 0; r < 16; ++r) { const int c = kb + (r & 3) + 8 * (r >> 2);
            p0[r] = (16 * c + 31 <= s) ? p0[r] : -INFINITY; p1[r] = (16 * (c + 32) + 31 <= s) ? p1[r] : -INFINITY; pmax = fmaxf(pmax, fmaxf(p0[r], p1[r])); }
        pmax = xhalf_max(pmax);
        const float mn = fmaxf(m, pmax), alpha = __builtin_amdgcn_exp2f((m - mn) * C2), mnC = -mn * C2; m = mn;
        float ps = 0.f;
#pragma unroll
        for (int r = 0; r < 16; ++r) ps += __builtin_amdgcn_exp2f(fmaf(p0[r], C2, mnC)) + __builtin_amdgcn_exp2f(fmaf(p1[r], C2, mnC));
        l = l * alpha + xhalf_sum(ps);
    }
    const float inv_l = l > 0.f ? 1.f / l : 0.f, mC = -m * C2;
#ifndef T_NOPASS2
    {
        f32x16 imp0, imp1;
#pragma unroll
        for (int e = 0; e < 16; ++e) { imp0[e] = 0.f; imp1[e] = 0.f; }
#pragma unroll 1
        for (int tc = 0; tc < 4; ++tc) {
            f32x16 p0, p1; qkt(p0, p1, L + A_KC + tc * SHM_T, qr, r32, hi);
            const int kb = tc * 64 + 4 * hi;
#pragma unroll
            for (int r = 0; r < 16; ++r) { const int c = kb + (r & 3) + 8 * (r >> 2);
                p0[r] = (16 * c + 31 <= s) ? __builtin_amdgcn_exp2f(fmaf(p0[r], C2, mC)) * inv_l : 0.f;
                p1[r] = (16 * (c + 32) + 31 <= s) ? __builtin_amdgcn_exp2f(fmaf(p1[r], C2, mC)) * inv_l : 0.f; }
#pragma unroll
            for (int ks = 0; ks < 4; ++ks) {
                unsigned hh[4], ll[4];
#pragma unroll
                for (int i = 0; i < 4; ++i) { const int r = 8 * (ks & 1) + 2 * i; const float a = (ks < 2) ? p0[r] : p1[r], bq = (ks < 2) ? p0[r + 1] : p1[r + 1];
                    hh[i] = cvtpk(a, bq); ll[i] = cvtpk(a - __uint_as_float(hh[i] << 16), bq - __uint_as_float(hh[i] & 0xffff0000u)); }
                const bf16x8 pah = pks(hh[0], hh[1], hh[2], hh[3]), pal = pks(ll[0], ll[1], ll[2], ll[3]);
                int jv = r32; asm volatile("" : "+v"(jv));
                const int c0 = tc * 64 + ks * 16 + 8 * hi;
                if (tc <= 1) { const bf16x8 hf = hfrag(c0, jv); imp0 = __builtin_amdgcn_mfma_f32_32x32x16_bf16(pah, hf, imp0, 0, 0, 0); imp0 = __builtin_amdgcn_mfma_f32_32x32x16_bf16(pal, hf, imp0, 0, 0, 0); }
                if (tc >= 1) { const bf16x8 hf = hfrag(c0, 32 + jv); imp1 = __builtin_amdgcn_mfma_f32_32x32x16_bf16(pah, hf, imp1, 0, 0, 0); imp1 = __builtin_amdgcn_mfma_f32_32x32x16_bf16(pal, hf, imp1, 0, 0, 0); }
            }
        }
        LAS float* impw0 = (LAS float*)(L + A_IMP) + wave * 512;
#pragma unroll
        for (int e = 0; e < 4; ++e) {
            impw0[(e + 4 * hi) * 64 + r32] = (imp0[e] + imp0[4 + e]) + (imp0[8 + e] + imp0[12 + e]);
            impw0[(e + 4 * hi) * 64 + 32 + r32] = (imp1[e] + imp1[4 + e]) + (imp1[8 + e] + imp1[12 + e]);
        }
    }
#endif
#pragma unroll
    for (int e = 0; e < 16; ++e) { o[0][e] = 0.f; o[1][e] = 0.f; o[2][e] = 0.f; o[3][e] = 0.f; }
    const int vbc = (int)(unsigned)(uintptr_t)(L + A_VC) + v_rd_base(lane);
#pragma unroll 1
    for (int tc = 0; tc < 4; ++tc) {
        f32x16 p0, p1; qkt(p0, p1, L + A_KC + tc * SHM_T, qr, r32, hi);
        const int kb = tc * 64 + 4 * hi;
#pragma unroll
        for (int r = 0; r < 16; ++r) { const int c = kb + (r & 3) + 8 * (r >> 2);
            p0[r] = (16 * c + 31 <= s) ? __builtin_amdgcn_exp2f(fmaf(p0[r], C2, mC)) * inv_l : 0.f;
            p1[r] = (16 * (c + 32) + 31 <= s) ? __builtin_amdgcn_exp2f(fmaf(p1[r], C2, mC)) * inv_l : 0.f; }
        const bf16x8 pa0 = pks(cvtpk(p0[0], p0[1]), cvtpk(p0[2], p0[3]), cvtpk(p0[4], p0[5]), cvtpk(p0[6], p0[7]));
        const bf16x8 pa1 = pks(cvtpk(p0[8], p0[9]), cvtpk(p0[10], p0[11]), cvtpk(p0[12], p0[13]), cvtpk(p0[14], p0[15]));
        const bf16x8 pa2 = pks(cvtpk(p1[0], p1[1]), cvtpk(p1[2], p1[3]), cvtpk(p1[4], p1[5]), cvtpk(p1[6], p1[7]));
        const bf16x8 pa3 = pks(cvtpk(p1[8], p1[9]), cvtpk(p1[10], p1[11]), cvtpk(p1[12], p1[13]), cvtpk(p1[14], p1[15]));
        pv_d0(o, vbc + tc * SHM_T, pa0, pa1, pa2, pa3);
    }
    if (hi == 0) sc_l[r32] = 1.f;
    asm volatile("s_waitcnt lgkmcnt(0)" ::: "memory");
    {
        bf16* obase = outC + (size_t)(b * SEQ + q0 + 8 * wave) * 2048 + g * 512;
        store_tile_direct(o, sc_l, [&](int row) { return obase + (size_t)(row & 7) * 2048 + (row >> 3) * 128; }, lane);
    }
    LAS unsigned* selw = (LAS unsigned*)(L + A_SEL) + wave * 16;
    for (int qi = 0; qi < 8; ++qi) {
        const int sq = q0 + 8 * wave + qi, j = lane;
        const float iv = impw[qi * 64 + lane];
        const bool forced = (j == 0) || (j == qb) || (j == qb - 1);
        const bool valid = (j * 64 <= sq);
        const float score = forced ? 1e6f : (valid ? iv : -INFINITY);
        int rank = 0;
#pragma unroll 8
        for (int jj = 0; jj < 64; ++jj) { const float os = __uint_as_float(__builtin_amdgcn_readlane(__float_as_uint(score), jj)); rank += (os > score || (os == score && jj < j)) ? 1 : 0; }
        const bool sel = (rank < NSEL) && (score != -INFINITY);
        const unsigned long long mk = __ballot(sel);
        if (lane == 0) { selw[2 * qi] = (unsigned)mk; selw[2 * qi + 1] = (unsigned)(mk >> 32); }
    }
    asm volatile("s_waitcnt lgkmcnt(0)" ::: "memory");
    const unsigned mlo = selw[2 * (r32 & 7)], mhi = selw[2 * (r32 & 7) + 1];
    __syncthreads();
#pragma unroll
    for (int d = 0; d < 4; ++d)
#pragma unroll
        for (int e = 0; e < 16; ++e) o[d][e] = 0.f;
    float m_reg = -1e30f, l_reg = 0.f;
    const bf16* kvb = proj + (size_t)(b * SEQ) * LDP + g * 128;
    attn_stream(L, kvb + OFF_KS, kvb + OFF_VS, (size_t)LDP, 0, qb + 1, qr, MaskSel{mlo, mhi, s, qb}, NeedAll{}, o, m_reg, l_reg, tid, lane, wave);
    if (hi == 0) sc_l[r32] = 1.f / l_reg;
    asm volatile("s_waitcnt lgkmcnt(0)" ::: "memory");
    {
        bf16* obase = outS + (size_t)(b * SEQ + q0 + 8 * wave) * 2048 + g * 512;
        store_tile_direct(o, sc_l, [&](int row) { return obase + (size_t)(row & 7) * 2048 + (row >> 3) * 128; }, lane);
    }
}
__device__ __forceinline__ void compress_unit(LAS unsigned char* L, const bf16* proj, int coloff, const bf16* W1T, const float* bias1, const float* w2, bf16* outkc,
                                              int b, int g, int cblk, int tid, int lane, int wave) {
    const int r32 = lane & 31, hi = lane >> 5, n = wave & 3, th = wave >> 2;
    const int tokbase = 16 * (32 * cblk + r32);
    f32x16 acc;
#pragma unroll
    for (int e = 0; e < 16; ++e) acc[e] = 0.f;
    const bf16* arow = proj + (size_t)(b * SEQ) * LDP + coloff + g * 128 + hi * 8;
    const bf16* brow = W1T + (size_t)(32 * n + r32) * 4096 + hi * 8;
#pragma unroll 2
    for (int t = 16 * th; t < 16 * th + 16; ++t) {
        int tok = tokbase + t; tok = tok < SEQ ? tok : SEQ - 1;
        const bf16* ap = arow + (size_t)tok * LDP; const bf16* bp = brow + t * 128;
#pragma unroll
        for (int ks = 0; ks < 8; ++ks) acc = __builtin_amdgcn_mfma_f32_32x32x16_bf16(*(const bf16x8*)(ap + 16 * ks), *(const bf16x8*)(bp + 16 * ks), acc, 0, 0, 0);
    }
    LAS float* part = (LAS float*)L + th * 4096;
#pragma unroll
    for (int r = 0; r < 16; ++r) part[crow(r, hi) * 128 + 32 * n + r32] = acc[r];
    __syncthreads();
    LAS float* hid = (LAS float*)L + 8192;
    for (int e = tid; e < 4096; e += NWAVES * 64) { const float v = ((LAS float*)L)[e] + ((LAS float*)L)[4096 + e] + bias1[e & 127];
        const float uu = 0.7978845608028654f * (v + 0.044715f * v * v * v); hid[e] = 0.5f * v * (1.f + tanhf(uu)); }
    __syncthreads();
    const int j2 = tid & 127, cg = tid >> 7;
    float oacc[8];
#pragma unroll
    for (int k = 0; k < 8; ++k) oacc[k] = 0.f;
#pragma unroll 16
    for (int j = 0; j < 128; ++j) { const float w = w2[j * 128 + j2];
#pragma unroll
        for (int k = 0; k < 8; ++k) oacc[k] += hid[(cg * 8 + k) * 128 + j] * w; }
#pragma unroll
    for (int k = 0; k < 8; ++k) { const int c = 32 * cblk + cg * 8 + k; outkc[((size_t)(b * GB + g) * 256 + c) * 128 + j2] = (c < NC) ? (bf16)f2bf(oacc[k]) : (bf16)0; }
    __syncthreads();
}
__device__ __forceinline__ void gate_unit(LAS unsigned char* L, const bf16* h, const bf16* Wg, const float* rowsq0, float* gates, int row0, int tid, int lane, int wave) {
    const int r32 = lane & 31, hi = lane >> 5, rt = wave & 1, kq = wave >> 1;
    f32x16 acc0, acc1;
#pragma unroll
    for (int e = 0; e < 16; ++e) { acc0[e] = 0.f; acc1[e] = 0.f; }
    const bf16* ap = h + (size_t)(row0 + 32 * rt + r32) * D_MODEL + kq * 1024 + hi * 8;
    const bf16* bp0 = Wg + (size_t)r32 * D_MODEL + kq * 1024 + hi * 8; const bf16* bp1 = bp0 + (size_t)32 * D_MODEL;
#pragma unroll 8
    for (int ks = 0; ks < 64; ++ks) {
        const bf16x8 a = *(const bf16x8*)(ap + 16 * ks), b0 = *(const bf16x8*)(bp0 + 16 * ks), b1 = *(const bf16x8*)(bp1 + 16 * ks);
        acc0 = __builtin_amdgcn_mfma_f32_32x32x16_bf16(a, b0, acc0, 0, 0, 0); acc1 = __builtin_amdgcn_mfma_f32_32x32x16_bf16(a, b1, acc1, 0, 0, 0);
    }
    LAS float* part = (LAS float*)L + wave * 2048;
#pragma unroll
    for (int r = 0; r < 16; ++r) { part[crow(r, hi) * 64 + r32] = acc0[r]; part[crow(r, hi) * 64 + 32 + r32] = acc1[r]; }
    __syncthreads();
    for (int e = tid; e < 64 * 48; e += NWAVES * 64) { const int row = e / 48, col = e % 48, rtt = row >> 5, rr = row & 31;
        const LAS float* p = (const LAS float*)L + rtt * 2048 + rr * 64 + col;
        const float v = (p[0] + p[2 * 2048]) + (p[4 * 2048] + p[6 * 2048]);
        gates[(size_t)(row0 + row) * 48 + col] = sigmoidf_(v / sqrtf(rowsq0[row0 + row] * (1.f / 4096.f) + EPS)); }
    __syncthreads();
}
}
__device__ __forceinline__ float wave_sum(float v) {
#pragma unroll
    for (int o = 1; o < 64; o <<= 1) v += __shfl_xor(v, o);
    return v;
}
__device__ __forceinline__ float wave_max(float v) {
#pragma unroll
    for (int o = 1; o < 64; o <<= 1) v = fmaxf(v, __shfl_xor(v, o));
    return v;
}
__device__ __forceinline__ void p0_transpose_item(const float* W, int N, int nvalid, bf16* WT, size_t ldt, int k0, int n0, int drow0, LAS float* scr, int lane, const float* kgain = nullptr, float fp8scale = 0.f) {
    const int rr = lane >> 3, c4 = lane & 7, nn = n0 + 4 * c4; const bool ok = nn < nvalid;
    const GAS f32x4* src = (const GAS f32x4*)(W + (size_t)(k0 + rr) * N + nn);
    f32x4 v[8];
#pragma unroll
    for (int i = 0; i < 8; ++i) v[i] = ok ? src[(size_t)i * 2 * N] : (f32x4){0.f, 0.f, 0.f, 0.f};
#pragma unroll
    for (int i = 0; i < 8; ++i) { LAS float* d = scr + (8 * i + rr) * 33 + 4 * c4; const float gk = kgain ? kgain[k0 + 8 * i + rr] : 1.f; d[0] = v[i].x * gk; d[1] = v[i].y * gk; d[2] = v[i].z * gk; d[3] = v[i].w * gk; }
    LDS_WAIT(); asm volatile("" ::: "memory");
    const int c = lane & 7;
#pragma unroll
    for (int j = 0; j < 4; ++j) { const int n = (lane >> 3) + 8 * j; const LAS float* s = scr + (8 * c) * 33 + n;
        if (fp8scale != 0.f) {
            int w0 = __builtin_amdgcn_cvt_pk_fp8_f32(s[0 * 33] * fp8scale, s[1 * 33] * fp8scale, 0, false); w0 = __builtin_amdgcn_cvt_pk_fp8_f32(s[2 * 33] * fp8scale, s[3 * 33] * fp8scale, w0, true);
            int w1 = __builtin_amdgcn_cvt_pk_fp8_f32(s[4 * 33] * fp8scale, s[5 * 33] * fp8scale, 0, false); w1 = __builtin_amdgcn_cvt_pk_fp8_f32(s[6 * 33] * fp8scale, s[7 * 33] * fp8scale, w1, true);
            *(GAS v2u*)((GAS unsigned char*)WT + (size_t)(drow0 + n) * ldt + k0 + 8 * c) = (v2u){(unsigned)w0, (unsigned)w1};
        } else {
        v4u o; o.x = pk2(s[0 * 33], s[1 * 33]); o.y = pk2(s[2 * 33], s[3 * 33]); o.z = pk2(s[4 * 33], s[5 * 33]); o.w = pk2(s[6 * 33], s[7 * 33]);
        *(GAS v4u*)(WT + (size_t)(drow0 + n) * ldt + k0 + 8 * c) = o; } }
    LDS_WAIT(); asm volatile("" ::: "memory");
}
__device__ __forceinline__ void row_to_bf16_sumsq(const float* xrow, bf16* orow, float* sumsq, int lane) {
    const GAS f32x4* xr = (const GAS f32x4*)xrow + lane;
    f32x4 v[16]; float s = 0.f;
#pragma unroll
    for (int j = 0; j < 16; ++j) { v[j] = xr[64 * j]; s += (v[j].x * v[j].x + v[j].y * v[j].y) + (v[j].z * v[j].z + v[j].w * v[j].w); }
    s = wave_sum(s);
    if (lane == 0) *sumsq = s;
    GAS v2u* o8 = (GAS v2u*)orow + lane;
#pragma unroll
    for (int j = 0; j < 16; ++j) { v2u w; w.x = pk2(v[j].x, v[j].y); w.y = pk2(v[j].z, v[j].w); o8[64 * j] = w; }
}
__device__ __forceinline__ void rms_row_inplace(float* xrow, const float* g, int lane) {
    GAS f32x4* xr = (GAS f32x4*)xrow + lane; const GAS f32x4* gr = (const GAS f32x4*)g + lane;
    f32x4 v[16]; float s = 0.f;
#pragma unroll
    for (int j = 0; j < 16; ++j) { v[j] = xr[64 * j]; s += (v[j].x * v[j].x + v[j].y * v[j].y) + (v[j].z * v[j].z + v[j].w * v[j].w); }
    const float rs = 1.f / sqrtf(wave_sum(s) * (1.f / 4096.f) + EPS);
#pragma unroll
    for (int j = 0; j < 16; ++j) { const f32x4 gg = gr[64 * j]; xr[64 * j] = v[j] * rs * gg; }
}

struct Args { const float* in[17]; float* out; unsigned char* ws; float inv[16]; int ph_lo, ph_hi, li, pad; };
constexpr int N_PHASES = 10;
__global__ void __launch_bounds__(NWAVES * 64, 2) mega(Args args) {
    extern __shared__ __attribute__((aligned(16))) unsigned char lds[];
    LAS unsigned char* L = (LAS unsigned char*)lds;
    volatile LAS unsigned* MISC = (volatile LAS unsigned*)(L + MISC_OFF);
    const int tid = threadIdx.x, lane = tid & 63, wave = __builtin_amdgcn_readfirstlane(tid >> 6);
    const int G = gridDim.x;
    unsigned char* ws = args.ws;
    gu32* ctl = (gu32*)(ws + WS_CTL);
    const float* x = args.in[0]; const float* norm_attn = args.in[1]; const float* w_in = args.in[2];
    const float* w_out = args.in[11]; const float* norm_ffn = args.in[12]; const float* w_gate = args.in[13]; const float* w_up = args.in[14]; const float* w_down = args.in[15];
    const float* norm_final = args.in[16];
    float* out = args.out;
    bf16* Win_t = (bf16*)(ws + WS_WIN); bf16* Wout_t = (bf16*)(ws + WS_WOUT); bf16* Wgu_t = (bf16*)(ws + WS_WGU); bf16* Wdn_t = (bf16*)(ws + WS_WDN);
    bf16* bufA = (bf16*)(ws + WS_BUFA); bf16* proj = (bf16*)(ws + WS_PROJ); bf16* mixed = proj; bf16* act = proj;
    float* cs = (float*)(ws + WS_CS);
    const float* ck_pe = args.in[3]; const float* ck_w1 = args.in[4]; const float* ck_w2 = args.in[5];
    const float* cv_pe = args.in[6]; const float* cv_w1 = args.in[7]; const float* cv_w2 = args.in[8];
    const float* out_norm_a = args.in[9]; const float* out_norm_b = args.in[10];
    bf16* kcb = (bf16*)(ws + WS_KCB); bf16* vcb = (bf16*)(ws + WS_KCB + 1 * MiB);
    bf16* ckW1T = (bf16*)(ws + WS_W1T); bf16* cvW1T = (bf16*)(ws + WS_W1T + 1 * MiB);
    float* bias1 = (float*)(ws + WS_BIAS1); float* lse = (float*)(ws + WS_LSE);
    bf16* partA = (bf16*)out;
    bf16* partC = (bf16*)out + (size_t)3 * T * 2048;
    bf16* partS = (bf16*)(ws + WS_PART); bf16* partW = partS + (size_t)T * 2048;
    float* rowsq = (float*)(ws + WS_ROWSQ);
    float* gates = (float*)(ws + WS_GATES);
    for (int u = tid; u < (LDS_BYTES - LDSCTL_OFF) / 4; u += NWAVES * 64) ((LAS unsigned*)(L + LDSCTL_OFF))[u] = 0u;
    __syncthreads();
    const int lo = args.ph_lo, hi = args.ph_hi;
    const bool one_launch = (hi - lo) > 1;
    XcdBarrier bar; bar.bar = (unsigned*)(ctl + CW_BAR) + args.li * XCD_BAR_WORDS; bar.x = 0; bar.st = nullptr;
    if (one_launch) bar = xcd_barrier_post((unsigned*)(ctl + CW_BAR) + args.li * XCD_BAR_WORDS, MISC + 8);
#ifndef MK_PH
#define MK_PH 0x3ff
#endif
#define IN(k) ((((MK_PH) >> (k)) & 1) && lo <= (k) && (k) < hi)
#define BOTH(k) (IN(k) && IN((k) + 1))
    const int gw = blockIdx.x * NWAVES + wave, NGW = G * NWAVES;

    if (IN(0)) {
        LAS float* scr = (LAS float*)(L + RING_OFF + wave * 16384);
        constexpr int I_IN = 64 * 360, I_OUT = 64 * 128, I_G = 64 * 344, I_D = 172 * 128, I_W1 = 64 * 4;
        constexpr int NITEMS = I_IN + I_OUT + 2 * I_G + I_D + 2 * I_W1;
        for (int it = gw; it < NITEMS; it += NGW) {
            int r = it;
            if (r < I_IN) { const int kb = r / 360, nb = r % 360; p0_transpose_item(w_in, D_IN, D_IN, Win_t, 4096, 64 * kb, 32 * nb, 32 * nb, scr, lane, norm_attn); continue; } r -= I_IN;
            if (r < I_OUT) { const int kb = r / 128, nb = r % 128; p0_transpose_item(w_out, 4096, 4096, Wout_t, 4096, 64 * kb, 32 * nb, 32 * nb, scr, lane); continue; } r -= I_OUT;
            if (r < I_G) { const int kb = r / 344, nb = r % 344, n0 = 32 * nb; p0_transpose_item(w_gate, D_FF, D_FF, Wgu_t, 4096, 64 * kb, n0, 256 * (n0 >> 7) + (n0 & 127), scr, lane, norm_ffn); continue; } r -= I_G;
            if (r < I_G) { const int kb = r / 344, nb = r % 344, n0 = 32 * nb; p0_transpose_item(w_up, D_FF, D_FF, Wgu_t, 4096, 64 * kb, n0, 256 * (n0 >> 7) + 128 + (n0 & 127), scr, lane, norm_ffn); continue; } r -= I_G;
            if (r < I_D) { const int kb = r / 128, nb = r % 128; p0_transpose_item(w_down, 4096, 4096, Wdn_t, D_FF, 64 * kb, 32 * nb, 32 * nb, scr, lane, nullptr, WDN_SCALE); continue; } r -= I_D;
            if (r < I_W1) { const int kb = r / 4, nb = r % 4; p0_transpose_item(ck_w1, 128, 128, ckW1T, 4096, 64 * kb, 32 * nb, 32 * nb, scr, lane); continue; } r -= I_W1;
            { const int kb = r / 4, nb = r % 4; p0_transpose_item(cv_w1, 128, 128, cvW1T, 4096, 64 * kb, 32 * nb, 32 * nb, scr, lane); }
        }
        for (int o = gw; o < 256; o += NGW) {
            const int which = o >> 7, j = o & 127; const float* pe = which ? cv_pe : ck_pe; const float* w1 = which ? cv_w1 : ck_w1;
            float a = 0.f;
            for (int i = lane; i < 4096; i += 64) a += pe[i] * w1[(size_t)i * 128 + j];
            a = wave_sum(a);
            if (lane == 0) bias1[o] = a;
        }
        for (int idx = blockIdx.x * (NWAVES * 64) + tid; idx < SEQ * 16; idx += G * NWAVES * 64) {
            const int s = idx >> 4, i = idx & 15; const float ang = (float)s * args.inv[i]; const double a = (double)ang;
            cs[2 * idx] = (float)cos(a); cs[2 * idx + 1] = (float)sin(a);
        }
        for (int m = gw; m < T; m += NGW) row_to_bf16_sumsq(x + (size_t)m * D_MODEL, bufA + (size_t)m * D_MODEL, rowsq + 2 * T + m, lane);
        for (int i = blockIdx.x * (NWAVES * 64) + tid; i < 2 * T; i += G * NWAVES * 64) rowsq[i] = 0.f;
        if (BOTH(0)) xcd_barrier(bar);
    }
    if (IN(1)) {
        pg8::Gemm g{bufA, Win_t, T, OFF_GL, D_MODEL}; pg8::StaticOrder S; S.init(T, OFF_GL, G, (int)blockIdx.x);
        pg8::EpiProj E{proj, LDP, cs, rowsq + 2 * T, 1.f / 4096.f, EPS};
        pg8::gemm_phase<pg8::EpiProj, pg8::StaticOrder, PG_ALIGN, true>(L + RING_OFF, g, S, E);
        if (BOTH(1)) xcd_barrier(bar);
    }
    if (IN(2)) {
        for (int cu = blockIdx.x; cu < 256; cu += G) { const int which = cu >> 7, r = cu & 127;
            att::compress_unit(L, proj, which ? OFF_VC : OFF_KC, which ? cvW1T : ckW1T, bias1 + which * 128, which ? cv_w2 : ck_w2, which ? vcb : kcb, r >> 5, (r >> 3) & 3, r & 7, tid, lane, wave); }
        for (int u = blockIdx.x; u < T / 64; u += G) att::gate_unit(L, bufA, Win_t + (size_t)OFF_GL * D_MODEL, rowsq + 2 * T, gates, 64 * u, tid, lane, wave);
        for (int u = blockIdx.x; u < 1024; u += G) att::window_unit(L, proj, partW, u, tid, lane, wave);
        for (int u = blockIdx.x; u < 3072; u += G) att::dilated_unit(L, proj, partA, lse, u, tid, lane, wave);
        if (BOTH(2)) xcd_barrier(bar);
    }
    if (IN(3)) {
        for (int rd = 0; rd * G < 1024; ++rd) {
            const int idx = (rd & 1) ? rd * G + (G - 1 - (int)blockIdx.x) : rd * G + (int)blockIdx.x;
            if (idx < 1024) { const int qb = 63 - (idx >> 4), bg = idx & 15; att::nsa_unit(L, proj, kcb, vcb, partC, partS, bg >> 2, bg & 3, qb, tid, lane, wave); }
        }
        if (BOTH(3)) xcd_barrier(bar);
    }
    if (IN(4)) {
        for (int it = gw; it < 2 * T; it += NGW) {
            const int m = it >> 1, grp = it & 1;
            float ov[32]; float ss = 0.f;
            if (grp == 0) {
#pragma unroll
                for (int k = 0; k < 4; ++k) {
                    const int ch = lane + 64 * k, head = ch >> 4;
                    const float l0 = lse[((size_t)0 * T + m) * 16 + head], l1 = lse[((size_t)1 * T + m) * 16 + head], l2 = lse[((size_t)2 * T + m) * 16 + head];
                    const float mx = fmaxf(l0, fmaxf(l1, l2)); const float e0 = __expf(l0 - mx), e1 = __expf(l1 - mx), e2 = __expf(l2 - mx); const float inv = 1.f / (e0 + e1 + e2);
                    const float w0 = e0 * inv, w1 = e1 * inv, w2 = e2 * inv;
                    const size_t off = (size_t)m * 2048 + 8 * ch;
                    const v4u x0 = *(const v4u*)(partA + off), x1 = *(const v4u*)(partA + (size_t)T * 2048 + off), x2 = *(const v4u*)(partA + (size_t)2 * T * 2048 + off);
#pragma unroll
                    for (int e = 0; e < 4; ++e) {
                        const float alo = w0 * __uint_as_float(x0[e] << 16) + w1 * __uint_as_float(x1[e] << 16) + w2 * __uint_as_float(x2[e] << 16);
                        const float ahi = w0 * __uint_as_float(x0[e] & 0xffff0000u) + w1 * __uint_as_float(x1[e] & 0xffff0000u) + w2 * __uint_as_float(x2[e] & 0xffff0000u);
                        ov[8 * k + 2 * e] = alo; ov[8 * k + 2 * e + 1] = ahi; ss += alo * alo + ahi * ahi;
                    }
                }
            } else {
#pragma unroll
                for (int k = 0; k < 4; ++k) {
                    const int ch = lane + 64 * k, head = ch >> 4;
                    const size_t off = (size_t)m * 2048 + 8 * ch;
                    const float gc = gates[(size_t)m * 48 + head * 3], gs = gates[(size_t)m * 48 + head * 3 + 1], gw_ = gates[(size_t)m * 48 + head * 3 + 2];
                    const v4u y0 = *(const v4u*)(partC + off), y1 = *(const v4u*)(partS + off), y2 = *(const v4u*)(partW + off);
#pragma unroll
                    for (int e = 0; e < 4; ++e) {
                        const float blo = gc * __uint_as_float(y0[e] << 16) + gs * __uint_as_float(y1[e] << 16) + gw_ * __uint_as_float(y2[e] << 16);
                        const float bhi = gc * __uint_as_float(y0[e] & 0xffff0000u) + gs * __uint_as_float(y1[e] & 0xffff0000u) + gw_ * __uint_as_float(y2[e] & 0xffff0000u);
                        ov[8 * k + 2 * e] = blo; ov[8 * k + 2 * e + 1] = bhi; ss += blo * blo + bhi * bhi;
                    }
                }
            }
            const float rs = 1.f / sqrtf(wave_sum(ss) * (1.f / 2048.f) + EPS);
            const float* gn = grp ? out_norm_b : out_norm_a;
#pragma unroll
            for (int k = 0; k < 4; ++k) {
                const int ch = lane + 64 * k;
                const f32x4 g0 = *(const f32x4*)(gn + 8 * ch), g1 = *(const f32x4*)(gn + 8 * ch + 4);
                v4u w;
                w.x = pk2(ov[8 * k + 0] * rs * g0.x, ov[8 * k + 1] * rs * g0.y); w.y = pk2(ov[8 * k + 2] * rs * g0.z, ov[8 * k + 3] * rs * g0.w);
                w.z = pk2(ov[8 * k + 4] * rs * g1.x, ov[8 * k + 5] * rs * g1.y); w.w = pk2(ov[8 * k + 6] * rs * g1.z, ov[8 * k + 7] * rs * g1.w);
                *(v4u*)(mixed + (size_t)m * D_MODEL + grp * 2048 + 8 * ch) = w;
            }
        }
        if (BOTH(4)) xcd_barrier(bar);
    }

    if (IN(5)) {
        pg8::Gemm g{mixed, Wout_t, T, D_MODEL, D_MODEL}; pg8::StaticOrder S; S.init(T, D_MODEL, G, (int)blockIdx.x);
        pg8::EpiResid<true> E{bufA, D_MODEL, bufA, rowsq, 1.f};
        pg8::gemm_phase<pg8::EpiResid<true>, pg8::StaticOrder, PG_ALIGN, true>(L + RING_OFF, g, S, E);
        if (IN(7)) xcd_barrier(bar);
    }
    if (IN(7)) {
        pg8::Gemm g{bufA, Wgu_t, T, NGU, D_MODEL}; pg8::StaticOrder S; S.init(T, NGU, G, (int)blockIdx.x);
        pg8::EpiSwiglu<true> E{act, D_FF, rowsq, 1.f / 4096.f, EPS};
        pg8::gemm_phase<pg8::EpiSwiglu<true>, pg8::StaticOrder, PG_ALIGN, true>(L + RING_OFF, g, S, E);
        if (BOTH(7)) xcd_barrier(bar);
    }
    if (IN(8)) {
        pg8::Gemm g{act, Wdn_t, T, D_MODEL, D_FF / 2}; pg8::StaticOrder S; S.init(T, D_MODEL, G, (int)blockIdx.x);
        pg8::EpiResid<true> E{bufA, D_MODEL, bufA, rowsq + T, 1.f / WDN_SCALE};
        pg8::gemm_phase<pg8::EpiResid<true>, pg8::StaticOrder, PG_ALIGN, P8_SP2, true>(L + RING_OFF, g, S, E);
        if (BOTH(8)) xcd_barrier(bar);
    }
    if (IN(9)) {
        for (int m = gw; m < T; m += NGW) {
            const float rs = 1.f / sqrtf(rowsq[T + m] * (1.f / 4096.f) + EPS);
            const GAS v2u* xr = (const GAS v2u*)(bufA + (size_t)m * D_MODEL) + lane; const GAS f32x4* gr = (const GAS f32x4*)norm_final + lane; GAS f32x4* orow = (GAS f32x4*)(out + (size_t)m * D_MODEL) + lane;
            v2u v[16];
#pragma unroll
            for (int j = 0; j < 16; ++j) v[j] = xr[64 * j];
#pragma unroll
            for (int j = 0; j < 16; ++j) { const f32x4 gg = gr[64 * j];
                orow[64 * j] = (f32x4){__uint_as_float(v[j].x << 16) * rs * gg.x, __uint_as_float(v[j].x & 0xffff0000u) * rs * gg.y, __uint_as_float(v[j].y << 16) * rs * gg.z, __uint_as_float(v[j].y & 0xffff0000u) * rs * gg.w}; }
        }
    }
#undef IN
#undef BOTH
}

extern "C" void kernel_launch(void* const* d_in, const int* in_sizes, int n_in, void* d_out, int out_size, void* d_ws, size_t ws_size, hipStream_t stream) {
    static int grid = 0;
    if (grid == 0) {
        if (n_in != 17 || out_size != T * D_MODEL || ws_size < WS_END) { fprintf(stderr, "kernel_launch: unexpected shapes (n_in %d out %d ws %zu); nothing launched\n", n_in, out_size, ws_size); grid = -1; return; }
        int dev = 0, cus = 0, per_cu = 0;
        if (hipGetDevice(&dev) != hipSuccess || hipDeviceGetAttribute(&cus, hipDeviceAttributeMultiprocessorCount, dev) != hipSuccess) { grid = -1; return; }
        if (hipFuncSetAttribute((const void*)mega, hipFuncAttributeMaxDynamicSharedMemorySize, LDS_BYTES) != hipSuccess) { fprintf(stderr, "kernel_launch: hipFuncSetAttribute failed\n"); grid = -1; return; }
        if (hipOccupancyMaxActiveBlocksPerMultiprocessor(&per_cu, (const void*)mega, NWAVES * 64, LDS_BYTES) != hipSuccess || per_cu < 1)
            fprintf(stderr, "kernel_launch: note: occupancy query reports %d workgroups per CU\n", per_cu);
        (void)hipGetLastError();
        grid = cus;
    }
    if (grid < 0) return;
    if (hipMemsetAsync((char*)d_ws + WS_CTL, 0, CTL_ZERO_BYTES, stream) != hipSuccess) return;
    Args a{};
    for (int i = 0; i < 17; ++i) a.in[i] = (const float*)d_in[i];
    a.out = (float*)d_out; a.ws = (unsigned char*)d_ws;
    for (int i = 0; i < 16; ++i) a.inv[i] = (float)pow(500000.0, -(double)(2 * i) / 32.0);
    unsigned char* ws = (unsigned char*)d_ws;
    int n_launch = 0;
    auto launch = [&](int lo, int hi) { a.ph_lo = lo; a.ph_hi = hi; a.li = n_launch++; hipLaunchKernelGGL(mega, dim3(grid), dim3(NWAVES * 64), LDS_BYTES, stream, a); };
#if MK_BUILD == 2
    for (int ph = 0; ph < N_PHASES; ++ph) launch(ph, ph + 1);
#elif MK_BUILD == 3
    launch(0, N_PHASES);
#else
#if MK_PROBE == 0
    launch(0, N_PHASES); launch(0, 1);
#elif MK_PROBE == 7
    launch(0, N_PHASES); launch(7, 8);
#else
    launch(0, MK_PROBE + 1); launch(MK_PROBE, MK_PROBE + 1); launch(MK_PROBE + 1, N_PHASES);
#endif
#endif
    const hipError_t le = hipPeekAtLastError();
    if (le != hipSuccess) fprintf(stderr, "kernel_launch: launch failed: %s\n", hipGetErrorName(le));
}
```

```cpp
#include <hip/hip_runtime.h>
#include <cstdio>
#include <cstdint>
#include <math.h>

#ifndef MK_BUILD
#define MK_BUILD 3
#endif
namespace pg8 {
#define PG8_LAS __attribute__((address_space(3)))
typedef unsigned short bf16_t;
typedef short bf16x8 __attribute__((ext_vector_type(8)));
typedef float f32x4 __attribute__((ext_vector_type(4)));
typedef unsigned u32x4 __attribute__((ext_vector_type(4)));
constexpr int BM = 256, BK = 64, HALF = 128, HTB = HALF * BK * 2  , STAGE_BYTES = 8 * HTB, NXCD = 8, WGM = 8;

__host__ __device__ __forceinline__ int lds_byte(int r, int c) { const int st = (r >> 4) * 2 + (c >> 5), rr = r & 15, cc = c & 31, ob = rr * 64 + cc * 2; return st * 1024 + (ob ^ (((ob >> 9) & 1) << 5)); }
__host__ __device__ __forceinline__ void stage_rc(int b, int& R, int& C) { const int st = b / 1024, sb = b % 1024, swz = sb ^ (((sb >> 9) & 1) << 5); R = (st >> 1) * 16 + swz / 64; C = (st & 1) * 32 + (swz % 64) / 2; }
__host__ __device__ __forceinline__ int perm32(int rho) { const int n = rho >> 4, i = rho & 15; return 8 * (i >> 2) + 4 * n + (i & 3); }

struct Unit { int pm, pn; };
struct Gemm { const bf16_t* A; const bf16_t* Bt; int M, N, K; };

struct StaticOrder {
    int nM, nN, nwg, G, c;
    __host__ __device__ void init(int M, int N, int G_, int c_) { nM = M / BM; nN = N / BM; nwg = nM * nN; G = G_; c = c_; }
    __host__ __device__ bool next(int i, Unit& u) const {
        const long L = (long)i * G + c; if (L >= nwg) return false;
        int wgid = (int)L; { const int q = nwg / NXCD, r = nwg % NXCD, xcd = wgid % NXCD, off = wgid / NXCD; wgid = (xcd < r ? xcd * (q + 1) : r * (q + 1) + (xcd - r) * q) + off; }
        const int nig = WGM * nN, gid = wgid / nig, fm = gid * WGM, gsz = (nM - fm) < WGM ? (nM - fm) : WGM;
        u.pm = fm + ((wgid % nig) % gsz); u.pn = (wgid % nig) / gsz; return true;
    }
    __device__ __forceinline__ void a_ready(const Unit&) const {}
    __device__ __forceinline__ void done(const Unit&) const {}
};
__device__ __forceinline__ unsigned cvt_pk_bf16(float lo, float hi) { unsigned r; asm volatile("v_cvt_pk_bf16_f32 %0, %1, %2" : "=v"(r) : "v"(lo), "v"(hi)); return r; }
typedef unsigned u32x4 __attribute__((ext_vector_type(4)));
typedef unsigned u32x2 __attribute__((ext_vector_type(2)));
struct EpiProj {
    static constexpr bool PERM = true, AFTER_DRAIN = false;
    bf16_t* O; int ldc; const float* cs; const float* rowsq; float inv_k, eps;
    __device__ __forceinline__ void operator()(const f32x4 (&acc)[2][2][4][2], const Unit& u, int wr, int wc, int fr, int fq) const {
        const int row0 = u.pm * BM + wr * 64 + fr;
        const int col0 = u.pn * BM + wc * 32 + 8 * fq;
#pragma unroll
        for (int bj = 0; bj < 2; ++bj) {
            const int hd = u.pn * 2 + bj;
            const bool rope = (wc == 0) && (hd < 32 || (hd >= 48 && hd < 68) || (hd >= 72 && hd < 76) || (hd >= 80 && hd < 84));
#pragma unroll
            for (int ai = 0; ai < 2; ++ai)
#pragma unroll
                for (int m = 0; m < 4; ++m) {
                    const int row = row0 + ai * HALF + m * 16;
                    const float rs = 1.f / sqrtf(rowsq[row] * inv_k + eps);
                    f32x4 v0 = acc[ai][bj][m][0] * rs, v1 = acc[ai][bj][m][1] * rs;
                    if (rope) {
                        f32x4 w0, w1;
#pragma unroll
                        for (int e = 0; e < 4; ++e) { w0[e] = __shfl_xor(v0[e], 32); w1[e] = __shfl_xor(v1[e], 32); }
                        const float* c = cs + ((size_t)(row & 4095) * 16 + 8 * (fq & 1)) * 2;
                        const f32x4 c0 = *(const f32x4*)c, c1 = *(const f32x4*)(c + 4), c2 = *(const f32x4*)(c + 8), c3 = *(const f32x4*)(c + 12);
                        const float cosv[8] = {c0[0], c0[2], c1[0], c1[2], c2[0], c2[2], c3[0], c3[2]};
                        const float sinv[8] = {c0[1], c0[3], c1[1], c1[3], c2[1], c2[3], c3[1], c3[3]};
                        if (fq < 2) {
#pragma unroll
                            for (int e = 0; e < 4; ++e) { v0[e] = v0[e] * cosv[e] - w0[e] * sinv[e]; v1[e] = v1[e] * cosv[4 + e] - w1[e] * sinv[4 + e]; }
                        } else {
#pragma unroll
                            for (int e = 0; e < 4; ++e) { v0[e] = w0[e] * sinv[e] + v0[e] * cosv[e]; v1[e] = w1[e] * sinv[4 + e] + v1[e] * cosv[4 + e]; }
                        }
                    }
                    u32x4 w; w.x = cvt_pk_bf16(v0[0], v0[1]); w.y = cvt_pk_bf16(v0[2], v0[3]); w.z = cvt_pk_bf16(v1[0], v1[1]); w.w = cvt_pk_bf16(v1[2], v1[3]);
                    *(u32x4*)(O + (size_t)row * ldc + col0 + bj * HALF) = w;
                }
        }
    }
};
template <bool R_BF16> struct EpiResid {
    static constexpr bool PERM = true, AFTER_DRAIN = false;
    const void* R; bf16_t* Ob; float* rowsq; unsigned char* O8; int ldc; float ascale;
    __device__ __forceinline__ void operator()(const f32x4 (&acc)[2][2][4][2], const Unit& u, int wr, int wc, int fr, int fq) const {
        const int row0 = u.pm * BM + wr * 64 + fr;
        const int col0 = u.pn * BM + wc * 32 + 8 * fq;
#pragma unroll
        for (int ai = 0; ai < 2; ++ai)
#pragma unroll
            for (int m = 0; m < 4; ++m) {
                const size_t ro = (size_t)(row0 + ai * HALF + m * 16) * ldc + col0;
                float ss = 0.f;
#pragma unroll
                for (int bj = 0; bj < 2; ++bj) {
                    f32x4 r0, r1;
                    if constexpr (R_BF16) { const u32x4 rb = *(const u32x4*)((const bf16_t*)R + ro + bj * HALF);
                        r0 = (f32x4){__builtin_bit_cast(float, rb.x << 16), __builtin_bit_cast(float, rb.x & 0xffff0000u), __builtin_bit_cast(float, rb.y << 16), __builtin_bit_cast(float, rb.y & 0xffff0000u)};
                        r1 = (f32x4){__builtin_bit_cast(float, rb.z << 16), __builtin_bit_cast(float, rb.z & 0xffff0000u), __builtin_bit_cast(float, rb.w << 16), __builtin_bit_cast(float, rb.w & 0xffff0000u)}; }
                    else { r0 = *(const f32x4*)((const float*)R + ro + bj * HALF); r1 = *(const f32x4*)((const float*)R + ro + bj * HALF + 4); }
                    const f32x4 o0 = r0 + acc[ai][bj][m][0] * ascale, o1 = r1 + acc[ai][bj][m][1] * ascale;
                    u32x4 w; w.x = cvt_pk_bf16(o0[0], o0[1]); w.y = cvt_pk_bf16(o0[2], o0[3]); w.z = cvt_pk_bf16(o1[0], o1[1]); w.w = cvt_pk_bf16(o1[2], o1[3]);
                    *(u32x4*)(Ob + ro + bj * HALF) = w;
                    if (O8) { int w0 = __builtin_amdgcn_cvt_pk_fp8_f32(o0[0], o0[1], 0, false); w0 = __builtin_amdgcn_cvt_pk_fp8_f32(o0[2], o0[3], w0, true);
                        int w1 = __builtin_amdgcn_cvt_pk_fp8_f32(o1[0], o1[1], 0, false); w1 = __builtin_amdgcn_cvt_pk_fp8_f32(o1[2], o1[3], w1, true);
                        *(u32x2*)(O8 + ro + bj * HALF) = (u32x2){(unsigned)w0, (unsigned)w1}; }
                    ss += (o0[0] * o0[0] + o0[1] * o0[1]) + (o0[2] * o0[2] + o0[3] * o0[3]) + (o1[0] * o1[0] + o1[1] * o1[1]) + (o1[2] * o1[2] + o1[3] * o1[3]);
                }
                ss += __shfl_xor(ss, 16); ss += __shfl_xor(ss, 32); if (fq == 0) atomicAdd(rowsq + (row0 + ai * HALF + m * 16), ss);
            }
    }
};
template <bool FP8OUT> struct EpiSwiglu {
    static constexpr bool PERM = true, AFTER_DRAIN = false;
    bf16_t* O; int ldc; const float* rowsq; float inv_k, eps, ascale;
    __device__ __forceinline__ static float silu_mul(float g, float uu) { return g * __builtin_amdgcn_rcpf(1.f + __builtin_amdgcn_exp2f(-1.4426950408889634f * g)) * uu; }
    __device__ __forceinline__ void operator()(const f32x4 (&acc)[2][2][4][2], const Unit& u, int wr, int wc, int fr, int fq) const {
        const int row0 = u.pm * BM + wr * 64 + fr;
        const int col0 = u.pn * HALF + wc * 32 + 8 * fq;
#pragma unroll
        for (int ai = 0; ai < 2; ++ai)
#pragma unroll
            for (int m = 0; m < 4; ++m) {
                const float rs = ascale / sqrtf(rowsq[row0 + ai * HALF + m * 16] * inv_k + eps);
                const f32x4 g0 = acc[ai][0][m][0] * rs, g1 = acc[ai][0][m][1] * rs, u0 = acc[ai][1][m][0] * rs, u1 = acc[ai][1][m][1] * rs;
                if constexpr (FP8OUT) {
                    int w0 = __builtin_amdgcn_cvt_pk_fp8_f32(silu_mul(g0[0], u0[0]), silu_mul(g0[1], u0[1]), 0, false); w0 = __builtin_amdgcn_cvt_pk_fp8_f32(silu_mul(g0[2], u0[2]), silu_mul(g0[3], u0[3]), w0, true);
                    int w1 = __builtin_amdgcn_cvt_pk_fp8_f32(silu_mul(g1[0], u1[0]), silu_mul(g1[1], u1[1]), 0, false); w1 = __builtin_amdgcn_cvt_pk_fp8_f32(silu_mul(g1[2], u1[2]), silu_mul(g1[3], u1[3]), w1, true);
                    *(u32x2*)((unsigned char*)O + (size_t)(row0 + ai * HALF + m * 16) * ldc + col0) = (u32x2){(unsigned)w0, (unsigned)w1};
                } else {
                u32x4 w;
                w.x = cvt_pk_bf16(silu_mul(g0[0], u0[0]), silu_mul(g0[1], u0[1])); w.y = cvt_pk_bf16(silu_mul(g0[2], u0[2]), silu_mul(g0[3], u0[3]));
                w.z = cvt_pk_bf16(silu_mul(g1[0], u1[0]), silu_mul(g1[1], u1[1])); w.w = cvt_pk_bf16(silu_mul(g1[2], u1[2]), silu_mul(g1[3], u1[3]));
                *(u32x4*)(O + (size_t)(row0 + ai * HALF + m * 16) * ldc + col0) = w; }
            }
    }
};
typedef int v8i_t __attribute__((ext_vector_type(8)));
typedef int v4i_t __attribute__((ext_vector_type(4)));
__device__ __forceinline__ v8i_t cat8(bf16x8 lo, bf16x8 hi) { const v4i_t a = __builtin_bit_cast(v4i_t, lo), b = __builtin_bit_cast(v4i_t, hi); return __builtin_shufflevector(a, b, 0, 1, 2, 3, 4, 5, 6, 7); }
template <class Epi, class Sched, bool ALIGN_EPI = false, bool SP2 = false, bool FP8 = false>
__device__ __forceinline__ void gemm_phase(PG8_LAS unsigned char* lds, const Gemm g, const Sched& S, const Epi& E) {
    const int tid = threadIdx.x, wid = __builtin_amdgcn_readfirstlane(tid >> 6), lane = tid & 63, wr = wid >> 2, wc = wid & 3, fr = lane & 15, fq = lane >> 4;
    const int K = g.K, nt = K / BK;
    unsigned voffA[2], voffB[2];
#pragma unroll
    for (int i = 0; i < 2; ++i) { int R, C; stage_rc(tid * 16 + i * 8192, R, C); const int Rb = Epi::PERM ? ((R & ~31) + perm32(R & 31)) : R;
        voffA[i] = (unsigned)(R * K + C) * 2u; voffB[i] = (unsigned)(Rb * K + C) * 2u; }
    const size_t kstep = (size_t)(BK * 2);
    const size_t hstep = (size_t)HALF * K * 2;
    const size_t tstep = 2 * hstep;
    const unsigned ldsw = (unsigned)wid * 1024u;
    const int aoff = lds_byte(wr * 64 + fr, fq * 8), boff = lds_byte(wc * 32 + fr, fq * 8);
#define PG8_SA(b, h) (((b) * 2 + (h)) * HTB)
#define PG8_SB(b, h) ((4 + (b) * 2 + (h)) * HTB)
#define PG8_STAGE(bufoff, gbase, voff) do { _Pragma("unroll") for (int _i = 0; _i < 2; ++_i) \
        __builtin_amdgcn_global_load_lds((const unsigned*)((const char*)(gbase) + (voff)[_i]), (PG8_LAS unsigned*)(lds + (bufoff) + ldsw + _i * 8192), 16, 0, 0); } while (0)
#define PG8_LDA(dst, b, h) do { if constexpr (FP8) { _Pragma("unroll") for (int m = 0; m < 4; ++m) dst##8[m] = cat8(*(const PG8_LAS bf16x8*)(lds + PG8_SA(b, h) + aoff + m * 2048), *(const PG8_LAS bf16x8*)(lds + PG8_SA(b, h) + aoff + m * 2048 + 1024)); } else { \
        _Pragma("unroll") for (int m = 0; m < 4; ++m) _Pragma("unroll") for (int k = 0; k < 2; ++k) dst[m][k] = *(const PG8_LAS bf16x8*)(lds + PG8_SA(b, h) + aoff + m * 2048 + k * 1024); } } while (0)
#define PG8_LDB(dst, b, h) do { if constexpr (FP8) { _Pragma("unroll") for (int n = 0; n < 2; ++n) dst##8[n] = cat8(*(const PG8_LAS bf16x8*)(lds + PG8_SB(b, h) + boff + n * 2048), *(const PG8_LAS bf16x8*)(lds + PG8_SB(b, h) + boff + n * 2048 + 1024)); } else { \
        _Pragma("unroll") for (int n = 0; n < 2; ++n) _Pragma("unroll") for (int k = 0; k < 2; ++k) dst[n][k] = *(const PG8_LAS bf16x8*)(lds + PG8_SB(b, h) + boff + n * 2048 + k * 1024); } } while (0)
#define PG8_MMA(ai, bj, At, Bt) do { __builtin_amdgcn_s_setprio(1); if constexpr (FP8) { _Pragma("unroll") for (int m = 0; m < 4; ++m) _Pragma("unroll") for (int n = 0; n < 2; ++n) \
        asm volatile("v_mfma_scale_f32_16x16x128_f8f6f4 %0, %1, %2, %0, %3, %3 op_sel_hi:[0,0,0]" : "+v"(acc[ai][bj][m][n]) : "v"(Bt##8[n]), "v"(At##8[m]), "v"(fp8_unit_scale)); } else { \
        _Pragma("unroll") for (int m = 0; m < 4; ++m) _Pragma("unroll") for (int n = 0; n < 2; ++n) _Pragma("unroll") for (int k = 0; k < 2; ++k) \
        acc[ai][bj][m][n] = __builtin_amdgcn_mfma_f32_16x16x32_bf16(Bt[n][k], At[m][k], acc[ai][bj][m][n], 0, 0, 0); } __builtin_amdgcn_s_setprio(0); } while (0)
#define PG8_WAIT_V(n) asm volatile("s_waitcnt vmcnt(" #n ")" ::: "memory")
#define PG8_WAIT_L(n) asm volatile("s_waitcnt lgkmcnt(" #n ")" ::: "memory")
#define PG8_BAR __builtin_amdgcn_s_barrier()
#define PG8_SCHED __builtin_amdgcn_sched_barrier(0)
    Unit cur, nxt; int ui = 0;
    if (!S.next(0, cur)) return;
    f32x4 acc[2][2][4][2];
#pragma unroll
    for (int a = 0; a < 2; ++a)
#pragma unroll
        for (int b = 0; b < 2; ++b)
#pragma unroll
            for (int m = 0; m < 4; ++m)
#pragma unroll
                for (int n = 0; n < 2; ++n) acc[a][b][m][n] = (f32x4){0.f, 0.f, 0.f, 0.f};
    const int fp8_unit_scale = 0x7F7F7F7F;
    bf16x8 At[4][2], B0[2][2], B1[2][2]; v8i_t At8[4], B08[2], B18[2];
    const char* cA = (const char*)g.A + (size_t)cur.pm * tstep; const char* cB = (const char*)g.Bt + (size_t)cur.pn * tstep;
    S.a_ready(cur);
    if constexpr (SP2) {
        PG8_STAGE(PG8_SB(0, 0), cB, voffB); PG8_STAGE(PG8_SB(0, 1), cB + hstep, voffB); PG8_STAGE(PG8_SA(0, 0), cA, voffA); PG8_STAGE(PG8_SA(0, 1), cA + hstep, voffA);
        if (wr == 1) PG8_BAR;
        PG8_WAIT_V(2); PG8_BAR;
        PG8_STAGE(PG8_SB(1, 0), cB + kstep, voffB); PG8_STAGE(PG8_SA(1, 0), cA + kstep, voffA); PG8_STAGE(PG8_SB(1, 1), cB + hstep + kstep, voffB);
        PG8_WAIT_V(6); PG8_BAR;
    } else {
        PG8_STAGE(PG8_SB(0, 0), cB, voffB); PG8_STAGE(PG8_SA(0, 0), cA, voffA); PG8_STAGE(PG8_SB(0, 1), cB + hstep, voffB); PG8_STAGE(PG8_SA(0, 1), cA + hstep, voffA);
        if (wr == 1) PG8_BAR;
        PG8_WAIT_V(4); PG8_BAR;
        PG8_STAGE(PG8_SB(1, 0), cB + kstep, voffB); PG8_STAGE(PG8_SA(1, 0), cA + kstep, voffA); PG8_STAGE(PG8_SB(1, 1), cB + hstep + kstep, voffB);
        PG8_WAIT_V(6); PG8_BAR;
    }
    for (;;) {
        const bool has_next = S.next(ui + 1, nxt);
        const char* nA = has_next ? (const char*)g.A + (size_t)nxt.pm * tstep : cA; const char* nB = has_next ? (const char*)g.Bt + (size_t)nxt.pn * tstep : cB;
        for (int t = 0; t < nt; t += 2) {
            const bool last = (t == nt - 2);
            const char* a1 = cA + (size_t)(t + 1) * kstep;
            const char* a2 = last ? nA : cA + (size_t)(t + 2) * kstep; const char* b2 = last ? nB : cB + (size_t)(t + 2) * kstep;
            const char* a3 = a2 + kstep; const char* b3 = b2 + kstep;
            if (last && has_next) S.a_ready(nxt);
            if constexpr (SP2) {
            PG8_LDB(B0, 0, 0); PG8_LDB(B1, 0, 1); PG8_SCHED; PG8_LDA(At, 0, 0); PG8_STAGE(PG8_SA(1, 1), a1 + hstep, voffA);
            PG8_WAIT_V(8); PG8_WAIT_L(0); PG8_BAR; PG8_MMA(0, 0, At, B0); PG8_MMA(0, 1, At, B1); PG8_BAR; PG8_SCHED;
            PG8_LDA(At, 0, 1); PG8_STAGE(PG8_SB(0, 0), b2, voffB); PG8_STAGE(PG8_SB(0, 1), b2 + hstep, voffB); PG8_STAGE(PG8_SA(0, 0), a2, voffA);
            PG8_WAIT_V(8); PG8_WAIT_L(0); PG8_BAR; PG8_MMA(1, 0, At, B0); PG8_MMA(1, 1, At, B1); PG8_BAR; PG8_SCHED;
            PG8_LDB(B0, 1, 0); PG8_LDB(B1, 1, 1); PG8_SCHED; PG8_LDA(At, 1, 0); PG8_STAGE(PG8_SA(0, 1), a2 + hstep, voffA);
            PG8_WAIT_V(8); PG8_WAIT_L(0); PG8_BAR; PG8_MMA(0, 0, At, B0); PG8_MMA(0, 1, At, B1); PG8_BAR; PG8_SCHED;
            PG8_LDA(At, 1, 1); PG8_STAGE(PG8_SB(1, 0), b3, voffB); PG8_STAGE(PG8_SB(1, 1), b3 + hstep, voffB); PG8_STAGE(PG8_SA(1, 0), a3, voffA);
            PG8_WAIT_V(8); PG8_WAIT_L(0); PG8_BAR; PG8_MMA(1, 0, At, B0); PG8_MMA(1, 1, At, B1); PG8_BAR; PG8_SCHED;
            } else {
            PG8_LDB(B0, 0, 0); PG8_SCHED; PG8_LDA(At, 0, 0); PG8_STAGE(PG8_SA(1, 1), a1 + hstep, voffA);
            PG8_WAIT_L(8); PG8_BAR; PG8_WAIT_L(0); PG8_MMA(0, 0, At, B0); PG8_BAR; PG8_SCHED;
            PG8_LDB(B1, 0, 1); PG8_STAGE(PG8_SB(0, 0), b2, voffB);
            PG8_BAR; PG8_WAIT_L(0); PG8_MMA(0, 1, At, B1); PG8_BAR;
            PG8_LDA(At, 0, 1); PG8_STAGE(PG8_SA(0, 0), a2, voffA);
            PG8_BAR; PG8_WAIT_L(0); PG8_MMA(1, 0, At, B0); PG8_BAR; PG8_SCHED;
            PG8_STAGE(PG8_SB(0, 1), b2 + hstep, voffB);
            PG8_WAIT_V(6); PG8_BAR; PG8_MMA(1, 1, At, B1); PG8_BAR;
            PG8_LDB(B0, 1, 0); PG8_SCHED; PG8_LDA(At, 1, 0); PG8_STAGE(PG8_SA(0, 1), a2 + hstep, voffA);
            PG8_WAIT_L(8); PG8_BAR; PG8_WAIT_L(0); PG8_MMA(0, 0, At, B0); PG8_BAR; PG8_SCHED;
            PG8_LDB(B1, 1, 1); PG8_STAGE(PG8_SB(1, 0), b3, voffB);
            PG8_BAR; PG8_WAIT_L(0); PG8_MMA(0, 1, At, B1); PG8_BAR;
            PG8_LDA(At, 1, 1); PG8_STAGE(PG8_SA(1, 0), a3, voffA);
            PG8_BAR; PG8_WAIT_L(0); PG8_MMA(1, 0, At, B0); PG8_BAR; PG8_SCHED;
            PG8_STAGE(PG8_SB(1, 1), b3 + hstep, voffB);
            PG8_WAIT_V(6); PG8_BAR; PG8_MMA(1, 1, At, B1); PG8_BAR;
            }
        }
        if constexpr (ALIGN_EPI) { if (wr == 0) PG8_BAR; }
        if constexpr (FP8) asm volatile("s_nop 15\n\ts_nop 15\n\ts_nop 15" ::: "memory");
        if constexpr (!Epi::AFTER_DRAIN) { E(acc, cur, wr, wc, fr, fq); S.done(cur); }
        if (!has_next) break;
#pragma unroll
        for (int a = 0; a < 2; ++a)
#pragma unroll
            for (int b = 0; b < 2; ++b)
#pragma unroll
                for (int m = 0; m < 4; ++m)
#pragma unroll
                    for (int n = 0; n < 2; ++n) acc[a][b][m][n] = (f32x4){0.f, 0.f, 0.f, 0.f};
        if constexpr (FP8) asm volatile("s_nop 7" ::: "memory");
        cur = nxt; cA = nA; cB = nB; ++ui;
        if constexpr (ALIGN_EPI) { if (wr == 1) PG8_BAR; }
    }
    PG8_WAIT_V(0);
    if constexpr (!ALIGN_EPI) { if (wr == 0) PG8_BAR; }
    PG8_BAR;
    if constexpr (Epi::AFTER_DRAIN) { E.fused(acc, cur, wr, wc, fr, fq, lds, wid, lane); S.done(cur); }
#undef PG8_SA
#undef PG8_SB
#undef PG8_STAGE
#undef PG8_LDA
#undef PG8_LDB
#undef PG8_MMA
#undef PG8_WAIT_V
#undef PG8_WAIT_L
#undef PG8_BAR
#undef PG8_SCHED
}
}
constexpr int D_MODEL = 4096, BATCH = 4, SEQ = 4096, T = BATCH * SEQ;
constexpr int HA = 16, HB = 16, GB = 4, RB = 4;
constexpr int D_IN = 11312, LDP = 11520, D_FF = 11008, NGU = 2 * D_FF;
constexpr int OFF_QA = 0, OFF_KA = 2048, OFF_VA = 4096, OFF_QB = 6144, OFF_KC = 8192, OFF_VC = 8704,
              OFF_KS = 9216, OFF_VS = 9728, OFF_KW = 10240, OFF_VW = 10752, OFF_GL = 11264;
constexpr int NC = 255, NS = 64, CMP_LEN = 32, CMP_STRIDE = 16, NSEL = 16, WIN = 512;
constexpr float EPS = 1e-5f;
constexpr float QSCALE = 0.08838834764831845f;
constexpr int NWAVES = 8;
#ifndef PG8_FP8_SCALE
#define PG8_FP8_SCALE 0x7F7F7F7F
#endif
#ifndef P8_SP2
#define P8_SP2 true
#endif
constexpr float WGU_SCALE = 64.f;
constexpr float WDN_SCALE = 64.f;

constexpr size_t MiB = 1u << 20;
constexpr size_t WS_CTL = 0, CTL_ZERO_BYTES = 1 * MiB;
constexpr size_t WS_WIN = 1 * MiB;
constexpr size_t WS_WOUT = 91 * MiB;
constexpr size_t WS_WGU = 123 * MiB;
constexpr size_t WS_WDN = 295 * MiB;
constexpr size_t WS_BUFA = 381 * MiB;
constexpr size_t WS_PROJ = 509 * MiB;
constexpr size_t WS_SMALL = 869 * MiB;
constexpr size_t WS_CS = WS_SMALL;
constexpr size_t WS_KCF = WS_SMALL + 1 * MiB;
constexpr size_t WS_KCB = WS_SMALL + 5 * MiB;
constexpr size_t WS_W1T = WS_SMALL + 7 * MiB;
constexpr size_t WS_BIAS1 = WS_SMALL + 9 * MiB;
constexpr size_t WS_LSE = WS_SMALL + 10 * MiB;
constexpr size_t WS_GATES = WS_SMALL + 13 * MiB;
constexpr size_t WS_ROWSQ = WS_SMALL + 16 * MiB;
constexpr size_t WS_PART = 888 * MiB;
constexpr size_t WS_END = 1016 * MiB;
static_assert(WS_WIN + (size_t)LDP * 4096 * 2 <= WS_WOUT && WS_WOUT + (size_t)4096 * 4096 * 2 <= WS_WGU && WS_WGU + (size_t)NGU * 4096 * 2 <= WS_WDN &&
              WS_WDN + (size_t)4096 * D_FF * 2 <= WS_BUFA && WS_BUFA + (size_t)T * 4096 * 2 <= WS_PROJ && WS_PROJ + (size_t)T * LDP * 2 <= WS_SMALL, "d_ws map");
constexpr int CW_TMO = 0, CW_CODE = 1;
constexpr int CW_BAR = 4096;

constexpr int RING_OFF = 0, RING_BYTES = 131072;
constexpr int LDSCTL_OFF = RING_BYTES, MISC_OFF = LDSCTL_OFF + 320;
constexpr int LDS_BYTES = 155648;

#define GAS __attribute__((address_space(1)))
#define LAS __attribute__((address_space(3)))
typedef unsigned short bf16;
typedef unsigned v4u __attribute__((ext_vector_type(4)));
typedef unsigned v2u __attribute__((ext_vector_type(2)));
typedef float f32x4 __attribute__((ext_vector_type(4)));
typedef short bf16x8 __attribute__((ext_vector_type(8)));
typedef GAS unsigned gu32;
#define RLX_AGENT __ATOMIC_RELAXED, __HIP_MEMORY_SCOPE_AGENT
#define LDS_WAIT() asm volatile("s_waitcnt lgkmcnt(0)" ::: "memory")
#define VM_WAIT() asm volatile("s_waitcnt vmcnt(0)" ::: "memory")
__device__ __forceinline__ unsigned f2bf(float f) { unsigned u = __builtin_bit_cast(unsigned, f); return (u + 0x7fffu + ((u >> 16) & 1u)) >> 16; }
__device__ __forceinline__ unsigned pk2(float lo, float hi) { return f2bf(lo) | (f2bf(hi) << 16); }
__device__ __forceinline__ float bf2f(bf16 v) { return __builtin_bit_cast(float, (unsigned)v << 16); }
#define XB_TMO      128
#define XB_XCNT(j)  (256  + 64 * (j))
#define XB_XSUB(j)  (1280 + 64 * (j))
#define XB_XGEN(j)  (2304 + 64 * (j))
#define XB_TOP      3328
#define XB_TOPGEN   3392
#define XCD_BAR_WORDS 3456
#define XB_SPIN_CAP (1u << 18)

__device__ __forceinline__ unsigned xb_ld(unsigned* p)              { return __hip_atomic_load(p, __ATOMIC_RELAXED, __HIP_MEMORY_SCOPE_AGENT); }
__device__ __forceinline__ unsigned xb_add(unsigned* p, unsigned v) { return __hip_atomic_fetch_add(p, v, __ATOMIC_RELAXED, __HIP_MEMORY_SCOPE_AGENT); }
__device__ __forceinline__ unsigned xb_xcc_id() { return (unsigned)__builtin_amdgcn_s_getreg((3 << 11) | 20) & 0xFu; }
#define XB_SPIN(cond, bar) do { unsigned _sp = 0; while (cond) { __builtin_amdgcn_s_sleep(1); \
    if ((++_sp & 255u) == 0u) { if (xb_ld(&(bar)[XB_TMO])) break; if (_sp > XB_SPIN_CAP) { atomicAdd(&(bar)[XB_TMO], 1u); break; } } } } while (0)

struct XcdBarrier {
    unsigned* bar; unsigned x;
    volatile LAS unsigned* st;
};

__device__ __forceinline__ XcdBarrier xcd_barrier_post(unsigned* bar, volatile LAS unsigned* st) {
    XcdBarrier b; b.bar = bar; b.x = xb_xcc_id(); b.st = st;
    if (threadIdx.x == 0) (void)xb_add(&bar[XB_XCNT(b.x)], 1u);
    return b;
}
__device__ __forceinline__ void xcd_barrier_complete(unsigned* bar, unsigned x, unsigned& nloc, unsigned& nx) {
    const unsigned G = gridDim.x * gridDim.y * gridDim.z;
    unsigned sum, cnt, mine, sp = 0u;
    for (;;) {
        sum = 0u; cnt = 0u; mine = 0u;
#pragma unroll
        for (unsigned j = 0; j < 16; ++j) { const unsigned c = xb_ld(&bar[XB_XCNT(j)]); sum += c; cnt += (c > 0u) ? 1u : 0u; mine = (j == x) ? c : mine; }
        if (sum == G) break;
        __builtin_amdgcn_s_sleep(1);
        if ((++sp & 255u) == 0u) { if (xb_ld(&bar[XB_TMO])) break; if (sp > XB_SPIN_CAP) { atomicAdd(&bar[XB_TMO], 1u); break; } }
    }
    nloc = mine > 0u ? mine : 1u; nx = cnt > 0u ? cnt : 1u;
}

__device__ __forceinline__ void xcd_barrier(const XcdBarrier& b) {
    asm volatile("s_waitcnt vmcnt(0)" ::: "memory");
    __syncthreads();
    if (threadIdx.x == 0) {
        unsigned* bar = b.bar;
        __builtin_amdgcn_s_waitcnt(0);
        unsigned nloc = b.st[0], nx = b.st[1];
        if (nloc == 0u) { xcd_barrier_complete(bar, b.x, nloc, nx); b.st[0] = nloc; b.st[1] = nx; }
        const unsigned old = xb_add(&bar[XB_XSUB(b.x)], 1u);
        const unsigned gen = old / nloc;
        if (old + 1u == (gen + 1u) * nloc) {
            __builtin_amdgcn_fence(__ATOMIC_RELEASE, "agent");
            asm volatile("s_waitcnt vmcnt(0)" ::: "memory");
            const unsigned og = xb_add(&bar[XB_TOP], 1u);
            const unsigned tg = og / nx;
            if (og + 1u == (tg + 1u) * nx) xb_add(&bar[XB_TOPGEN], 1u);
            else XB_SPIN(xb_ld(&bar[XB_TOPGEN]) == tg, bar);
            __builtin_amdgcn_fence(__ATOMIC_ACQUIRE, "agent");
            xb_add(&bar[XB_XGEN(b.x)], 1u);
            asm volatile("s_waitcnt vmcnt(0)" ::: "memory");
        } else {
            XB_SPIN(xb_ld(&bar[XB_XGEN(b.x)]) == gen, bar);
            __builtin_amdgcn_fence(__ATOMIC_ACQUIRE, "agent");
            asm volatile("s_waitcnt vmcnt(0)" ::: "memory");
        }
    }
    __syncthreads();
}
namespace att {
typedef float f32x16 __attribute__((ext_vector_type(16)));
typedef short s16x4 __attribute__((ext_vector_type(4)));
constexpr int SHM_T = 16384;
constexpr int A_V = 0, A_K = 4 * SHM_T;
constexpr int A_KC = 0, A_VC = 4 * SHM_T;
constexpr int A_WS = 131072 + 1024;
constexpr int A_IMP = A_WS + 2048;
constexpr int A_SEL = A_IMP + 16384;
constexpr int A_END = A_SEL + 512;
constexpr float C2 = QSCALE * 1.4426950408889634f;
constexpr float THR_RAW = 8.f / QSCALE;
#define KSWZ(row, colB) ((row) * 256 + ((colB) ^ (((row) & 7) << 4)))
__device__ __forceinline__ int crow(int r, int hi) { return (r & 3) + 8 * (r >> 2) + 4 * hi; }
__device__ __forceinline__ unsigned cvtpk(float lo, float hi) { unsigned r; asm volatile("v_cvt_pk_bf16_f32 %0, %1, %2" : "=v"(r) : "v"(lo), "v"(hi)); return r; }
__device__ __forceinline__ int v_st(int k, int c) { const int kk = (k & ~0xC) | ((k & 4) << 1) | ((k & 8) >> 1); return ((kk >> 3) * 4 + (c >> 5)) * 512 + ((kk & 7) * 32 + (c & 31)) * 2; }
__device__ __forceinline__ int v_rd_base(int lane) { return ((lane & 3) << 3) | (((lane >> 2) & 3) << 6) | (((lane >> 4) & 1) << 5) | (((lane >> 5) & 1) << 8); }
constexpr int v_rd_off(int d0, int ks, int half) { return d0 * 512 + ks * 4096 + half * 2048; }
template <int OFF> __device__ __forceinline__ s16x4 tr_read(int vb) {
    s16x4 r; asm volatile("ds_read_b64_tr_b16 %0, %1 offset:%2" : "=&v"(r) : "v"(vb), "i"(OFF) : "memory"); return r;
}
struct VFrag { s16x4 l0, h0, l1, h1, l2, h2, l3, h3; };
template <int D0> __device__ __forceinline__ void v_reads(VFrag& f, int vb) {
    f.l0 = tr_read<v_rd_off(D0, 0, 0)>(vb); f.h0 = tr_read<v_rd_off(D0, 0, 1)>(vb); f.l1 = tr_read<v_rd_off(D0, 1, 0)>(vb); f.h1 = tr_read<v_rd_off(D0, 1, 1)>(vb);
    f.l2 = tr_read<v_rd_off(D0, 2, 0)>(vb); f.h2 = tr_read<v_rd_off(D0, 2, 1)>(vb); f.l3 = tr_read<v_rd_off(D0, 3, 0)>(vb); f.h3 = tr_read<v_rd_off(D0, 3, 1)>(vb);
}
#define ATT_PK(Lx, Hx) (bf16x8){Lx[0], Lx[1], Lx[2], Lx[3], Hx[0], Hx[1], Hx[2], Hx[3]}
__device__ __forceinline__ void pv_mma(f32x16& od, const VFrag& f, bf16x8 pa0, bf16x8 pa1, bf16x8 pa2, bf16x8 pa3) {
    od = __builtin_amdgcn_mfma_f32_32x32x16_bf16(pa0, ATT_PK(f.l0, f.h0), od, 0, 0, 0);
    od = __builtin_amdgcn_mfma_f32_32x32x16_bf16(pa1, ATT_PK(f.l1, f.h1), od, 0, 0, 0);
    od = __builtin_amdgcn_mfma_f32_32x32x16_bf16(pa2, ATT_PK(f.l2, f.h2), od, 0, 0, 0);
    od = __builtin_amdgcn_mfma_f32_32x32x16_bf16(pa3, ATT_PK(f.l3, f.h3), od, 0, 0, 0);
}
__device__ __forceinline__ void pv_d0(f32x16 (&o)[4], int vb, bf16x8 pa0, bf16x8 pa1, bf16x8 pa2, bf16x8 pa3) {
    VFrag fa, fb;
    v_reads<0>(fa, vb); v_reads<1>(fb, vb);
    asm volatile("s_waitcnt lgkmcnt(8)" ::: "memory"); __builtin_amdgcn_sched_barrier(0);
    pv_mma(o[0], fa, pa0, pa1, pa2, pa3); __builtin_amdgcn_sched_barrier(0);
    v_reads<2>(fa, vb);
    asm volatile("s_waitcnt lgkmcnt(8)" ::: "memory"); __builtin_amdgcn_sched_barrier(0);
    pv_mma(o[1], fb, pa0, pa1, pa2, pa3); __builtin_amdgcn_sched_barrier(0);
    v_reads<3>(fb, vb);
    asm volatile("s_waitcnt lgkmcnt(8)" ::: "memory"); __builtin_amdgcn_sched_barrier(0);
    pv_mma(o[2], fa, pa0, pa1, pa2, pa3); __builtin_amdgcn_sched_barrier(0);
    asm volatile("s_waitcnt lgkmcnt(0)" ::: "memory"); __builtin_amdgcn_sched_barrier(0);
    pv_mma(o[3], fb, pa0, pa1, pa2, pa3);
}
#undef ATT_PK
#define ATT_KRD(B, d0) do { const int cb_ = ((d0) * 16 + hi * 8) * 2; B##0 = *(const LAS bf16x8*)(Ks + KSWZ(r32, cb_)); B##1 = *(const LAS bf16x8*)(Ks + KSWZ(32 + r32, cb_)); } while (0)
#define ATT_KMM(B, d0) do { p0 = __builtin_amdgcn_mfma_f32_32x32x16_bf16(B##0, qr[d0], p0, 0, 0, 0); p1 = __builtin_amdgcn_mfma_f32_32x32x16_bf16(B##1, qr[d0], p1, 0, 0, 0); } while (0)
__device__ __forceinline__ void qkt(f32x16& p0, f32x16& p1, const LAS unsigned char* Ks, const bf16x8 (&qr)[8], int r32, int hi) {
    bf16x8 a0, a1, b0, b1, c0, c1, e0, e1;
    ATT_KRD(a, 0); ATT_KRD(b, 1); ATT_KRD(c, 2); ATT_KRD(e, 3);
#pragma unroll
    for (int r = 0; r < 16; ++r) { p0[r] = 0.f; p1[r] = 0.f; }
    __builtin_amdgcn_sched_barrier(0);
    ATT_KMM(a, 0); ATT_KMM(b, 1); __builtin_amdgcn_sched_barrier(0);
    ATT_KRD(a, 4); ATT_KRD(b, 5); __builtin_amdgcn_sched_barrier(0);
    ATT_KMM(c, 2); ATT_KMM(e, 3); __builtin_amdgcn_sched_barrier(0);
    ATT_KRD(c, 6); ATT_KRD(e, 7); __builtin_amdgcn_sched_barrier(0);
    ATT_KMM(a, 4); ATT_KMM(b, 5); __builtin_amdgcn_sched_barrier(0);
    ATT_KMM(c, 6); ATT_KMM(e, 7);
}
#undef ATT_KRD
#undef ATT_KMM
__device__ __forceinline__ float xhalf_max(float v) { auto rr = __builtin_amdgcn_permlane32_swap(__float_as_uint(v), __float_as_uint(v), false, false); return fmaxf(__uint_as_float(rr[0]), __uint_as_float(rr[1])); }
__device__ __forceinline__ float xhalf_sum(float v) { auto rr = __builtin_amdgcn_permlane32_swap(__float_as_uint(v), __float_as_uint(v), false, false); return __uint_as_float(rr[0]) + __uint_as_float(rr[1]); }
__device__ __forceinline__ bf16x8 pks(unsigned a0, unsigned a1, unsigned b0, unsigned b1) {
    auto r0 = __builtin_amdgcn_permlane32_swap(a0, b0, false, false); auto r1 = __builtin_amdgcn_permlane32_swap(a1, b1, false, false);
    v4u w = {r0[0], r1[0], r0[1], r1[1]}; return __builtin_bit_cast(bf16x8, w);
}
__device__ __forceinline__ void softmax_tile(f32x16& p0, f32x16& p1, float& m_reg, float& l_reg, float& alpha, bf16x8& pa0, bf16x8& pa1, bf16x8& pa2, bf16x8& pa3) {
    float pmax = fmaxf(p0[0], p1[0]);
#pragma unroll
    for (int r = 1; r < 16; ++r) pmax = fmaxf(fmaxf(pmax, p0[r]), p1[r]);
    pmax = xhalf_max(pmax);
    float mn;
    if (__all(pmax - m_reg <= THR_RAW)) { mn = m_reg; alpha = 1.f; }
    else { mn = fmaxf(m_reg, pmax); alpha = __builtin_amdgcn_exp2f((m_reg - mn) * C2); m_reg = mn; }
    const float mnC = -mn * C2;
    float ps = 0.f;
#pragma unroll
    for (int r = 0; r < 16; ++r) { p0[r] = __builtin_amdgcn_exp2f(fmaf(p0[r], C2, mnC)); p1[r] = __builtin_amdgcn_exp2f(fmaf(p1[r], C2, mnC)); ps += p0[r] + p1[r]; }
    ps = xhalf_sum(ps);
    l_reg = l_reg * alpha + ps;
    pa0 = pks(cvtpk(p0[0], p0[1]), cvtpk(p0[2], p0[3]), cvtpk(p0[4], p0[5]), cvtpk(p0[6], p0[7]));
    pa1 = pks(cvtpk(p0[8], p0[9]), cvtpk(p0[10], p0[11]), cvtpk(p0[12], p0[13]), cvtpk(p0[14], p0[15]));
    pa2 = pks(cvtpk(p1[0], p1[1]), cvtpk(p1[2], p1[3]), cvtpk(p1[4], p1[5]), cvtpk(p1[6], p1[7]));
    pa3 = pks(cvtpk(p1[8], p1[9]), cvtpk(p1[10], p1[11]), cvtpk(p1[12], p1[13]), cvtpk(p1[14], p1[15]));
}
struct MaskBand { int qi, W, amin, amax;
    __device__ __forceinline__ bool interior(int t) const { return (t * 64 + 63 <= amin) && (t * 64 >= amax - W); }
    __device__ __forceinline__ void operator()(f32x16& p0, f32x16& p1, int t, int hi) const {
        const int kb = t * 64 + 4 * hi;
#pragma unroll
        for (int r = 0; r < 16; ++r) { const int k = kb + (r & 3) + 8 * (r >> 2);
            p0[r] = ((unsigned)(qi - k) <= (unsigned)W) ? p0[r] : -INFINITY; p1[r] = ((unsigned)(qi - k - 32) <= (unsigned)W) ? p1[r] : -INFINITY; }
    } };
struct NeedBand { int a, W;
    __device__ __forceinline__ bool operator()(int t) const { return (t * 64 + 63 >= a - W) && (t * 64 <= a + 31); } };
struct NeedAll { __device__ __forceinline__ bool operator()(int) const { return true; } };
struct MaskSel { unsigned mlo, mhi; int s, qb;
    __device__ __forceinline__ bool interior(int t) const { const bool bit = ((t < 32 ? (mlo >> t) : (mhi >> (t - 32))) & 1u) != 0u; return (t < qb) && (__all(bit) != 0); }
    __device__ __forceinline__ void operator()(f32x16& p0, f32x16& p1, int t, int hi) const {
        const bool bit = ((t < 32 ? (mlo >> t) : (mhi >> (t - 32))) & 1u) != 0u;
        const int kb = t * 64 + 4 * hi;
#pragma unroll
        for (int r = 0; r < 16; ++r) { const int k = kb + (r & 3) + 8 * (r >> 2);
            p0[r] = (bit && k <= s) ? p0[r] : -INFINITY; p1[r] = (bit && k + 32 <= s) ? p1[r] : -INFINITY; }
    } };
struct NeedSel { unsigned mlo, mhi;
    __device__ __forceinline__ bool operator()(int t) const { const bool bit = ((t < 32 ? (mlo >> t) : (mhi >> (t - 32))) & 1u) != 0u; return __any(bit) != 0; } };

template <class Mask, class Need>
__device__ __forceinline__ void attn_stream(LAS unsigned char* L, const bf16* Kg, const bf16* Vg, size_t stride, int t_lo, int t_hi, const bf16x8 (&qr)[8],
                                            const Mask& mask, const Need& need, f32x16 (&o)[4], float& m_reg, float& l_reg, int tid, int lane, int wave) {
    asm volatile("" : "+v"(tid), "+v"(lane));
    const int r32 = lane & 31, hi = lane >> 5;
    const bool late = wave >= 4;
    LAS float* al_l = (LAS float*)(L + A_WS + wave * 256) + 32;
    const int vb0 = (int)(unsigned)(uintptr_t)(L + A_V) + v_rd_base(lane);
    const int krow = 4 * wave + (lane >> 4), kch = (lane & 15) ^ (krow & 7);
    const int vsub = 2 * wave + hi, vkk = 8 * (vsub >> 2) + (r32 >> 2), vk = (vkk & ~0xC) | ((vkk & 4) << 1) | ((vkk & 8) >> 1);
    const bf16* kp = Kg + ((size_t)t_lo * 64 + krow) * stride + kch * 8;
    const bf16* vp = Vg + ((size_t)t_lo * 64 + vk) * stride + (vsub & 3) * 32 + (lane & 3) * 8;
    const size_t s32 = 32 * stride, s64 = 64 * stride;
#define ATT_DMA(kslot, vslot) do { \
        __builtin_amdgcn_global_load_lds((const unsigned*)kp, (LAS unsigned*)(L + A_K + (kslot) * SHM_T + wave * 1024), 16, 0, 0); \
        __builtin_amdgcn_global_load_lds((const unsigned*)(kp + s32), (LAS unsigned*)(L + A_K + (kslot) * SHM_T + 8192 + wave * 1024), 16, 0, 0); \
        __builtin_amdgcn_global_load_lds((const unsigned*)vp, (LAS unsigned*)(L + A_V + (vslot) * SHM_T + wave * 1024), 16, 0, 0); \
        __builtin_amdgcn_global_load_lds((const unsigned*)(vp + s32), (LAS unsigned*)(L + A_V + (vslot) * SHM_T + 8192 + wave * 1024), 16, 0, 0); \
        kp += s64; vp += s64; } while (0)
#define ATT_RESC() do { if (__any(alpha < 1.f)) { if (hi == 0) al_l[r32] = alpha; asm volatile("s_waitcnt lgkmcnt(0)" ::: "memory"); \
        _Pragma("unroll") for (int d = 0; d < 4; ++d) _Pragma("unroll") for (int r = 0; r < 16; ++r) o[d][r] *= al_l[crow(r, hi)]; } } while (0)
    ATT_DMA(0, 0);
    if (t_lo + 1 < t_hi) ATT_DMA(1, 1);
    int ks = 0, vs = 0, vsp = 0; bool pend = false;
    bf16x8 pa0, pa1, pa2, pa3;
    for (int t = t_lo; t < t_hi; ++t) {
        if (t + 1 < t_hi) asm volatile("s_waitcnt vmcnt(4)" ::: "memory"); else asm volatile("s_waitcnt vmcnt(0)" ::: "memory");
        __builtin_amdgcn_s_barrier();
        asm volatile("" ::: "memory");
        if (t + 2 < t_hi) { const int k2 = ks >= 1 ? ks - 1 : 2, v2 = vs >= 2 ? vs - 2 : vs + 2; ATT_DMA(k2, v2); }
        if (pend) { pv_d0(o, vb0 + vsp * SHM_T, pa0, pa1, pa2, pa3); pend = false; }
        if (need(t)) {
            f32x16 p0, p1; qkt(p0, p1, L + A_K + ks * SHM_T, qr, r32, hi);
            if (!mask.interior(t)) mask(p0, p1, t, hi);
            float alpha;
            softmax_tile(p0, p1, m_reg, l_reg, alpha, pa0, pa1, pa2, pa3);
            ATT_RESC();
            if (late) { pend = true; vsp = vs; }
            else pv_d0(o, vb0 + vs * SHM_T, pa0, pa1, pa2, pa3);
        }
        ks = ks == 2 ? 0 : ks + 1; vs = (vs + 1) & 3;
    }
    if (pend) pv_d0(o, vb0 + vsp * SHM_T, pa0, pa1, pa2, pa3);
#undef ATT_DMA
#undef ATT_RESC
    asm volatile("s_waitcnt lgkmcnt(0)" ::: "memory");
    __builtin_amdgcn_s_barrier();
}
__device__ __forceinline__ int st_img(int wave) { return wave < 4 ? 2 * SHM_T + wave * 8192 : A_K + 2 * SHM_T + (wave - 4) * 8192; }
template <class RowPtr>
__device__ __forceinline__ void store_tile(LAS unsigned char* L, const f32x16 (&o)[4], const LAS float* sc_l, const RowPtr& rowptr, int lane, int wave) {
    const int r32 = lane & 31, hi = lane >> 5, odd = lane & 1;
    LAS unsigned char* img = L + st_img(wave);
#pragma unroll
    for (int rp = 0; rp < 8; ++rp) {
        const int r = 2 * rp;
        const float s0 = sc_l[crow(r, hi)], s1 = sc_l[crow(r + 1, hi)];
        const int row = crow(r + odd, hi);
#pragma unroll
        for (int d0 = 0; d0 < 4; ++d0) {
            const float a = o[d0][r] * s0, b = o[d0][r + 1] * s1;
            const float send = odd ? a : b;
            const float recv = __shfl_xor(send, 1);
            const unsigned w = cvtpk(odd ? recv : a, odd ? b : recv);
            *(LAS unsigned*)(img + row * 256 + (((32 * d0 + (r32 & ~1)) * 2) ^ ((row & 7) << 4))) = w;
        }
    }
    asm volatile("s_waitcnt lgkmcnt(0)" ::: "memory");
#pragma unroll
    for (int i = 0; i < 8; ++i) {
        const int row = 4 * i + (lane >> 4), ch = lane & 15;
        const v4u v = *(const LAS v4u*)(img + row * 256 + ((ch * 16) ^ ((row & 7) << 4)));
        *(v4u*)(rowptr(row) + ch * 8) = v;
    }
}
template <class RowPtr>
__device__ __forceinline__ void store_tile_direct(const f32x16 (&o)[4], const LAS float* sc_l, const RowPtr& rowptr, int lane) {
    const int r32 = lane & 31, hi = lane >> 5, odd = lane & 1;
#pragma unroll
    for (int rp = 0; rp < 8; ++rp) {
        const int r = 2 * rp;
        const float s0 = sc_l[crow(r, hi)], s1 = sc_l[crow(r + 1, hi)];
        bf16* prow = rowptr(crow(r + odd, hi)) + (r32 & ~1);
#pragma unroll
        for (int d0 = 0; d0 < 4; ++d0) {
            const float a = o[d0][r] * s0, b = o[d0][r + 1] * s1;
            const float send = odd ? a : b;
            const float recv = __shfl_xor(send, 1);
            *(unsigned*)(prow + 32 * d0) = cvtpk(odd ? recv : a, odd ? b : recv);
        }
    }
}
__device__ __forceinline__ float sigmoidf_(float v) { return 1.f / (1.f + __expf(-v)); }

__device__ __forceinline__ void dilated_unit(LAS unsigned char* L, const bf16* proj, bf16* outA, float* lse, int u, int tid, int lane, int wave) {
    const int r32 = lane & 31, hi = lane >> 5;
    const int cfg = u >> 10, r = u & 1023, sh = 2 * cfg, dil = 1 << sh;
    const int b = r >> 8, h = (r >> 4) & 15, rb = r & 15, res = rb & (dil - 1), blk = rb >> sh;
    const int i0 = blk * 256, a = i0 + 32 * wave, qi = a + r32;
    const bf16* base = proj + (size_t)(b * SEQ + res) * LDP + h * 128;
    const size_t stride = (size_t)dil * LDP;
    const bf16* qrow = base + OFF_QA + (size_t)qi * stride + hi * 8;
    bf16x8 qr[8];
#pragma unroll
    for (int d0 = 0; d0 < 8; ++d0) qr[d0] = *(const bf16x8*)(qrow + d0 * 16);
    f32x16 o[4];
#pragma unroll
    for (int d = 0; d < 4; ++d)
#pragma unroll
        for (int e = 0; e < 16; ++e) o[d][e] = 0.f;
    float m_reg = -1e30f, l_reg = 0.f;
    const int t_lo = (i0 >= 128) ? (i0 - 128) >> 6 : 0, t_hi = (i0 >> 6) + 4;
    attn_stream(L, base + OFF_KA, base + OFF_VA, stride, t_lo, t_hi, qr, MaskBand{qi, 128, a, a + 31}, NeedBand{a, 128}, o, m_reg, l_reg, tid, lane, wave);
    LAS float* sc_l = (LAS float*)(L + A_WS + wave * 256);
    const int tok = qi * dil + res;
    if (hi == 0) { sc_l[r32] = 1.f / l_reg; lse[((size_t)cfg * T + (size_t)b * SEQ + tok) * 16 + h] = m_reg * QSCALE + __logf(l_reg); }
    asm volatile("s_waitcnt lgkmcnt(0)" ::: "memory");
    bf16* obase = outA + (size_t)cfg * T * 2048 + (size_t)(b * SEQ + res) * 2048 + h * 128;
    const size_t ostride = (size_t)dil * 2048;
    store_tile(L, o, sc_l, [&](int row) { return obase + (size_t)(a + row) * ostride; }, lane, wave);
}
__device__ __forceinline__ void window_unit(LAS unsigned char* L, const bf16* proj, bf16* outB, int u, int tid, int lane, int wave) {
    const int r32 = lane & 31, hi = lane >> 5;
    const int b = u >> 8, g = (u >> 6) & 3, qb = u & 63, q0 = qb * 64;
    const int head = r32 >> 3, s = q0 + 8 * wave + (r32 & 7);
    const bf16* prow = proj + (size_t)(b * SEQ + s) * LDP;
    const bf16* qrow = prow + OFF_QB + (g * 4 + head) * 128 + hi * 8;
    bf16x8 qr[8];
#pragma unroll
    for (int d0 = 0; d0 < 8; ++d0) qr[d0] = *(const bf16x8*)(qrow + d0 * 16);
    f32x16 o[4];
#pragma unroll
    for (int d = 0; d < 4; ++d)
#pragma unroll
        for (int e = 0; e < 16; ++e) o[d][e] = 0.f;
    float m_reg = -1e30f, l_reg = 0.f;
    const bf16* kvb = proj + (size_t)(b * SEQ) * LDP + g * 128;
    attn_stream(L, kvb + OFF_KW, kvb + OFF_VW, (size_t)LDP, qb >= 8 ? qb - 8 : 0, qb + 1, qr, MaskBand{s, WIN - 1, q0 + 8 * wave, q0 + 8 * wave + 7}, NeedAll{}, o, m_reg, l_reg, tid, lane, wave);
    LAS float* sc_l = (LAS float*)(L + A_WS + wave * 256);
    if (hi == 0) sc_l[r32] = 1.f / l_reg;
    asm volatile("s_waitcnt lgkmcnt(0)" ::: "memory");
    bf16* obase = outB + (size_t)(b * SEQ + q0 + 8 * wave) * 2048 + g * 512;
    store_tile(L, o, sc_l, [&](int row) { return obase + (size_t)(row & 7) * 2048 + (row >> 3) * 128; }, lane, wave);
}
__device__ __forceinline__ bf16x8 hfrag(int c0, int j) {
    bf16x8 f; const int d = c0 - 4 * j;
#pragma unroll
    for (int jj = 0; jj < 8; ++jj) f[jj] = ((unsigned)(d + jj + 1) <= 4u) ? (short)0x3F80 : (short)0;
    return f;
}
__device__ __forceinline__ void nsa_unit(LAS unsigned char* L, const bf16* proj, const bf16* kc, const bf16* vc, bf16* outC, bf16* outS, int b, int g, int qb, int tid, int lane, int wave) {
    const int r32 = lane & 31, hi = lane >> 5;
    const int q0 = qb * 64, head = r32 >> 3, s = q0 + 8 * wave + (r32 & 7);
    const bf16* prow = proj + (size_t)(b * SEQ + s) * LDP;
    const bf16* qrow = prow + OFF_QB + (g * 4 + head) * 128 + hi * 8;
    bf16x8 qr[8];
#pragma unroll
    for (int d0 = 0; d0 < 8; ++d0) qr[d0] = *(const bf16x8*)(qrow + d0 * 16);
    {
        int tid_ = tid; asm volatile("" : "+v"(tid_));
        const int sr = tid_ >> 4, sc = (tid_ & 15) * 8;
        const bf16* kcb = kc + (size_t)(b * GB + g) * 256 * 128 + (size_t)sr * 128 + sc; const bf16* vcb = vc + (size_t)(b * GB + g) * 256 * 128 + (size_t)sr * 128 + sc;
#pragma unroll
        for (int tc = 0; tc < 4; ++tc) {
            const bf16x8 k0 = *(const bf16x8*)(kcb + tc * 8192), k1 = *(const bf16x8*)(kcb + tc * 8192 + 4096), v0 = *(const bf16x8*)(vcb + tc * 8192), v1 = *(const bf16x8*)(vcb + tc * 8192 + 4096);
            *(LAS bf16x8*)(L + A_KC + tc * SHM_T + KSWZ(sr, sc * 2)) = k0; *(LAS bf16x8*)(L + A_KC + tc * SHM_T + KSWZ(32 + sr, sc * 2)) = k1;
            *(LAS bf16x8*)(L + A_VC + tc * SHM_T + v_st(sr, sc)) = v0; *(LAS bf16x8*)(L + A_VC + tc * SHM_T + v_st(32 + sr, sc)) = v1;
        }
    }
    __syncthreads();
    LAS float* impw = (LAS float*)(L + A_IMP) + wave * 512;
    LAS float* sc_l = (LAS float*)(L + A_WS + wave * 256);
    f32x16 o[4];
    float m = -1e30f, l = 0.f;
#pragma unroll 1
    for (int tc = 0; tc < 4; ++tc) {
        f32x16 p0, p1; qkt(p0, p1, L + A_KC + tc * SHM_T, qr, r32, hi);
        const int kb = tc * 64 + 4 * hi; float pmax = -INFINITY;
#pragma unroll
        for (int r = 0; r < 16; ++r) { const int c = kb + (r & 3) + 8 * (r >> 2);
            p0[r] = (16 * c + 31 <= s) ? p0[r] : -INFINITY; p1[r] = (16 * (c + 32) + 31 <= s) ? p1[r] : -INFINITY; pmax = fmaxf(pmax, fmaxf(p0[r], p1[r])); }
        pmax = xhalf_max(pmax);
        const float mn = fmaxf(m, pmax), alpha = __builtin_amdgcn_exp2f((m - mn) * C2), mnC = -mn * C2; m = mn;
        float ps = 0.f;
#pragma unroll
        for (int r = 0; r < 16; ++r) ps += __builtin_amdgcn_exp2f(fmaf(p0[r], C2, mnC)) + __builtin_amdgcn_exp2f(fmaf(p1[r], C2, mnC));
        l = l * alpha + xhalf_sum(ps);
    }
    const float inv_l = l > 0.f ? 1.f / l : 0.f, mC = -m * C2;
#ifndef T_NOPASS2
    {
        f32x16 imp0, imp1;
#pragma unroll
        for (int e = 0; e < 16; ++e) { imp0[e] = 0.f; imp1[e] = 0.f; }
#pragma unroll 1
        for (int tc = 0; tc < 4; ++tc) {
            f32x16 p0, p1; qkt(p0, p1, L + A_KC + tc * SHM_T, qr, r32, hi);
            const int kb = tc * 64 + 4 * hi;
#pragma unroll
            for (int r = 0; r < 16; ++r) { const int c = kb + (r & 3) + 8 * (r >> 2);
                p0[r] = (16 * c + 31 <= s) ? __builtin_amdgcn_exp2f(fmaf(p0[r], C2, mC)) * inv_l : 0.f;
                p1[r] = (16 * (c + 32) + 31 <= s) ? __builtin_amdgcn_exp2f(fmaf(p1[r], C2, mC)) * inv_l : 0.f; }
#pragma unroll
            for (int ks = 0; ks < 4; ++ks) {
                unsigned hh[4], ll[4];
#pragma unroll
                for (int i = 0; i < 4; ++i) { const int r = 8 * (ks & 1) + 2 * i; const float a = (ks < 2) ? p0[r] : p1[r], bq = (ks < 2) ? p0[r + 1] : p1[r + 1];
                    hh[i] = cvtpk(a, bq); ll[i] = cvtpk(a - __uint_as_float(hh[i] << 16), bq - __uint_as_float(hh[i] & 0xffff0000u)); }
                const bf16x8 pah = pks(hh[0], hh[1], hh[2], hh[3]), pal = pks(ll[0], ll[1], ll[2], ll[3]);
                int jv = r32; asm volatile("" : "+v"(jv));
                const int c0 = tc * 64 + ks * 16 + 8 * hi;
                if (tc <= 1) { const bf16x8 hf = hfrag(c0, jv); imp0 = __builtin_amdgcn_mfma_f32_32x32x16_bf16(pah, hf, imp0, 0, 0, 0); imp0 = __builtin_amdgcn_mfma_f32_32x32x16_bf16(pal, hf, imp0, 0, 0, 0); }
                if (tc >= 1) { const bf16x8 hf = hfrag(c0, 32 + jv); imp1 = __builtin_amdgcn_mfma_f32_32x32x16_bf16(pah, hf, imp1, 0, 0, 0); imp1 = __builtin_amdgcn_mfma_f32_32x32x16_bf16(pal, hf, imp1, 0, 0, 0); }
            }
        }
        LAS float* impw0 = (LAS float*)(L + A_IMP) + wave * 512;
#pragma unroll
        for (int e = 0; e < 4; ++e) {
            impw0[(e + 4 * hi) * 64 + r32] = (imp0[e] + imp0[4 + e]) + (imp0[8 + e] + imp0[12 + e]);
            impw0[(e + 4 * hi) * 64 + 32 + r32] = (imp1[e] + imp1[4 + e]) + (imp1[8 + e] + imp1[12 + e]);
        }
    }
#endif
#pragma unroll
    for (int e = 0; e < 16; ++e) { o[0][e] = 0.f; o[1][e] = 0.f; o[2][e] = 0.f; o[3][e] = 0.f; }
    const int vbc = (int)(unsigned)(uintptr_t)(L + A_VC) + v_rd_base(lane);
#pragma unroll 1
    for (int tc = 0; tc < 4; ++tc) {
        f32x16 p0, p1; qkt(p0, p1, L + A_KC + tc * SHM_T, qr, r32, hi);
        const int kb = tc * 64 + 4 * hi;
#pragma unroll
        for (int r = 0; r < 16; ++r) { const int c = kb + (r & 3) + 8 * (r >> 2);
            p0[r] = (16 * c + 31 <= s) ? __builtin_amdgcn_exp2f(fmaf(p0[r], C2, mC)) * inv_l : 0.f;
            p1[r] = (16 * (c + 32) + 31 <= s) ? __builtin_amdgcn_exp2f(fmaf(p1[r], C2, mC)) * inv_l : 0.f; }
        const bf16x8 pa0 = pks(cvtpk(p0[0], p0[1]), cvtpk(p0[2], p0[3]), cvtpk(p0[4], p0[5]), cvtpk(p0[6], p0[7]));
        const bf16x8 pa1 = pks(cvtpk(p0[8], p0[9]), cvtpk(p0[10], p0[11]), cvtpk(p0[12], p0[13]), cvtpk(p0[14], p0[15]));
        const bf16x8 pa2 = pks(cvtpk(p1[0], p1[1]), cvtpk(p1[2], p1[3]), cvtpk(p1[4], p1[5]), cvtpk(p1[6], p1[7]));
        const bf16x8 pa3 = pks(cvtpk(p1[8], p1[9]), cvtpk(p1[10], p1[11]), cvtpk(p1[12], p1[13]), cvtpk(p1[14], p1[15]));
        pv_d0(o, vbc + tc * SHM_T, pa0, pa1, pa2, pa3);
    }
    if (hi == 0) sc_l[r32] = 1.f;
    asm volatile("s_waitcnt lgkmcnt(0)" ::: "memory");
    {
        bf16* obase = outC + (size_t)(b * SEQ + q0 + 8 * wave) * 2048 + g * 512;
        store_tile_direct(o, sc_l, [&](int row) { return obase + (size_t)(row & 7) * 2048 + (row >> 3) * 128; }, lane);
    }
    LAS unsigned* selw = (LAS unsigned*)(L + A_SEL) + wave * 16;
    for (int qi = 0; qi < 8; ++qi) {
        const int sq = q0 + 8 * wave + qi, j = lane;
        const float iv = impw[qi * 64 + lane];
        const bool forced = (j == 0) || (j == qb) || (j == qb - 1);
        const bool valid = (j * 64 <= sq);
        const float score = forced ? 1e6f : (valid ? iv : -INFINITY);
        int rank = 0;
#pragma unroll 8
        for (int jj = 0; jj < 64; ++jj) { const float os = __uint_as_float(__builtin_amdgcn_readlane(__float_as_uint(score), jj)); rank += (os > score || (os == score && jj < j)) ? 1 : 0; }
        const bool sel = (rank < NSEL) && (score != -INFINITY);
        const unsigned long long mk = __ballot(sel);
        if (lane == 0) { selw[2 * qi] = (unsigned)mk; selw[2 * qi + 1] = (unsigned)(mk >> 32); }
    }
    asm volatile("s_waitcnt lgkmcnt(0)" ::: "memory");
    const unsigned mlo = selw[2 * (r32 & 7)], mhi = selw[2 * (r32 & 7) + 1];
    __syncthreads();
#pragma unroll
    for (int d = 0; d < 4; ++d)
#pragma unroll
        for (int e = 0; e < 16; ++e) o[d][e] = 0.f;
    float m_reg = -1e30f, l_reg = 0.f;
    const bf16* kvb = proj + (size_t)(b * SEQ) * LDP + g * 128;
    attn_stream(L, kvb + OFF_KS, kvb + OFF_VS, (size_t)LDP, 0, qb + 1, qr, MaskSel{mlo, mhi, s, qb}, NeedSel{mlo, mhi}, o, m_reg, l_reg, tid, lane, wave);
    if (hi == 0) sc_l[r32] = 1.f / l_reg;
    asm volatile("s_waitcnt lgkmcnt(0)" ::: "memory");
    {
        bf16* obase = outS + (size_t)(b * SEQ + q0 + 8 * wave) * 2048 + g * 512;
        store_tile_direct(o, sc_l, [&](int row) { return obase + (size_t)(row & 7) * 2048 + (row >> 3) * 128; }, lane);
    }
}
__device__ __forceinline__ void compress_unit(LAS unsigned char* L, const bf16* proj, int coloff, const bf16* W1T, const float* bias1, const float* w2, bf16* outkc,
                                              int b, int g, int cblk, int tid, int lane, int wave) {
    const int r32 = lane & 31, hi = lane >> 5, n = wave & 3, th = wave >> 2;
    const int tokbase = 16 * (32 * cblk + r32);
    f32x16 acc;
#pragma unroll
    for (int e = 0; e < 16; ++e) acc[e] = 0.f;
    const bf16* arow = proj + (size_t)(b * SEQ) * LDP + coloff + g * 128 + hi * 8;
    const bf16* brow = W1T + (size_t)(32 * n + r32) * 4096 + hi * 8;
#pragma unroll 2
    for (int t = 16 * th; t < 16 * th + 16; ++t) {
        int tok = tokbase + t; tok = tok < SEQ ? tok : SEQ - 1;
        const bf16* ap = arow + (size_t)tok * LDP; const bf16* bp = brow + t * 128;
#pragma unroll
        for (int ks = 0; ks < 8; ++ks) acc = __builtin_amdgcn_mfma_f32_32x32x16_bf16(*(const bf16x8*)(ap + 16 * ks), *(const bf16x8*)(bp + 16 * ks), acc, 0, 0, 0);
    }
    LAS float* part = (LAS float*)L + th * 4096;
#pragma unroll
    for (int r = 0; r < 16; ++r) part[crow(r, hi) * 128 + 32 * n + r32] = acc[r];
    __syncthreads();
    LAS float* hid = (LAS float*)L + 8192;
    for (int e = tid; e < 4096; e += NWAVES * 64) { const float v = ((LAS float*)L)[e] + ((LAS float*)L)[4096 + e] + bias1[e & 127];
        const float uu = 0.7978845608028654f * (v + 0.044715f * v * v * v); hid[e] = 0.5f * v * (1.f + tanhf(uu)); }
    __syncthreads();
    const int j2 = tid & 127, cg = tid >> 7;
    float oacc[8];
#pragma unroll
    for (int k = 0; k < 8; ++k) oacc[k] = 0.f;
#pragma unroll 16
    for (int j = 0; j < 128; ++j) { const float w = w2[j * 128 + j2];
#pragma unroll
        for (int k = 0; k < 8; ++k) oacc[k] += hid[(cg * 8 + k) * 128 + j] * w; }
#pragma unroll
    for (int k = 0; k < 8; ++k) { const int c = 32 * cblk + cg * 8 + k; outkc[((size_t)(b * GB + g) * 256 + c) * 128 + j2] = (c < NC) ? (bf16)f2bf(oacc[k]) : (bf16)0; }
    __syncthreads();
}
__device__ __forceinline__ void gate_unit(LAS unsigned char* L, const bf16* h, const bf16* Wg, const float* rowsq0, float* gates, int row0, int tid, int lane, int wave) {
    const int r32 = lane & 31, hi = lane >> 5, rt = wave & 1, kq = wave >> 1;
    f32x16 acc0, acc1;
#pragma unroll
    for (int e = 0; e < 16; ++e) { acc0[e] = 0.f; acc1[e] = 0.f; }
    const bf16* ap = h + (size_t)(row0 + 32 * rt + r32) * D_MODEL + kq * 1024 + hi * 8;
    const bf16* bp0 = Wg + (size_t)r32 * D_MODEL + kq * 1024 + hi * 8; const bf16* bp1 = bp0 + (size_t)32 * D_MODEL;
#pragma unroll 8
    for (int ks = 0; ks < 64; ++ks) {
        const bf16x8 a = *(const bf16x8*)(ap + 16 * ks), b0 = *(const bf16x8*)(bp0 + 16 * ks), b1 = *(const bf16x8*)(bp1 + 16 * ks);
        acc0 = __builtin_amdgcn_mfma_f32_32x32x16_bf16(a, b0, acc0, 0, 0, 0); acc1 = __builtin_amdgcn_mfma_f32_32x32x16_bf16(a, b1, acc1, 0, 0, 0);
    }
    LAS float* part = (LAS float*)L + wave * 2048;
#pragma unroll
    for (int r = 0; r < 16; ++r) { part[crow(r, hi) * 64 + r32] = acc0[r]; part[crow(r, hi) * 64 + 32 + r32] = acc1[r]; }
    __syncthreads();
    for (int e = tid; e < 64 * 48; e += NWAVES * 64) { const int row = e / 48, col = e % 48, rtt = row >> 5, rr = row & 31;
        const LAS float* p = (const LAS float*)L + rtt * 2048 + rr * 64 + col;
        const float v = (p[0] + p[2 * 2048]) + (p[4 * 2048] + p[6 * 2048]);
        gates[(size_t)(row0 + row) * 48 + col] = sigmoidf_(v / sqrtf(rowsq0[row0 + row] * (1.f / 4096.f) + EPS)); }
    __syncthreads();
}
}
__device__ __forceinline__ float wave_sum(float v) {
#pragma unroll
    for (int o = 1; o < 64; o <<= 1) v += __shfl_xor(v, o);
    return v;
}
__device__ __forceinline__ float wave_max(float v) {
#pragma unroll
    for (int o = 1; o < 64; o <<= 1) v = fmaxf(v, __shfl_xor(v, o));
    return v;
}
__device__ __forceinline__ void p0_transpose_item(const float* W, int N, int nvalid, bf16* WT, size_t ldt, int k0, int n0, int drow0, LAS float* scr, int lane, const float* kgain = nullptr, float fp8scale = 0.f) {
    const int rr = lane >> 3, c4 = lane & 7, nn = n0 + 4 * c4; const bool ok = nn < nvalid;
    const GAS f32x4* src = (const GAS f32x4*)(W + (size_t)(k0 + rr) * N + nn);
    f32x4 v[8];
#pragma unroll
    for (int i = 0; i < 8; ++i) v[i] = ok ? src[(size_t)i * 2 * N] : (f32x4){0.f, 0.f, 0.f, 0.f};
#pragma unroll
    for (int i = 0; i < 8; ++i) { LAS float* d = scr + (8 * i + rr) * 33 + 4 * c4; const float gk = kgain ? kgain[k0 + 8 * i + rr] : 1.f; d[0] = v[i].x * gk; d[1] = v[i].y * gk; d[2] = v[i].z * gk; d[3] = v[i].w * gk; }
    LDS_WAIT(); asm volatile("" ::: "memory");
    const int c = lane & 7;
#pragma unroll
    for (int j = 0; j < 4; ++j) { const int n = (lane >> 3) + 8 * j; const LAS float* s = scr + (8 * c) * 33 + n;
        if (fp8scale != 0.f) {
            int w0 = __builtin_amdgcn_cvt_pk_fp8_f32(s[0 * 33] * fp8scale, s[1 * 33] * fp8scale, 0, false); w0 = __builtin_amdgcn_cvt_pk_fp8_f32(s[2 * 33] * fp8scale, s[3 * 33] * fp8scale, w0, true);
            int w1 = __builtin_amdgcn_cvt_pk_fp8_f32(s[4 * 33] * fp8scale, s[5 * 33] * fp8scale, 0, false); w1 = __builtin_amdgcn_cvt_pk_fp8_f32(s[6 * 33] * fp8scale, s[7 * 33] * fp8scale, w1, true);
            *(GAS v2u*)((GAS unsigned char*)WT + (size_t)(drow0 + n) * ldt + k0 + 8 * c) = (v2u){(unsigned)w0, (unsigned)w1};
        } else {
        v4u o; o.x = pk2(s[0 * 33], s[1 * 33]); o.y = pk2(s[2 * 33], s[3 * 33]); o.z = pk2(s[4 * 33], s[5 * 33]); o.w = pk2(s[6 * 33], s[7 * 33]);
        *(GAS v4u*)(WT + (size_t)(drow0 + n) * ldt + k0 + 8 * c) = o; } }
    LDS_WAIT(); asm volatile("" ::: "memory");
}
__device__ __forceinline__ void row_to_bf16_sumsq(const float* xrow, bf16* orow, float* sumsq, int lane) {
    const GAS f32x4* xr = (const GAS f32x4*)xrow + lane;
    f32x4 v[16]; float s = 0.f;
#pragma unroll
    for (int j = 0; j < 16; ++j) { v[j] = xr[64 * j]; s += (v[j].x * v[j].x + v[j].y * v[j].y) + (v[j].z * v[j].z + v[j].w * v[j].w); }
    s = wave_sum(s);
    if (lane == 0) *sumsq = s;
    GAS v2u* o8 = (GAS v2u*)orow + lane;
#pragma unroll
    for (int j = 0; j < 16; ++j) { v2u w; w.x = pk2(v[j].x, v[j].y); w.y = pk2(v[j].z, v[j].w); o8[64 * j] = w; }
}
__device__ __forceinline__ void rms_row_inplace(float* xrow, const float* g, int lane) {
    GAS f32x4* xr = (GAS f32x4*)xrow + lane; const GAS f32x4* gr = (const GAS f32x4*)g + lane;
    f32x4 v[16]; float s = 0.f;
#pragma unroll
    for (int j = 0; j < 16; ++j) { v[j] = xr[64 * j]; s += (v[j].x * v[j].x + v[j].y * v[j].y) + (v[j].z * v[j].z + v[j].w * v[j].w); }
    const float rs = 1.f / sqrtf(wave_sum(s) * (1.f / 4096.f) + EPS);
#pragma unroll
    for (int j = 0; j < 16; ++j) { const f32x4 gg = gr[64 * j]; xr[64 * j] = v[j] * rs * gg; }
}

struct Args { const float* in[17]; float* out; unsigned char* ws; float inv[16]; int ph_lo, ph_hi, li, pad; };
constexpr int N_PHASES = 10;
__global__ void __launch_bounds__(NWAVES * 64, 2) mega(Args args) {
    extern __shared__ __attribute__((aligned(16))) unsigned char lds[];
    LAS unsigned char* L = (LAS unsigned char*)lds;
    volatile LAS unsigned* MISC = (volatile LAS unsigned*)(L + MISC_OFF);
    const int tid = threadIdx.x, lane = tid & 63, wave = __builtin_amdgcn_readfirstlane(tid >> 6);
    const int G = gridDim.x;
    unsigned char* ws = args.ws;
    gu32* ctl = (gu32*)(ws + WS_CTL);
    const float* x = args.in[0]; const float* norm_attn = args.in[1]; const float* w_in = args.in[2];
    const float* w_out = args.in[11]; const float* norm_ffn = args.in[12]; const float* w_gate = args.in[13]; const float* w_up = args.in[14]; const float* w_down = args.in[15];
    const float* norm_final = args.in[16];
    float* out = args.out;
    bf16* Win_t = (bf16*)(ws + WS_WIN); bf16* Wout_t = (bf16*)(ws + WS_WOUT); bf16* Wgu_t = (bf16*)(ws + WS_WGU); bf16* Wdn_t = (bf16*)(ws + WS_WDN);
    bf16* bufA = (bf16*)(ws + WS_BUFA); bf16* proj = (bf16*)(ws + WS_PROJ); bf16* mixed = proj; bf16* act = proj;
    float* cs = (float*)(ws + WS_CS);
    const float* ck_pe = args.in[3]; const float* ck_w1 = args.in[4]; const float* ck_w2 = args.in[5];
    const float* cv_pe = args.in[6]; const float* cv_w1 = args.in[7]; const float* cv_w2 = args.in[8];
    const float* out_norm_a = args.in[9]; const float* out_norm_b = args.in[10];
    bf16* kcb = (bf16*)(ws + WS_KCB); bf16* vcb = (bf16*)(ws + WS_KCB + 1 * MiB);
    bf16* ckW1T = (bf16*)(ws + WS_W1T); bf16* cvW1T = (bf16*)(ws + WS_W1T + 1 * MiB);
    float* bias1 = (float*)(ws + WS_BIAS1); float* lse = (float*)(ws + WS_LSE);
    bf16* partA = (bf16*)out;
    bf16* partC = (bf16*)out + (size_t)3 * T * 2048;
    bf16* partS = (bf16*)(ws + WS_PART); bf16* partW = partS + (size_t)T * 2048;
    unsigned char* x1f8 = ws + WS_PART;
    float* rowsq = (float*)(ws + WS_ROWSQ);
    float* gates = (float*)(ws + WS_GATES);
    for (int u = tid; u < (LDS_BYTES - LDSCTL_OFF) / 4; u += NWAVES * 64) ((LAS unsigned*)(L + LDSCTL_OFF))[u] = 0u;
    __syncthreads();
    const int lo = args.ph_lo, hi = args.ph_hi;
    const bool one_launch = (hi - lo) > 1;
    XcdBarrier bar; bar.bar = (unsigned*)(ctl + CW_BAR) + args.li * XCD_BAR_WORDS; bar.x = 0; bar.st = nullptr;
    if (one_launch) bar = xcd_barrier_post((unsigned*)(ctl + CW_BAR) + args.li * XCD_BAR_WORDS, MISC + 8);
#ifndef MK_PH
#define MK_PH 0x3ff
#endif
#define IN(k) ((((MK_PH) >> (k)) & 1) && lo <= (k) && (k) < hi)
#define BOTH(k) (IN(k) && IN((k) + 1))
    const int gw = blockIdx.x * NWAVES + wave, NGW = G * NWAVES;

    if (IN(0)) {
        LAS float* scr = (LAS float*)(L + RING_OFF + wave * 16384);
        constexpr int I_IN = 64 * 360, I_OUT = 64 * 128, I_G = 64 * 344, I_D = 172 * 128, I_W1 = 64 * 4;
        constexpr int NITEMS = I_IN + I_OUT + 2 * I_G + I_D + 2 * I_W1;
        for (int it = gw; it < NITEMS; it += NGW) {
            int r = it;
            if (r < I_IN) { const int kb = r / 360, nb = r % 360; p0_transpose_item(w_in, D_IN, D_IN, Win_t, 4096, 64 * kb, 32 * nb, 32 * nb, scr, lane, norm_attn); continue; } r -= I_IN;
            if (r < I_OUT) { const int kb = r / 128, nb = r % 128; p0_transpose_item(w_out, 4096, 4096, Wout_t, 4096, 64 * kb, 32 * nb, 32 * nb, scr, lane); continue; } r -= I_OUT;
            if (r < I_G) { const int kb = r / 344, nb = r % 344, n0 = 32 * nb; p0_transpose_item(w_gate, D_FF, D_FF, Wgu_t, 4096, 64 * kb, n0, 256 * (n0 >> 7) + (n0 & 127), scr, lane, norm_ffn, WGU_SCALE); continue; } r -= I_G;
            if (r < I_G) { const int kb = r / 344, nb = r % 344, n0 = 32 * nb; p0_transpose_item(w_up, D_FF, D_FF, Wgu_t, 4096, 64 * kb, n0, 256 * (n0 >> 7) + 128 + (n0 & 127), scr, lane, norm_ffn, WGU_SCALE); continue; } r -= I_G;
            if (r < I_D) { const int kb = r / 128, nb = r % 128; p0_transpose_item(w_down, 4096, 4096, Wdn_t, D_FF, 64 * kb, 32 * nb, 32 * nb, scr, lane, nullptr, WDN_SCALE); continue; } r -= I_D;
            if (r < I_W1) { const int kb = r / 4, nb = r % 4; p0_transpose_item(ck_w1, 128, 128, ckW1T, 4096, 64 * kb, 32 * nb, 32 * nb, scr, lane); continue; } r -= I_W1;
            { const int kb = r / 4, nb = r % 4; p0_transpose_item(cv_w1, 128, 128, cvW1T, 4096, 64 * kb, 32 * nb, 32 * nb, scr, lane); }
        }
        for (int o = gw; o < 256; o += NGW) {
            const int which = o >> 7, j = o & 127; const float* pe = which ? cv_pe : ck_pe; const float* w1 = which ? cv_w1 : ck_w1;
            float a = 0.f;
            for (int i = lane; i < 4096; i += 64) a += pe[i] * w1[(size_t)i * 128 + j];
            a = wave_sum(a);
            if (lane == 0) bias1[o] = a;
        }
        for (int idx = blockIdx.x * (NWAVES * 64) + tid; idx < SEQ * 16; idx += G * NWAVES * 64) {
            const int s = idx >> 4, i = idx & 15; const float ang = (float)s * args.inv[i]; const double a = (double)ang;
            cs[2 * idx] = (float)cos(a); cs[2 * idx + 1] = (float)sin(a);
        }
        for (int m = gw; m < T; m += NGW) row_to_bf16_sumsq(x + (size_t)m * D_MODEL, bufA + (size_t)m * D_MODEL, rowsq + 2 * T + m, lane);
        for (int i = blockIdx.x * (NWAVES * 64) + tid; i < 2 * T; i += G * NWAVES * 64) rowsq[i] = 0.f;
        if (BOTH(0)) xcd_barrier(bar);
    }
    if (IN(1)) {
        pg8::Gemm g{bufA, Win_t, T, OFF_GL, D_MODEL}; pg8::StaticOrder S; S.init(T, OFF_GL, G, (int)blockIdx.x);
        pg8::EpiProj E{proj, LDP, cs, rowsq + 2 * T, 1.f / 4096.f, EPS};
        pg8::gemm_phase<pg8::EpiProj, pg8::StaticOrder, true, true>(L + RING_OFF, g, S, E);
        if (BOTH(1)) xcd_barrier(bar);
    }
    if (IN(2)) {
        for (int cu = blockIdx.x; cu < 256; cu += G) { const int which = cu >> 7, r = cu & 127;
            att::compress_unit(L, proj, which ? OFF_VC : OFF_KC, which ? cvW1T : ckW1T, bias1 + which * 128, which ? cv_w2 : ck_w2, which ? vcb : kcb, r >> 5, (r >> 3) & 3, r & 7, tid, lane, wave); }
        for (int u = blockIdx.x; u < T / 64; u += G) att::gate_unit(L, bufA, Win_t + (size_t)OFF_GL * D_MODEL, rowsq + 2 * T, gates, 64 * u, tid, lane, wave);
        for (int u = blockIdx.x; u < 1024; u += G) att::window_unit(L, proj, partW, u, tid, lane, wave);
        for (int u = blockIdx.x; u < 3072; u += G) att::dilated_unit(L, proj, partA, lse, u, tid, lane, wave);
        if (BOTH(2)) xcd_barrier(bar);
    }
    if (IN(3)) {
        for (int rd = 0; rd * G < 1024; ++rd) {
            const int idx = (rd & 1) ? rd * G + (G - 1 - (int)blockIdx.x) : rd * G + (int)blockIdx.x;
            if (idx < 1024) { const int qb = 63 - (idx >> 4), bg = idx & 15; att::nsa_unit(L, proj, kcb, vcb, partC, partS, bg >> 2, bg & 3, qb, tid, lane, wave); }
        }
        if (BOTH(3)) xcd_barrier(bar);
    }
    if (IN(4)) {
        for (int it = gw; it < 2 * T; it += NGW) {
            const int m = it >> 1, grp = it & 1;
            float ov[32]; float ss = 0.f;
            if (grp == 0) {
#pragma unroll
                for (int k = 0; k < 4; ++k) {
                    const int ch = lane + 64 * k, head = ch >> 4;
                    const float l0 = lse[((size_t)0 * T + m) * 16 + head], l1 = lse[((size_t)1 * T + m) * 16 + head], l2 = lse[((size_t)2 * T + m) * 16 + head];
                    const float mx = fmaxf(l0, fmaxf(l1, l2)); const float e0 = __expf(l0 - mx), e1 = __expf(l1 - mx), e2 = __expf(l2 - mx); const float inv = 1.f / (e0 + e1 + e2);
                    const float w0 = e0 * inv, w1 = e1 * inv, w2 = e2 * inv;
                    const size_t off = (size_t)m * 2048 + 8 * ch;
                    const v4u x0 = *(const v4u*)(partA + off), x1 = *(const v4u*)(partA + (size_t)T * 2048 + off), x2 = *(const v4u*)(partA + (size_t)2 * T * 2048 + off);
#pragma unroll
                    for (int e = 0; e < 4; ++e) {
                        const float alo = w0 * __uint_as_float(x0[e] << 16) + w1 * __uint_as_float(x1[e] << 16) + w2 * __uint_as_float(x2[e] << 16);
                        const float ahi = w0 * __uint_as_float(x0[e] & 0xffff0000u) + w1 * __uint_as_float(x1[e] & 0xffff0000u) + w2 * __uint_as_float(x2[e] & 0xffff0000u);
                        ov[8 * k + 2 * e] = alo; ov[8 * k + 2 * e + 1] = ahi; ss += alo * alo + ahi * ahi;
                    }
                }
            } else {
#pragma unroll
                for (int k = 0; k < 4; ++k) {
                    const int ch = lane + 64 * k, head = ch >> 4;
                    const size_t off = (size_t)m * 2048 + 8 * ch;
                    const float gc = gates[(size_t)m * 48 + head * 3], gs = gates[(size_t)m * 48 + head * 3 + 1], gw_ = gates[(size_t)m * 48 + head * 3 + 2];
                    const v4u y0 = *(const v4u*)(partC + off), y1 = *(const v4u*)(partS + off), y2 = *(const v4u*)(partW + off);
#pragma unroll
                    for (int e = 0; e < 4; ++e) {
                        const float blo = gc * __uint_as_float(y0[e] << 16) + gs * __uint_as_float(y1[e] << 16) + gw_ * __uint_as_float(y2[e] << 16);
                        const float bhi = gc * __uint_as_float(y0[e] & 0xffff0000u) + gs * __uint_as_float(y1[e] & 0xffff0000u) + gw_ * __uint_as_float(y2[e] & 0xffff0000u);
                        ov[8 * k + 2 * e] = blo; ov[8 * k + 2 * e + 1] = bhi; ss += blo * blo + bhi * bhi;
                    }
                }
            }
            const float rs = 1.f / sqrtf(wave_sum(ss) * (1.f / 2048.f) + EPS);
            const float* gn = grp ? out_norm_b : out_norm_a;
#pragma unroll
            for (int k = 0; k < 4; ++k) {
                const int ch = lane + 64 * k;
                const f32x4 g0 = *(const f32x4*)(gn + 8 * ch), g1 = *(const f32x4*)(gn + 8 * ch + 4);
                v4u w;
                w.x = pk2(ov[8 * k + 0] * rs * g0.x, ov[8 * k + 1] * rs * g0.y); w.y = pk2(ov[8 * k + 2] * rs * g0.z, ov[8 * k + 3] * rs * g0.w);
                w.z = pk2(ov[8 * k + 4] * rs * g1.x, ov[8 * k + 5] * rs * g1.y); w.w = pk2(ov[8 * k + 6] * rs * g1.z, ov[8 * k + 7] * rs * g1.w);
                *(v4u*)(mixed + (size_t)m * D_MODEL + grp * 2048 + 8 * ch) = w;
            }
        }
        if (BOTH(4)) xcd_barrier(bar);
    }

    if (IN(5)) {
        pg8::Gemm g{mixed, Wout_t, T, D_MODEL, D_MODEL}; pg8::StaticOrder S; S.init(T, D_MODEL, G, (int)blockIdx.x);
        pg8::EpiResid<true> E{bufA, bufA, rowsq, x1f8, D_MODEL, 1.f};
        pg8::gemm_phase<pg8::EpiResid<true>, pg8::StaticOrder, true, true>(L + RING_OFF, g, S, E);
        if (IN(7)) xcd_barrier(bar);
    }
    if (IN(7)) {
        pg8::Gemm g{(const bf16*)x1f8, Wgu_t, T, NGU, D_MODEL / 2}; pg8::StaticOrder S; S.init(T, NGU, G, (int)blockIdx.x);
        pg8::EpiSwiglu<true> E{act, D_FF, rowsq, 1.f / 4096.f, EPS, 1.f / WGU_SCALE};
        pg8::gemm_phase<pg8::EpiSwiglu<true>, pg8::StaticOrder, true, true, true>(L + RING_OFF, g, S, E);
        if (BOTH(7)) xcd_barrier(bar);
    }
    if (IN(8)) {
        pg8::Gemm g{act, Wdn_t, T, D_MODEL, D_FF / 2}; pg8::StaticOrder S; S.init(T, D_MODEL, G, (int)blockIdx.x);
        pg8::EpiResid<true> E{bufA, bufA, rowsq + T, nullptr, D_MODEL, 1.f / WDN_SCALE};
        pg8::gemm_phase<pg8::EpiResid<true>, pg8::StaticOrder, true, P8_SP2, true>(L + RING_OFF, g, S, E);
        if (BOTH(8)) xcd_barrier(bar);
    }
    if (IN(9)) {
        for (int m = gw; m < T; m += NGW) {
            const float rs = 1.f / sqrtf(rowsq[T + m] * (1.f / 4096.f) + EPS);
            const GAS v2u* xr = (const GAS v2u*)(bufA + (size_t)m * D_MODEL) + lane; const GAS f32x4* gr = (const GAS f32x4*)norm_final + lane; GAS f32x4* orow = (GAS f32x4*)(out + (size_t)m * D_MODEL) + lane;
            v2u v[16];
#pragma unroll
            for (int j = 0; j < 16; ++j) v[j] = xr[64 * j];
#pragma unroll
            for (int j = 0; j < 16; ++j) { const f32x4 gg = gr[64 * j];
                orow[64 * j] = (f32x4){__uint_as_float(v[j].x << 16) * rs * gg.x, __uint_as_float(v[j].x & 0xffff0000u) * rs * gg.y, __uint_as_float(v[j].y << 16) * rs * gg.z, __uint_as_float(v[j].y & 0xffff0000u) * rs * gg.w}; }
        }
    }
#undef IN
#undef BOTH
}

extern "C" void kernel_launch(void* const* d_in, const int* in_sizes, int n_in, void* d_out, int out_size, void* d_ws, size_t ws_size, hipStream_t stream) {
    static int grid = 0;
    if (grid == 0) {
        if (n_in != 17 || out_size != T * D_MODEL || ws_size < WS_END) { fprintf(stderr, "kernel_launch: unexpected shapes (n_in %d out %d ws %zu); nothing launched\n", n_in, out_size, ws_size); grid = -1; return; }
        int dev = 0, cus = 0, per_cu = 0;
        if (hipGetDevice(&dev) != hipSuccess || hipDeviceGetAttribute(&cus, hipDeviceAttributeMultiprocessorCount, dev) != hipSuccess) { grid = -1; return; }
        if (hipFuncSetAttribute((const void*)mega, hipFuncAttributeMaxDynamicSharedMemorySize, LDS_BYTES) != hipSuccess) { fprintf(stderr, "kernel_launch: hipFuncSetAttribute failed\n"); grid = -1; return; }
        if (hipOccupancyMaxActiveBlocksPerMultiprocessor(&per_cu, (const void*)mega, NWAVES * 64, LDS_BYTES) != hipSuccess || per_cu < 1)
            fprintf(stderr, "kernel_launch: note: occupancy query reports %d workgroups per CU\n", per_cu);
        (void)hipGetLastError();
        grid = cus;
    }
    if (grid < 0) return;
    if (hipMemsetAsync((char*)d_ws + WS_CTL, 0, CTL_ZERO_BYTES, stream) != hipSuccess) return;
    Args a{};
    for (int i = 0; i < 17; ++i) a.in[i] = (const float*)d_in[i];
    a.out = (float*)d_out; a.ws = (unsigned char*)d_ws;
    for (int i = 0; i < 16; ++i) a.inv[i] = (float)pow(500000.0, -(double)(2 * i) / 32.0);
    unsigned char* ws = (unsigned char*)d_ws;
    int n_launch = 0;
    auto launch = [&](int lo, int hi) { a.ph_lo = lo; a.ph_hi = hi; a.li = n_launch++; hipLaunchKernelGGL(mega, dim3(grid), dim3(NWAVES * 64), LDS_BYTES, stream, a); };
#if MK_BUILD == 2
    for (int ph = 0; ph < N_PHASES; ++ph) launch(ph, ph + 1);
#elif MK_BUILD == 3
    launch(0, N_PHASES);
#else
#if MK_PROBE == 0
    launch(0, N_PHASES); launch(0, 1);
#elif MK_PROBE == 7
    launch(0, N_PHASES); launch(7, 8);
#else
    launch(0, MK_PROBE + 1); launch(MK_PROBE, MK_PROBE + 1); launch(MK_PROBE + 1, N_PHASES);
#endif
#endif
    const hipError_t le = hipPeekAtLastError();
    if (le != hipSuccess) fprintf(stderr, "kernel_launch: launch failed: %s\n", hipGetErrorName(le));
}
```

```cpp
#include <hip/hip_runtime.h>
#include <cstdio>
#include <cstdint>
#include <math.h>

#ifndef MK_TSEC
#define MK_TSEC -1
#endif
#ifndef MK_TWAVE
#define MK_TWAVE 0
#endif
#ifndef MK_TUNIT
#define MK_TUNIT 2
#endif
#ifndef MK_BUILD
#define MK_BUILD 3
#endif
namespace pg8 {
#define PG8_LAS __attribute__((address_space(3)))
typedef unsigned short bf16_t;
typedef short bf16x8 __attribute__((ext_vector_type(8)));
typedef float f32x4 __attribute__((ext_vector_type(4)));
typedef unsigned u32x4 __attribute__((ext_vector_type(4)));
constexpr int BM = 256, BK = 64, HALF = 128, HTB = HALF * BK * 2  , STAGE_BYTES = 8 * HTB, NXCD = 8, WGM = 8;

__host__ __device__ __forceinline__ int lds_byte(int r, int c) { const int st = (r >> 4) * 2 + (c >> 5), rr = r & 15, cc = c & 31, ob = rr * 64 + cc * 2; return st * 1024 + (ob ^ (((ob >> 9) & 1) << 5)); }
__host__ __device__ __forceinline__ void stage_rc(int b, int& R, int& C) { const int st = b / 1024, sb = b % 1024, swz = sb ^ (((sb >> 9) & 1) << 5); R = (st >> 1) * 16 + swz / 64; C = (st & 1) * 32 + (swz % 64) / 2; }
__host__ __device__ __forceinline__ int perm32(int rho) { const int n = rho >> 4, i = rho & 15; return 8 * (i >> 2) + 4 * n + (i & 3); }

struct Unit { int pm, pn; };
struct Gemm { const bf16_t* A; const bf16_t* Bt; int M, N, K; };

struct StaticOrder {
    int nM, nN, nwg, G, c;
    __host__ __device__ void init(int M, int N, int G_, int c_) { nM = M / BM; nN = N / BM; nwg = nM * nN; G = G_; c = c_; }
    __host__ __device__ bool next(int i, Unit& u) const {
        const long L = (long)i * G + c; if (L >= nwg) return false;
        int wgid = (int)L; { const int q = nwg / NXCD, r = nwg % NXCD, xcd = wgid % NXCD, off = wgid / NXCD; wgid = (xcd < r ? xcd * (q + 1) : r * (q + 1) + (xcd - r) * q) + off; }
        const int nig = WGM * nN, gid = wgid / nig, fm = gid * WGM, gsz = (nM - fm) < WGM ? (nM - fm) : WGM;
        u.pm = fm + ((wgid % nig) % gsz); u.pn = (wgid % nig) / gsz; return true;
    }
    __device__ __forceinline__ void a_ready(const Unit&) const {}
    __device__ __forceinline__ void done(const Unit&) const {}
};
__device__ __forceinline__ unsigned cvt_pk_bf16(float lo, float hi) { unsigned r; asm volatile("v_cvt_pk_bf16_f32 %0, %1, %2" : "=v"(r) : "v"(lo), "v"(hi)); return r; }
typedef unsigned u32x4 __attribute__((ext_vector_type(4)));
typedef unsigned u32x2 __attribute__((ext_vector_type(2)));
struct EpiProj {
    static constexpr bool PERM = true, AFTER_DRAIN = false;
    bf16_t* O; int ldc; const float* cs; const float* rowsq; float inv_k, eps;
    __device__ __forceinline__ void operator()(const f32x4 (&acc)[2][2][4][2], const Unit& u, int wr, int wc, int fr, int fq) const {
        const int row0 = u.pm * BM + wr * 64 + fr;
        const int col0 = u.pn * BM + wc * 32 + 8 * fq;
#pragma unroll
        for (int bj = 0; bj < 2; ++bj) {
            const int hd = u.pn * 2 + bj;
            const bool rope = (wc == 0) && (hd < 32 || (hd >= 48 && hd < 68) || (hd >= 72 && hd < 76) || (hd >= 80 && hd < 84));
#pragma unroll
            for (int ai = 0; ai < 2; ++ai)
#pragma unroll
                for (int m = 0; m < 4; ++m) {
                    const int row = row0 + ai * HALF + m * 16;
                    const float rs = 1.f / sqrtf(rowsq[row] * inv_k + eps);
                    f32x4 v0 = acc[ai][bj][m][0] * rs, v1 = acc[ai][bj][m][1] * rs;
                    if (rope) {
                        f32x4 w0, w1;
#pragma unroll
                        for (int e = 0; e < 4; ++e) { w0[e] = __shfl_xor(v0[e], 32); w1[e] = __shfl_xor(v1[e], 32); }
                        const float* c = cs + ((size_t)(row & 4095) * 16 + 8 * (fq & 1)) * 2;
                        const f32x4 c0 = *(const f32x4*)c, c1 = *(const f32x4*)(c + 4), c2 = *(const f32x4*)(c + 8), c3 = *(const f32x4*)(c + 12);
                        const float cosv[8] = {c0[0], c0[2], c1[0], c1[2], c2[0], c2[2], c3[0], c3[2]};
                        const float sinv[8] = {c0[1], c0[3], c1[1], c1[3], c2[1], c2[3], c3[1], c3[3]};
                        if (fq < 2) {
#pragma unroll
                            for (int e = 0; e < 4; ++e) { v0[e] = v0[e] * cosv[e] - w0[e] * sinv[e]; v1[e] = v1[e] * cosv[4 + e] - w1[e] * sinv[4 + e]; }
                        } else {
#pragma unroll
                            for (int e = 0; e < 4; ++e) { v0[e] = w0[e] * sinv[e] + v0[e] * cosv[e]; v1[e] = w1[e] * sinv[4 + e] + v1[e] * cosv[4 + e]; }
                        }
                    }
                    u32x4 w; w.x = cvt_pk_bf16(v0[0], v0[1]); w.y = cvt_pk_bf16(v0[2], v0[3]); w.z = cvt_pk_bf16(v1[0], v1[1]); w.w = cvt_pk_bf16(v1[2], v1[3]);
                    *(u32x4*)(O + (size_t)row * ldc + col0 + bj * HALF) = w;
                }
        }
    }
};
template <bool R_BF16> struct EpiResid {
    static constexpr bool PERM = true, AFTER_DRAIN = false;
    const void* R; bf16_t* Ob; float* rowsq; unsigned char* O8; int ldc; float ascale;
    __device__ __forceinline__ void operator()(const f32x4 (&acc)[2][2][4][2], const Unit& u, int wr, int wc, int fr, int fq) const {
        const int row0 = u.pm * BM + wr * 64 + fr;
        const int col0 = u.pn * BM + wc * 32 + 8 * fq;
#pragma unroll
        for (int ai = 0; ai < 2; ++ai)
#pragma unroll
            for (int m = 0; m < 4; ++m) {
                const size_t ro = (size_t)(row0 + ai * HALF + m * 16) * ldc + col0;
                float ss = 0.f;
#pragma unroll
                for (int bj = 0; bj < 2; ++bj) {
                    f32x4 r0, r1;
                    if constexpr (R_BF16) { const u32x4 rb = *(const u32x4*)((const bf16_t*)R + ro + bj * HALF);
                        r0 = (f32x4){__builtin_bit_cast(float, rb.x << 16), __builtin_bit_cast(float, rb.x & 0xffff0000u), __builtin_bit_cast(float, rb.y << 16), __builtin_bit_cast(float, rb.y & 0xffff0000u)};
                        r1 = (f32x4){__builtin_bit_cast(float, rb.z << 16), __builtin_bit_cast(float, rb.z & 0xffff0000u), __builtin_bit_cast(float, rb.w << 16), __builtin_bit_cast(float, rb.w & 0xffff0000u)}; }
                    else { r0 = *(const f32x4*)((const float*)R + ro + bj * HALF); r1 = *(const f32x4*)((const float*)R + ro + bj * HALF + 4); }
                    const f32x4 o0 = r0 + acc[ai][bj][m][0] * ascale, o1 = r1 + acc[ai][bj][m][1] * ascale;
                    u32x4 w; w.x = cvt_pk_bf16(o0[0], o0[1]); w.y = cvt_pk_bf16(o0[2], o0[3]); w.z = cvt_pk_bf16(o1[0], o1[1]); w.w = cvt_pk_bf16(o1[2], o1[3]);
                    *(u32x4*)(Ob + ro + bj * HALF) = w;
                    if (O8) { int w0 = __builtin_amdgcn_cvt_pk_fp8_f32(o0[0], o0[1], 0, false); w0 = __builtin_amdgcn_cvt_pk_fp8_f32(o0[2], o0[3], w0, true);
                        int w1 = __builtin_amdgcn_cvt_pk_fp8_f32(o1[0], o1[1], 0, false); w1 = __builtin_amdgcn_cvt_pk_fp8_f32(o1[2], o1[3], w1, true);
                        *(u32x2*)(O8 + ro + bj * HALF) = (u32x2){(unsigned)w0, (unsigned)w1}; }
                    ss += (o0[0] * o0[0] + o0[1] * o0[1]) + (o0[2] * o0[2] + o0[3] * o0[3]) + (o1[0] * o1[0] + o1[1] * o1[1]) + (o1[2] * o1[2] + o1[3] * o1[3]);
                }
                ss += __shfl_xor(ss, 16); ss += __shfl_xor(ss, 32); if (fq == 0) atomicAdd(rowsq + (row0 + ai * HALF + m * 16), ss);
            }
    }
};
template <bool FP8OUT> struct EpiSwiglu {
    static constexpr bool PERM = true, AFTER_DRAIN = false;
    bf16_t* O; int ldc; const float* rowsq; float inv_k, eps, ascale;
    __device__ __forceinline__ static float silu_mul(float g, float uu) { return g * __builtin_amdgcn_rcpf(1.f + __builtin_amdgcn_exp2f(-1.4426950408889634f * g)) * uu; }
    __device__ __forceinline__ void operator()(const f32x4 (&acc)[2][2][4][2], const Unit& u, int wr, int wc, int fr, int fq) const {
        const int row0 = u.pm * BM + wr * 64 + fr;
        const int col0 = u.pn * HALF + wc * 32 + 8 * fq;
#pragma unroll
        for (int ai = 0; ai < 2; ++ai)
#pragma unroll
            for (int m = 0; m < 4; ++m) {
                const float rs = ascale / sqrtf(rowsq[row0 + ai * HALF + m * 16] * inv_k + eps);
                const f32x4 g0 = acc[ai][0][m][0] * rs, g1 = acc[ai][0][m][1] * rs, u0 = acc[ai][1][m][0] * rs, u1 = acc[ai][1][m][1] * rs;
                if constexpr (FP8OUT) {
                    int w0 = __builtin_amdgcn_cvt_pk_fp8_f32(silu_mul(g0[0], u0[0]), silu_mul(g0[1], u0[1]), 0, false); w0 = __builtin_amdgcn_cvt_pk_fp8_f32(silu_mul(g0[2], u0[2]), silu_mul(g0[3], u0[3]), w0, true);
                    int w1 = __builtin_amdgcn_cvt_pk_fp8_f32(silu_mul(g1[0], u1[0]), silu_mul(g1[1], u1[1]), 0, false); w1 = __builtin_amdgcn_cvt_pk_fp8_f32(silu_mul(g1[2], u1[2]), silu_mul(g1[3], u1[3]), w1, true);
                    *(u32x2*)((unsigned char*)O + (size_t)(row0 + ai * HALF + m * 16) * ldc + col0) = (u32x2){(unsigned)w0, (unsigned)w1};
                } else {
                u32x4 w;
                w.x = cvt_pk_bf16(silu_mul(g0[0], u0[0]), silu_mul(g0[1], u0[1])); w.y = cvt_pk_bf16(silu_mul(g0[2], u0[2]), silu_mul(g0[3], u0[3]));
                w.z = cvt_pk_bf16(silu_mul(g1[0], u1[0]), silu_mul(g1[1], u1[1])); w.w = cvt_pk_bf16(silu_mul(g1[2], u1[2]), silu_mul(g1[3], u1[3]));
                *(u32x4*)(O + (size_t)(row0 + ai * HALF + m * 16) * ldc + col0) = w; }
            }
    }
};
typedef int v8i_t __attribute__((ext_vector_type(8)));
typedef int v4i_t __attribute__((ext_vector_type(4)));
__device__ __forceinline__ v8i_t cat8(bf16x8 lo, bf16x8 hi) { const v4i_t a = __builtin_bit_cast(v4i_t, lo), b = __builtin_bit_cast(v4i_t, hi); return __builtin_shufflevector(a, b, 0, 1, 2, 3, 4, 5, 6, 7); }
template <class Epi, class Sched, bool ALIGN_EPI = false, bool SP2 = false, bool FP8 = false>
__device__ __forceinline__ void gemm_phase(PG8_LAS unsigned char* lds, const Gemm g, const Sched& S, const Epi& E) {
    const int tid = threadIdx.x, wid = __builtin_amdgcn_readfirstlane(tid >> 6), lane = tid & 63, wr = wid >> 2, wc = wid & 3, fr = lane & 15, fq = lane >> 4;
    const int K = g.K, nt = K / BK;
    unsigned voffA[2], voffB[2];
#pragma unroll
    for (int i = 0; i < 2; ++i) { int R, C; stage_rc(tid * 16 + i * 8192, R, C); const int Rb = Epi::PERM ? ((R & ~31) + perm32(R & 31)) : R;
        voffA[i] = (unsigned)(R * K + C) * 2u; voffB[i] = (unsigned)(Rb * K + C) * 2u; }
    const size_t kstep = (size_t)(BK * 2);
    const size_t hstep = (size_t)HALF * K * 2;
    const size_t tstep = 2 * hstep;
    const unsigned ldsw = (unsigned)wid * 1024u;
    const int aoff = lds_byte(wr * 64 + fr, fq * 8), boff = lds_byte(wc * 32 + fr, fq * 8);
#define PG8_SA(b, h) (((b) * 2 + (h)) * HTB)
#define PG8_SB(b, h) ((4 + (b) * 2 + (h)) * HTB)
#define PG8_STAGE(bufoff, gbase, voff) do { _Pragma("unroll") for (int _i = 0; _i < 2; ++_i) \
        __builtin_amdgcn_global_load_lds((const unsigned*)((const char*)(gbase) + (voff)[_i]), (PG8_LAS unsigned*)(lds + (bufoff) + ldsw + _i * 8192), 16, 0, 0); } while (0)
#define PG8_LDA(dst, b, h) do { if constexpr (FP8) { _Pragma("unroll") for (int m = 0; m < 4; ++m) dst##8[m] = cat8(*(const PG8_LAS bf16x8*)(lds + PG8_SA(b, h) + aoff + m * 2048), *(const PG8_LAS bf16x8*)(lds + PG8_SA(b, h) + aoff + m * 2048 + 1024)); } else { \
        _Pragma("unroll") for (int m = 0; m < 4; ++m) _Pragma("unroll") for (int k = 0; k < 2; ++k) dst[m][k] = *(const PG8_LAS bf16x8*)(lds + PG8_SA(b, h) + aoff + m * 2048 + k * 1024); } } while (0)
#define PG8_LDB(dst, b, h) do { if constexpr (FP8) { _Pragma("unroll") for (int n = 0; n < 2; ++n) dst##8[n] = cat8(*(const PG8_LAS bf16x8*)(lds + PG8_SB(b, h) + boff + n * 2048), *(const PG8_LAS bf16x8*)(lds + PG8_SB(b, h) + boff + n * 2048 + 1024)); } else { \
        _Pragma("unroll") for (int n = 0; n < 2; ++n) _Pragma("unroll") for (int k = 0; k < 2; ++k) dst[n][k] = *(const PG8_LAS bf16x8*)(lds + PG8_SB(b, h) + boff + n * 2048 + k * 1024); } } while (0)
#define PG8_MMA(ai, bj, At, Bt) do { __builtin_amdgcn_s_setprio(1); if constexpr (FP8) { _Pragma("unroll") for (int m = 0; m < 4; ++m) _Pragma("unroll") for (int n = 0; n < 2; ++n) \
        asm volatile("v_mfma_scale_f32_16x16x128_f8f6f4 %0, %1, %2, %0, %3, %3 op_sel_hi:[0,0,0]" : "+v"(acc[ai][bj][m][n]) : "v"(Bt##8[n]), "v"(At##8[m]), "v"(fp8_unit_scale)); } else { \
        _Pragma("unroll") for (int m = 0; m < 4; ++m) _Pragma("unroll") for (int n = 0; n < 2; ++n) _Pragma("unroll") for (int k = 0; k < 2; ++k) \
        acc[ai][bj][m][n] = __builtin_amdgcn_mfma_f32_16x16x32_bf16(Bt[n][k], At[m][k], acc[ai][bj][m][n], 0, 0, 0); } __builtin_amdgcn_s_setprio(0); } while (0)
#define PG8_WAIT_V(n) asm volatile("s_waitcnt vmcnt(" #n ")" ::: "memory")
#define PG8_WAIT_L(n) asm volatile("s_waitcnt lgkmcnt(" #n ")" ::: "memory")
#define PG8_BAR __builtin_amdgcn_s_barrier()
#define PG8_SCHED __builtin_amdgcn_sched_barrier(0)
    Unit cur, nxt; int ui = 0;
    if (!S.next(0, cur)) return;
    f32x4 acc[2][2][4][2];
#pragma unroll
    for (int a = 0; a < 2; ++a)
#pragma unroll
        for (int b = 0; b < 2; ++b)
#pragma unroll
            for (int m = 0; m < 4; ++m)
#pragma unroll
                for (int n = 0; n < 2; ++n) acc[a][b][m][n] = (f32x4){0.f, 0.f, 0.f, 0.f};
    const int fp8_unit_scale = 0x7F7F7F7F;
    bf16x8 At[4][2], B0[2][2], B1[2][2]; v8i_t At8[4], B08[2], B18[2];
    const char* cA = (const char*)g.A + (size_t)cur.pm * tstep; const char* cB = (const char*)g.Bt + (size_t)cur.pn * tstep;
    S.a_ready(cur);
    if constexpr (SP2) {
        PG8_STAGE(PG8_SB(0, 0), cB, voffB); PG8_STAGE(PG8_SB(0, 1), cB + hstep, voffB); PG8_STAGE(PG8_SA(0, 0), cA, voffA); PG8_STAGE(PG8_SA(0, 1), cA + hstep, voffA);
        if (wr == 1) PG8_BAR;
        PG8_WAIT_V(2); PG8_BAR;
        PG8_STAGE(PG8_SB(1, 0), cB + kstep, voffB); PG8_STAGE(PG8_SA(1, 0), cA + kstep, voffA); PG8_STAGE(PG8_SB(1, 1), cB + hstep + kstep, voffB);
        PG8_WAIT_V(6); PG8_BAR;
    } else {
        PG8_STAGE(PG8_SB(0, 0), cB, voffB); PG8_STAGE(PG8_SA(0, 0), cA, voffA); PG8_STAGE(PG8_SB(0, 1), cB + hstep, voffB); PG8_STAGE(PG8_SA(0, 1), cA + hstep, voffA);
        if (wr == 1) PG8_BAR;
        PG8_WAIT_V(4); PG8_BAR;
        PG8_STAGE(PG8_SB(1, 0), cB + kstep, voffB); PG8_STAGE(PG8_SA(1, 0), cA + kstep, voffA); PG8_STAGE(PG8_SB(1, 1), cB + hstep + kstep, voffB);
        PG8_WAIT_V(6); PG8_BAR;
    }
    for (;;) {
        const bool has_next = S.next(ui + 1, nxt);
        const char* nA = has_next ? (const char*)g.A + (size_t)nxt.pm * tstep : cA; const char* nB = has_next ? (const char*)g.Bt + (size_t)nxt.pn * tstep : cB;
        for (int t = 0; t < nt; t += 2) {
            const bool last = (t == nt - 2);
            const char* a1 = cA + (size_t)(t + 1) * kstep;
            const char* a2 = last ? nA : cA + (size_t)(t + 2) * kstep; const char* b2 = last ? nB : cB + (size_t)(t + 2) * kstep;
            const char* a3 = a2 + kstep; const char* b3 = b2 + kstep;
            if (last && has_next) S.a_ready(nxt);
            if constexpr (SP2) {
            PG8_LDB(B0, 0, 0); PG8_LDB(B1, 0, 1); PG8_SCHED; PG8_LDA(At, 0, 0); PG8_STAGE(PG8_SA(1, 1), a1 + hstep, voffA);
            PG8_WAIT_V(8); PG8_WAIT_L(0); PG8_BAR; PG8_MMA(0, 0, At, B0); PG8_MMA(0, 1, At, B1); PG8_BAR; PG8_SCHED;
            PG8_LDA(At, 0, 1); PG8_STAGE(PG8_SB(0, 0), b2, voffB); PG8_STAGE(PG8_SB(0, 1), b2 + hstep, voffB); PG8_STAGE(PG8_SA(0, 0), a2, voffA);
            PG8_WAIT_V(8); PG8_WAIT_L(0); PG8_BAR; PG8_MMA(1, 0, At, B0); PG8_MMA(1, 1, At, B1); PG8_BAR; PG8_SCHED;
            PG8_LDB(B0, 1, 0); PG8_LDB(B1, 1, 1); PG8_SCHED; PG8_LDA(At, 1, 0); PG8_STAGE(PG8_SA(0, 1), a2 + hstep, voffA);
            PG8_WAIT_V(8); PG8_WAIT_L(0); PG8_BAR; PG8_MMA(0, 0, At, B0); PG8_MMA(0, 1, At, B1); PG8_BAR; PG8_SCHED;
            PG8_LDA(At, 1, 1); PG8_STAGE(PG8_SB(1, 0), b3, voffB); PG8_STAGE(PG8_SB(1, 1), b3 + hstep, voffB); PG8_STAGE(PG8_SA(1, 0), a3, voffA);
            PG8_WAIT_V(8); PG8_WAIT_L(0); PG8_BAR; PG8_MMA(1, 0, At, B0); PG8_MMA(1, 1, At, B1); PG8_BAR; PG8_SCHED;
            } else {
            PG8_LDB(B0, 0, 0); PG8_SCHED; PG8_LDA(At, 0, 0); PG8_STAGE(PG8_SA(1, 1), a1 + hstep, voffA);
            PG8_WAIT_L(8); PG8_BAR; PG8_WAIT_L(0); PG8_MMA(0, 0, At, B0); PG8_BAR; PG8_SCHED;
            PG8_LDB(B1, 0, 1); PG8_STAGE(PG8_SB(0, 0), b2, voffB);
            PG8_BAR; PG8_WAIT_L(0); PG8_MMA(0, 1, At, B1); PG8_BAR;
            PG8_LDA(At, 0, 1); PG8_STAGE(PG8_SA(0, 0), a2, voffA);
            PG8_BAR; PG8_WAIT_L(0); PG8_MMA(1, 0, At, B0); PG8_BAR; PG8_SCHED;
            PG8_STAGE(PG8_SB(0, 1), b2 + hstep, voffB);
            PG8_WAIT_V(6); PG8_BAR; PG8_MMA(1, 1, At, B1); PG8_BAR;
            PG8_LDB(B0, 1, 0); PG8_SCHED; PG8_LDA(At, 1, 0); PG8_STAGE(PG8_SA(0, 1), a2 + hstep, voffA);
            PG8_WAIT_L(8); PG8_BAR; PG8_WAIT_L(0); PG8_MMA(0, 0, At, B0); PG8_BAR; PG8_SCHED;
            PG8_LDB(B1, 1, 1); PG8_STAGE(PG8_SB(1, 0), b3, voffB);
            PG8_BAR; PG8_WAIT_L(0); PG8_MMA(0, 1, At, B1); PG8_BAR;
            PG8_LDA(At, 1, 1); PG8_STAGE(PG8_SA(1, 0), a3, voffA);
            PG8_BAR; PG8_WAIT_L(0); PG8_MMA(1, 0, At, B0); PG8_BAR; PG8_SCHED;
            PG8_STAGE(PG8_SB(1, 1), b3 + hstep, voffB);
            PG8_WAIT_V(6); PG8_BAR; PG8_MMA(1, 1, At, B1); PG8_BAR;
            }
        }
        if constexpr (ALIGN_EPI) { if (wr == 0) PG8_BAR; }
        if constexpr (FP8) asm volatile("s_nop 15\n\ts_nop 15\n\ts_nop 15" ::: "memory");
        if constexpr (!Epi::AFTER_DRAIN) { E(acc, cur, wr, wc, fr, fq); S.done(cur); }
        if (!has_next) break;
#pragma unroll
        for (int a = 0; a < 2; ++a)
#pragma unroll
            for (int b = 0; b < 2; ++b)
#pragma unroll
                for (int m = 0; m < 4; ++m)
#pragma unroll
                    for (int n = 0; n < 2; ++n) acc[a][b][m][n] = (f32x4){0.f, 0.f, 0.f, 0.f};
        if constexpr (FP8) asm volatile("s_nop 7" ::: "memory");
        cur = nxt; cA = nA; cB = nB; ++ui;
        if constexpr (ALIGN_EPI) { if (wr == 1) PG8_BAR; }
    }
    PG8_WAIT_V(0);
    if constexpr (!ALIGN_EPI) { if (wr == 0) PG8_BAR; }
    PG8_BAR;
    if constexpr (Epi::AFTER_DRAIN) { E.fused(acc, cur, wr, wc, fr, fq, lds, wid, lane); S.done(cur); }
#undef PG8_SA
#undef PG8_SB
#undef PG8_STAGE
#undef PG8_LDA
#undef PG8_LDB
#undef PG8_MMA
#undef PG8_WAIT_V
#undef PG8_WAIT_L
#undef PG8_BAR
#undef PG8_SCHED
}
}
constexpr int D_MODEL = 4096, BATCH = 4, SEQ = 4096, T = BATCH * SEQ;
constexpr int HA = 16, HB = 16, GB = 4, RB = 4;
constexpr int D_IN = 11312, LDP = 11520, D_FF = 11008, NGU = 2 * D_FF;
constexpr int OFF_QA = 0, OFF_KA = 2048, OFF_VA = 4096, OFF_QB = 6144, OFF_KC = 8192, OFF_VC = 8704,
              OFF_KS = 9216, OFF_VS = 9728, OFF_KW = 10240, OFF_VW = 10752, OFF_GL = 11264;
constexpr int NC = 255, NS = 64, CMP_LEN = 32, CMP_STRIDE = 16, NSEL = 16, WIN = 512;
constexpr float EPS = 1e-5f;
constexpr float QSCALE = 0.08838834764831845f;
constexpr int NWAVES = 8;
#ifndef PG8_FP8_SCALE
#define PG8_FP8_SCALE 0x7F7F7F7F
#endif
#ifndef P8_SP2
#define P8_SP2 true
#endif
constexpr float WGU_SCALE = 64.f;
constexpr float WDN_SCALE = 64.f;

constexpr size_t MiB = 1u << 20;
constexpr size_t WS_CTL = 0, CTL_ZERO_BYTES = 1 * MiB;
constexpr size_t WS_WIN = 1 * MiB;
constexpr size_t WS_WOUT = 91 * MiB;
constexpr size_t WS_WGU = 123 * MiB;
constexpr size_t WS_WDN = 295 * MiB;
constexpr size_t WS_BUFA = 381 * MiB;
constexpr size_t WS_PROJ = 509 * MiB;
constexpr size_t WS_SMALL = 869 * MiB;
constexpr size_t WS_CS = WS_SMALL;
constexpr size_t WS_KCF = WS_SMALL + 1 * MiB;
constexpr size_t WS_KCB = WS_SMALL + 5 * MiB;
constexpr size_t WS_W1T = WS_SMALL + 7 * MiB;
constexpr size_t WS_BIAS1 = WS_SMALL + 9 * MiB;
constexpr size_t WS_LSE = WS_SMALL + 10 * MiB;
constexpr size_t WS_GATES = WS_SMALL + 13 * MiB;
constexpr size_t WS_ROWSQ = WS_SMALL + 16 * MiB;
constexpr size_t WS_PART = 888 * MiB;
constexpr size_t WS_END = 1016 * MiB;
static_assert(WS_WIN + (size_t)LDP * 4096 * 2 <= WS_WOUT && WS_WOUT + (size_t)4096 * 4096 * 2 <= WS_WGU && WS_WGU + (size_t)NGU * 4096 * 2 <= WS_WDN &&
              WS_WDN + (size_t)4096 * D_FF * 2 <= WS_BUFA && WS_BUFA + (size_t)T * 4096 * 2 <= WS_PROJ && WS_PROJ + (size_t)T * LDP * 2 <= WS_SMALL, "d_ws map");
constexpr int CW_TMO = 0, CW_CODE = 1;
constexpr int CW_BAR = 4096;

constexpr int RING_OFF = 0, RING_BYTES = 131072;
constexpr int LDSCTL_OFF = RING_BYTES, MISC_OFF = LDSCTL_OFF + 320;
constexpr int LDS_BYTES = 155648;

#define GAS __attribute__((address_space(1)))
#define LAS __attribute__((address_space(3)))
typedef unsigned short bf16;
typedef unsigned v4u __attribute__((ext_vector_type(4)));
typedef unsigned v2u __attribute__((ext_vector_type(2)));
typedef float f32x4 __attribute__((ext_vector_type(4)));
typedef short bf16x8 __attribute__((ext_vector_type(8)));
typedef GAS unsigned gu32;
#define RLX_AGENT __ATOMIC_RELAXED, __HIP_MEMORY_SCOPE_AGENT
#define LDS_WAIT() asm volatile("s_waitcnt lgkmcnt(0)" ::: "memory")
#define VM_WAIT() asm volatile("s_waitcnt vmcnt(0)" ::: "memory")
__device__ __forceinline__ unsigned f2bf(float f) { unsigned u = __builtin_bit_cast(unsigned, f); return (u + 0x7fffu + ((u >> 16) & 1u)) >> 16; }
__device__ __forceinline__ unsigned pk2(float lo, float hi) { return f2bf(lo) | (f2bf(hi) << 16); }
__device__ __forceinline__ float bf2f(bf16 v) { return __builtin_bit_cast(float, (unsigned)v << 16); }
#define XB_TMO      128
#define XB_XCNT(j)  (256  + 64 * (j))
#define XB_XSUB(j)  (1280 + 64 * (j))
#define XB_XGEN(j)  (2304 + 64 * (j))
#define XB_TOP      3328
#define XB_TOPGEN   3392
#define XCD_BAR_WORDS 3456
#define XB_SPIN_CAP (1u << 18)

__device__ __forceinline__ unsigned xb_ld(unsigned* p)              { return __hip_atomic_load(p, __ATOMIC_RELAXED, __HIP_MEMORY_SCOPE_AGENT); }
__device__ __forceinline__ unsigned xb_add(unsigned* p, unsigned v) { return __hip_atomic_fetch_add(p, v, __ATOMIC_RELAXED, __HIP_MEMORY_SCOPE_AGENT); }
__device__ __forceinline__ unsigned xb_xcc_id() { return (unsigned)__builtin_amdgcn_s_getreg((3 << 11) | 20) & 0xFu; }
#define XB_SPIN(cond, bar) do { unsigned _sp = 0; while (cond) { __builtin_amdgcn_s_sleep(1); \
    if ((++_sp & 255u) == 0u) { if (xb_ld(&(bar)[XB_TMO])) break; if (_sp > XB_SPIN_CAP) { atomicAdd(&(bar)[XB_TMO], 1u); break; } } } } while (0)

struct XcdBarrier {
    unsigned* bar; unsigned x;
    volatile LAS unsigned* st;
};

__device__ __forceinline__ XcdBarrier xcd_barrier_post(unsigned* bar, volatile LAS unsigned* st) {
    XcdBarrier b; b.bar = bar; b.x = xb_xcc_id(); b.st = st;
    if (threadIdx.x == 0) (void)xb_add(&bar[XB_XCNT(b.x)], 1u);
    return b;
}
__device__ __forceinline__ void xcd_barrier_complete(unsigned* bar, unsigned x, unsigned& nloc, unsigned& nx) {
    const unsigned G = gridDim.x * gridDim.y * gridDim.z;
    unsigned sum, cnt, mine, sp = 0u;
    for (;;) {
        sum = 0u; cnt = 0u; mine = 0u;
#pragma unroll
        for (unsigned j = 0; j < 16; ++j) { const unsigned c = xb_ld(&bar[XB_XCNT(j)]); sum += c; cnt += (c > 0u) ? 1u : 0u; mine = (j == x) ? c : mine; }
        if (sum == G) break;
        __builtin_amdgcn_s_sleep(1);
        if ((++sp & 255u) == 0u) { if (xb_ld(&bar[XB_TMO])) break; if (sp > XB_SPIN_CAP) { atomicAdd(&bar[XB_TMO], 1u); break; } }
    }
    nloc = mine > 0u ? mine : 1u; nx = cnt > 0u ? cnt : 1u;
}

__device__ __forceinline__ void xcd_barrier(const XcdBarrier& b) {
    asm volatile("s_waitcnt vmcnt(0)" ::: "memory");
    __syncthreads();
    if (threadIdx.x == 0) {
        unsigned* bar = b.bar;
        __builtin_amdgcn_s_waitcnt(0);
        unsigned nloc = b.st[0], nx = b.st[1];
        if (nloc == 0u) { xcd_barrier_complete(bar, b.x, nloc, nx); b.st[0] = nloc; b.st[1] = nx; }
        const unsigned old = xb_add(&bar[XB_XSUB(b.x)], 1u);
        const unsigned gen = old / nloc;
        if (old + 1u == (gen + 1u) * nloc) {
            __builtin_amdgcn_fence(__ATOMIC_RELEASE, "agent");
            asm volatile("s_waitcnt vmcnt(0)" ::: "memory");
            const unsigned og = xb_add(&bar[XB_TOP], 1u);
            const unsigned tg = og / nx;
            if (og + 1u == (tg + 1u) * nx) xb_add(&bar[XB_TOPGEN], 1u);
            else XB_SPIN(xb_ld(&bar[XB_TOPGEN]) == tg, bar);
            __builtin_amdgcn_fence(__ATOMIC_ACQUIRE, "agent");
            xb_add(&bar[XB_XGEN(b.x)], 1u);
            asm volatile("s_waitcnt vmcnt(0)" ::: "memory");
        } else {
            XB_SPIN(xb_ld(&bar[XB_XGEN(b.x)]) == gen, bar);
            __builtin_amdgcn_fence(__ATOMIC_ACQUIRE, "agent");
            asm volatile("s_waitcnt vmcnt(0)" ::: "memory");
        }
    }
    __syncthreads();
}
namespace att {
#ifdef MK_TPROBE
#define SECARG , sec_acc
#define SECPARM , unsigned long long& sec_acc
#define SEC_BEGIN(kind) unsigned long long sec_t; asm volatile("s_memrealtime %0\n\ts_waitcnt lgkmcnt(0)" : "=s"(sec_t) :: "memory"); int sec_n = 0; const bool sec_on = (kind) == MK_TUNIT
#define SSEC(k) do { unsigned long long t_; asm volatile("s_memrealtime %0\n\ts_waitcnt lgkmcnt(0)" : "=s"(t_) :: "memory"); if (ssec_on && MK_TSEC == (k) && wave == MK_TWAVE) *ssec_acc += t_ - ssec_t; ssec_t = t_; } while (0)
#define SSEC_PARM , unsigned long long* ssec_acc = nullptr, bool ssec_on = false
#define SSEC_ARG , &sec_acc, sec_on
#define SSEC_INIT unsigned long long ssec_t; asm volatile("s_memrealtime %0\n\ts_waitcnt lgkmcnt(0)" : "=s"(ssec_t) :: "memory")
#define SEC() do { unsigned long long t_; asm volatile("s_memrealtime %0\n\ts_waitcnt lgkmcnt(0)" : "=s"(t_) :: "memory"); if (sec_on && sec_n == MK_TSEC) sec_acc += t_ - sec_t; sec_t = t_; ++sec_n; } while (0)
#else
#define SECARG
#define SECPARM
#define SEC_BEGIN(kind) do { } while (0)
#define SEC() do { } while (0)
#define SSEC(k) do { } while (0)
#define SSEC_PARM
#define SSEC_ARG
#define SSEC_INIT do { } while (0)
#endif
typedef float f32x16 __attribute__((ext_vector_type(16)));
typedef short s16x4 __attribute__((ext_vector_type(4)));
constexpr int SHM_T = 16384;
constexpr int A_V = 0, A_K = 4 * SHM_T;
constexpr int A_KC = 0, A_VC = 4 * SHM_T;
constexpr int A_WS = 131072 + 1024;
constexpr int A_IMP = A_WS + 2048;
constexpr int A_SEL = A_IMP + 16384;
constexpr int A_END = A_SEL + 512;
constexpr float C2 = QSCALE * 1.4426950408889634f;
constexpr float THR_RAW = 8.f / QSCALE;
#define KSWZ(row, colB) ((row) * 256 + ((colB) ^ (((row) & 7) << 4)))
__device__ __forceinline__ int crow(int r, int hi) { return (r & 3) + 8 * (r >> 2) + 4 * hi; }
__device__ __forceinline__ unsigned cvtpk(float lo, float hi) { unsigned r; asm volatile("v_cvt_pk_bf16_f32 %0, %1, %2" : "=v"(r) : "v"(lo), "v"(hi)); return r; }
__device__ __forceinline__ int v_st(int k, int c) { const int kk = (k & ~0xC) | ((k & 4) << 1) | ((k & 8) >> 1); return ((kk >> 3) * 4 + (c >> 5)) * 512 + ((kk & 7) * 32 + (c & 31)) * 2; }
__device__ __forceinline__ int v_rd_base(int lane) { return ((lane & 3) << 3) | (((lane >> 2) & 3) << 6) | (((lane >> 4) & 1) << 5) | (((lane >> 5) & 1) << 8); }
constexpr int v_rd_off(int d0, int ks, int half) { return d0 * 512 + ks * 4096 + half * 2048; }
template <int OFF> __device__ __forceinline__ s16x4 tr_read(int vb) {
    s16x4 r; asm volatile("ds_read_b64_tr_b16 %0, %1 offset:%2" : "=&v"(r) : "v"(vb), "i"(OFF) : "memory"); return r;
}
struct VFrag { s16x4 l0, h0, l1, h1, l2, h2, l3, h3; };
template <int D0> __device__ __forceinline__ void v_reads(VFrag& f, int vb) {
    f.l0 = tr_read<v_rd_off(D0, 0, 0)>(vb); f.h0 = tr_read<v_rd_off(D0, 0, 1)>(vb); f.l1 = tr_read<v_rd_off(D0, 1, 0)>(vb); f.h1 = tr_read<v_rd_off(D0, 1, 1)>(vb);
    f.l2 = tr_read<v_rd_off(D0, 2, 0)>(vb); f.h2 = tr_read<v_rd_off(D0, 2, 1)>(vb); f.l3 = tr_read<v_rd_off(D0, 3, 0)>(vb); f.h3 = tr_read<v_rd_off(D0, 3, 1)>(vb);
}
#define ATT_PK(Lx, Hx) (bf16x8){Lx[0], Lx[1], Lx[2], Lx[3], Hx[0], Hx[1], Hx[2], Hx[3]}
__device__ __forceinline__ void pv_mma(f32x16& od, const VFrag& f, bf16x8 pa0, bf16x8 pa1, bf16x8 pa2, bf16x8 pa3) {
    od = __builtin_amdgcn_mfma_f32_32x32x16_bf16(pa0, ATT_PK(f.l0, f.h0), od, 0, 0, 0);
    od = __builtin_amdgcn_mfma_f32_32x32x16_bf16(pa1, ATT_PK(f.l1, f.h1), od, 0, 0, 0);
    od = __builtin_amdgcn_mfma_f32_32x32x16_bf16(pa2, ATT_PK(f.l2, f.h2), od, 0, 0, 0);
    od = __builtin_amdgcn_mfma_f32_32x32x16_bf16(pa3, ATT_PK(f.l3, f.h3), od, 0, 0, 0);
}
__device__ __forceinline__ void pv_d0(f32x16 (&o)[4], int vb, bf16x8 pa0, bf16x8 pa1, bf16x8 pa2, bf16x8 pa3) {
    VFrag fa, fb;
    v_reads<0>(fa, vb); v_reads<1>(fb, vb);
    asm volatile("s_waitcnt lgkmcnt(8)" ::: "memory"); __builtin_amdgcn_sched_barrier(0);
    pv_mma(o[0], fa, pa0, pa1, pa2, pa3); __builtin_amdgcn_sched_barrier(0);
    v_reads<2>(fa, vb);
    asm volatile("s_waitcnt lgkmcnt(8)" ::: "memory"); __builtin_amdgcn_sched_barrier(0);
    pv_mma(o[1], fb, pa0, pa1, pa2, pa3); __builtin_amdgcn_sched_barrier(0);
    v_reads<3>(fb, vb);
    asm volatile("s_waitcnt lgkmcnt(8)" ::: "memory"); __builtin_amdgcn_sched_barrier(0);
    pv_mma(o[2], fa, pa0, pa1, pa2, pa3); __builtin_amdgcn_sched_barrier(0);
    asm volatile("s_waitcnt lgkmcnt(0)" ::: "memory"); __builtin_amdgcn_sched_barrier(0);
    pv_mma(o[3], fb, pa0, pa1, pa2, pa3);
}
#undef ATT_PK
__device__ __forceinline__ void pv_d0_lean(f32x16 (&o)[4], int vb, bf16x8 pa0, bf16x8 pa1, bf16x8 pa2, bf16x8 pa3) {
    VFrag f;
    v_reads<0>(f, vb); asm volatile("s_waitcnt lgkmcnt(0)" ::: "memory"); __builtin_amdgcn_sched_barrier(0); pv_mma(o[0], f, pa0, pa1, pa2, pa3); __builtin_amdgcn_sched_barrier(0);
    v_reads<1>(f, vb); asm volatile("s_waitcnt lgkmcnt(0)" ::: "memory"); __builtin_amdgcn_sched_barrier(0); pv_mma(o[1], f, pa0, pa1, pa2, pa3); __builtin_amdgcn_sched_barrier(0);
    v_reads<2>(f, vb); asm volatile("s_waitcnt lgkmcnt(0)" ::: "memory"); __builtin_amdgcn_sched_barrier(0); pv_mma(o[2], f, pa0, pa1, pa2, pa3); __builtin_amdgcn_sched_barrier(0);
    v_reads<3>(f, vb); asm volatile("s_waitcnt lgkmcnt(0)" ::: "memory"); __builtin_amdgcn_sched_barrier(0); pv_mma(o[3], f, pa0, pa1, pa2, pa3);
}
#define ATT_KRD(B, d0) do { const int cb_ = ((d0) * 16 + hi * 8) * 2; B##0 = *(const LAS bf16x8*)(Ks + KSWZ(r32, cb_)); B##1 = *(const LAS bf16x8*)(Ks + KSWZ(32 + r32, cb_)); } while (0)
#define ATT_KMM(B, d0) do { p0 = __builtin_amdgcn_mfma_f32_32x32x16_bf16(B##0, qr[d0], p0, 0, 0, 0); p1 = __builtin_amdgcn_mfma_f32_32x32x16_bf16(B##1, qr[d0], p1, 0, 0, 0); } while (0)
__device__ __forceinline__ void qkt(f32x16& p0, f32x16& p1, const LAS unsigned char* Ks, const bf16x8 (&qr)[8], int r32, int hi) {
    bf16x8 a0, a1, b0, b1, c0, c1, e0, e1;
    ATT_KRD(a, 0); ATT_KRD(b, 1); ATT_KRD(c, 2); ATT_KRD(e, 3);
#pragma unroll
    for (int r = 0; r < 16; ++r) { p0[r] = 0.f; p1[r] = 0.f; }
    __builtin_amdgcn_sched_barrier(0);
    ATT_KMM(a, 0); ATT_KMM(b, 1); __builtin_amdgcn_sched_barrier(0);
    ATT_KRD(a, 4); ATT_KRD(b, 5); __builtin_amdgcn_sched_barrier(0);
    ATT_KMM(c, 2); ATT_KMM(e, 3); __builtin_amdgcn_sched_barrier(0);
    ATT_KRD(c, 6); ATT_KRD(e, 7); __builtin_amdgcn_sched_barrier(0);
    ATT_KMM(a, 4); ATT_KMM(b, 5); __builtin_amdgcn_sched_barrier(0);
    ATT_KMM(c, 6); ATT_KMM(e, 7);
}
#undef ATT_KRD
#undef ATT_KMM
__device__ __forceinline__ float xhalf_max(float v) { auto rr = __builtin_amdgcn_permlane32_swap(__float_as_uint(v), __float_as_uint(v), false, false); return fmaxf(__uint_as_float(rr[0]), __uint_as_float(rr[1])); }
__device__ __forceinline__ float xhalf_sum(float v) { auto rr = __builtin_amdgcn_permlane32_swap(__float_as_uint(v), __float_as_uint(v), false, false); return __uint_as_float(rr[0]) + __uint_as_float(rr[1]); }
__device__ __forceinline__ bf16x8 pks(unsigned a0, unsigned a1, unsigned b0, unsigned b1) {
    auto r0 = __builtin_amdgcn_permlane32_swap(a0, b0, false, false); auto r1 = __builtin_amdgcn_permlane32_swap(a1, b1, false, false);
    v4u w = {r0[0], r1[0], r0[1], r1[1]}; return __builtin_bit_cast(bf16x8, w);
}
__device__ __forceinline__ void softmax_tile(f32x16& p0, f32x16& p1, float& m_reg, float& l_reg, float& alpha, bf16x8& pa0, bf16x8& pa1, bf16x8& pa2, bf16x8& pa3) {
    float pmax = fmaxf(p0[0], p1[0]);
#pragma unroll
    for (int r = 1; r < 16; ++r) pmax = fmaxf(fmaxf(pmax, p0[r]), p1[r]);
    pmax = xhalf_max(pmax);
    float mn;
    if (__all(pmax - m_reg <= THR_RAW)) { mn = m_reg; alpha = 1.f; }
    else { mn = fmaxf(m_reg, pmax); alpha = __builtin_amdgcn_exp2f((m_reg - mn) * C2); m_reg = mn; }
    const float mnC = -mn * C2;
    float ps = 0.f;
#pragma unroll
    for (int r = 0; r < 16; ++r) { p0[r] = __builtin_amdgcn_exp2f(fmaf(p0[r], C2, mnC)); p1[r] = __builtin_amdgcn_exp2f(fmaf(p1[r], C2, mnC)); ps += p0[r] + p1[r]; }
    ps = xhalf_sum(ps);
    l_reg = l_reg * alpha + ps;
    pa0 = pks(cvtpk(p0[0], p0[1]), cvtpk(p0[2], p0[3]), cvtpk(p0[4], p0[5]), cvtpk(p0[6], p0[7]));
    pa1 = pks(cvtpk(p0[8], p0[9]), cvtpk(p0[10], p0[11]), cvtpk(p0[12], p0[13]), cvtpk(p0[14], p0[15]));
    pa2 = pks(cvtpk(p1[0], p1[1]), cvtpk(p1[2], p1[3]), cvtpk(p1[4], p1[5]), cvtpk(p1[6], p1[7]));
    pa3 = pks(cvtpk(p1[8], p1[9]), cvtpk(p1[10], p1[11]), cvtpk(p1[12], p1[13]), cvtpk(p1[14], p1[15]));
}
struct MaskBand { int qi, W, amin, amax;
    __device__ __forceinline__ bool interior(int t) const { return (t * 64 + 63 <= amin) && (t * 64 >= amax - W); }
    __device__ __forceinline__ void operator()(f32x16& p0, f32x16& p1, int t, int hi) const {
        const int kb = t * 64 + 4 * hi;
#pragma unroll
        for (int r = 0; r < 16; ++r) { const int k = kb + (r & 3) + 8 * (r >> 2);
            p0[r] = ((unsigned)(qi - k) <= (unsigned)W) ? p0[r] : -INFINITY; p1[r] = ((unsigned)(qi - k - 32) <= (unsigned)W) ? p1[r] : -INFINITY; }
    } };
struct NeedBand { int a, W;
    __device__ __forceinline__ bool operator()(int t) const { return (t * 64 + 63 >= a - W) && (t * 64 <= a + 31); } };
struct NeedAll { __device__ __forceinline__ bool operator()(int) const { return true; } };
struct MaskSel { unsigned mlo, mhi; int s, qb;
    __device__ __forceinline__ bool interior(int) const { return false; }
    __device__ __forceinline__ void operator()(f32x16& p0, f32x16& p1, int t, int hi) const {
        const bool bit = ((t < 32 ? (mlo >> t) : (mhi >> (t - 32))) & 1u) != 0u;
        const int lim = (bit ? s : -1) - (t * 64 + 4 * hi);
#pragma unroll
        for (int r = 0; r < 16; ++r) { const int c = (r & 3) + 8 * (r >> 2);
            p0[r] = (c <= lim) ? p0[r] : -INFINITY; p1[r] = (c + 32 <= lim) ? p1[r] : -INFINITY; }
    } };
struct NeedSel { unsigned mlo, mhi;
    __device__ __forceinline__ bool operator()(int t) const { const bool bit = ((t < 32 ? (mlo >> t) : (mhi >> (t - 32))) & 1u) != 0u; return __any(bit) != 0; } };

struct NoPre { __device__ __forceinline__ void operator()() const {} };
template <class Mask, class Need, int PRE = 0, class Pre = NoPre>
__device__ __forceinline__ void attn_stream(LAS unsigned char* L, const bf16* Kg, const bf16* Vg, size_t stride, int t_lo, int t_hi, const bf16x8 (&qr)[8],
                                            const Mask& mask, const Need& need, f32x16 (&o)[4], float& m_reg, float& l_reg, int tid, int lane, int wave, const Pre& pre = Pre() SSEC_PARM) {
    SSEC_INIT;
    asm volatile("" : "+v"(tid), "+v"(lane));
    const bool late = wave >= 4;
    const bf16* kp; const bf16* vp;
    { const int krow = 4 * wave + (lane >> 4), kch = (lane & 15) ^ (krow & 7);
      const int vsub = 2 * wave + (lane >> 5), vkk = 8 * (vsub >> 2) + ((lane & 31) >> 2), vk = (vkk & ~0xC) | ((vkk & 4) << 1) | ((vkk & 8) >> 1);
      kp = Kg + ((size_t)t_lo * 64 + krow) * stride + kch * 8;
      vp = Vg + ((size_t)t_lo * 64 + vk) * stride + (vsub & 3) * 32 + (lane & 3) * 8; }
    const size_t s32 = 32 * stride, s64 = 64 * stride;
#define ATT_DMA(kslot, vslot) do { \
        __builtin_amdgcn_global_load_lds((const unsigned*)kp, (LAS unsigned*)(L + A_K + (kslot) * SHM_T + wave * 1024), 16, 0, 0); \
        __builtin_amdgcn_global_load_lds((const unsigned*)(kp + s32), (LAS unsigned*)(L + A_K + (kslot) * SHM_T + 8192 + wave * 1024), 16, 0, 0); \
        __builtin_amdgcn_global_load_lds((const unsigned*)vp, (LAS unsigned*)(L + A_V + (vslot) * SHM_T + wave * 1024), 16, 0, 0); \
        __builtin_amdgcn_global_load_lds((const unsigned*)(vp + s32), (LAS unsigned*)(L + A_V + (vslot) * SHM_T + 8192 + wave * 1024), 16, 0, 0); \
        kp += s64; vp += s64; } while (0)
#define ATT_RESC() do { if (__any(alpha < 1.f)) { if (hi == 0) al_l[r32] = alpha; asm volatile("s_waitcnt lgkmcnt(0)" ::: "memory"); \
        _Pragma("unroll") for (int d = 0; d < 4; ++d) _Pragma("unroll") for (int r = 0; r < 16; ++r) o[d][r] *= al_l[crow(r, hi)]; } } while (0)
    ATT_DMA(0, 0);
    if (t_lo + 1 < t_hi) ATT_DMA(1, 1);
    pre();
    asm volatile("" : "+v"(lane));
    const int r32 = lane & 31, hi = lane >> 5;
    LAS float* al_l = (LAS float*)(L + A_WS + wave * 256) + 32;
    const int vb0 = (int)(unsigned)(uintptr_t)(L + A_V) + v_rd_base(lane);
    int ks = 0, vs = 0, vsp = 0; bool pend = false;
    bf16x8 pa0, pa1, pa2, pa3;
    for (int t = t_lo; t < t_hi; ++t) {
        if (PRE > 0 && t - t_lo < 2 && t + 1 < t_hi) asm volatile("s_waitcnt vmcnt(%0)" :: "n"(4 + PRE) : "memory");
        else if (t + 1 < t_hi) asm volatile("s_waitcnt vmcnt(4)" ::: "memory"); else asm volatile("s_waitcnt vmcnt(0)" ::: "memory");
        __builtin_amdgcn_s_barrier();
        asm volatile("" ::: "memory");
        SSEC(10);
        if (t + 2 < t_hi) { const int k2 = ks >= 1 ? ks - 1 : 2, v2 = vs >= 2 ? vs - 2 : vs + 2; ATT_DMA(k2, v2); }
        SSEC(11);
        if (pend) { pv_d0(o, vb0 + vsp * SHM_T, pa0, pa1, pa2, pa3); pend = false; }
        SSEC(12);
        if (need(t)) {
            f32x16 p0, p1; qkt(p0, p1, L + A_K + ks * SHM_T, qr, r32, hi);
            SSEC(13);
            if (!mask.interior(t)) mask(p0, p1, t, hi);
            float alpha;
            softmax_tile(p0, p1, m_reg, l_reg, alpha, pa0, pa1, pa2, pa3);
            ATT_RESC();
            SSEC(14);
            if (late) { pend = true; vsp = vs; }
            else pv_d0(o, vb0 + vs * SHM_T, pa0, pa1, pa2, pa3);
        }
        SSEC(15);
        ks = ks == 2 ? 0 : ks + 1; vs = (vs + 1) & 3;
    }
    if (pend) pv_d0(o, vb0 + vsp * SHM_T, pa0, pa1, pa2, pa3);
#undef ATT_DMA
#undef ATT_RESC
    asm volatile("s_waitcnt lgkmcnt(0)" ::: "memory");
    __builtin_amdgcn_s_barrier();
}
__device__ __forceinline__ int st_img(int wave) { return wave < 4 ? 2 * SHM_T + wave * 8192 : A_K + 2 * SHM_T + (wave - 4) * 8192; }
constexpr int ST_VMOPS = 8;
template <class RowPtr>
__device__ __forceinline__ void store_tile(LAS unsigned char* L, const f32x16 (&o)[4], const LAS float* sc_l, const RowPtr& rowptr, int lane, int wave) {
    const int r32 = lane & 31, hi = lane >> 5, odd = lane & 1;
    LAS unsigned char* img = L + st_img(wave);
#pragma unroll
    for (int rp = 0; rp < 8; ++rp) {
        const int r = 2 * rp;
        const float s0 = sc_l[crow(r, hi)], s1 = sc_l[crow(r + 1, hi)];
        const int row = crow(r + odd, hi);
#pragma unroll
        for (int d0 = 0; d0 < 4; ++d0) {
            const float a = o[d0][r] * s0, b = o[d0][r + 1] * s1;
            const float send = odd ? a : b;
            const float recv = __shfl_xor(send, 1);
            const unsigned w = cvtpk(odd ? recv : a, odd ? b : recv);
            *(LAS unsigned*)(img + row * 256 + (((32 * d0 + (r32 & ~1)) * 2) ^ ((row & 7) << 4))) = w;
        }
    }
    asm volatile("s_waitcnt lgkmcnt(0)" ::: "memory");
#pragma unroll
    for (int i = 0; i < 8; ++i) {
        const int row = 4 * i + (lane >> 4), ch = lane & 15;
        const v4u v = *(const LAS v4u*)(img + row * 256 + ((ch * 16) ^ ((row & 7) << 4)));
        *(v4u*)(rowptr(row) + ch * 8) = v;
    }
}
constexpr int STD_VMOPS = 32;
template <class RowPtr>
__device__ __forceinline__ void store_tile_direct(const f32x16 (&o)[4], const LAS float* sc_l, const RowPtr& rowptr, int lane) {
    const int r32 = lane & 31, hi = lane >> 5, odd = lane & 1;
#pragma unroll
    for (int rp = 0; rp < 8; ++rp) {
        const int r = 2 * rp;
        const float s0 = sc_l[crow(r, hi)], s1 = sc_l[crow(r + 1, hi)];
        bf16* prow = rowptr(crow(r + odd, hi)) + (r32 & ~1);
#pragma unroll
        for (int d0 = 0; d0 < 4; ++d0) {
            const float a = o[d0][r] * s0, b = o[d0][r + 1] * s1;
            const float send = odd ? a : b;
            const float recv = __shfl_xor(send, 1);
            *(unsigned*)(prow + 32 * d0) = cvtpk(odd ? recv : a, odd ? b : recv);
        }
    }
}
__device__ __forceinline__ float sigmoidf_(float v) { return 1.f / (1.f + __expf(-v)); }

__device__ __forceinline__ void dilated_unit(LAS unsigned char* L, const bf16* proj, bf16* outA, float* lse, int u, int tid, int lane, int wave SECPARM) {
    SEC_BEGIN(0);
    const int r32 = lane & 31, hi = lane >> 5;
    const int cfg = u >> 10, r = u & 1023, sh = 2 * cfg, dil = 1 << sh;
    const int b = r >> 8, h = (r >> 4) & 15, rb = r & 15, res = rb & (dil - 1), blk = rb >> sh;
    const int i0 = blk * 256, a = i0 + 32 * wave, qi = a + r32;
    const bf16* base = proj + (size_t)(b * SEQ + res) * LDP + h * 128;
    const size_t stride = (size_t)dil * LDP;
    const bf16* qrow = base + OFF_QA + (size_t)qi * stride + hi * 8;
    bf16x8 qr[8];
#pragma unroll
    for (int d0 = 0; d0 < 8; ++d0) qr[d0] = *(const bf16x8*)(qrow + d0 * 16);
    f32x16 o[4];
#pragma unroll
    for (int d = 0; d < 4; ++d)
#pragma unroll
        for (int e = 0; e < 16; ++e) o[d][e] = 0.f;
    float m_reg = -1e30f, l_reg = 0.f;
    const int t_lo = (i0 >= 128) ? (i0 - 128) >> 6 : 0, t_hi = (i0 >> 6) + 4;
    SEC();
    attn_stream(L, base + OFF_KA, base + OFF_VA, stride, t_lo, t_hi, qr, MaskBand{qi, 128, a, a + 31}, NeedBand{a, 128}, o, m_reg, l_reg, tid, lane, wave, NoPre() SSEC_ARG);
    SEC();
    LAS float* sc_l = (LAS float*)(L + A_WS + wave * 256);
    const int tok = qi * dil + res;
    if (hi == 0) { sc_l[r32] = 1.f / l_reg; lse[((size_t)cfg * T + (size_t)b * SEQ + tok) * 16 + h] = m_reg * QSCALE + __logf(l_reg); }
    asm volatile("s_waitcnt lgkmcnt(0)" ::: "memory");
    bf16* obase = outA + (size_t)cfg * T * 2048 + (size_t)(b * SEQ + res) * 2048 + h * 128;
    const size_t ostride = (size_t)dil * 2048;
    store_tile(L, o, sc_l, [&](int row) { return obase + (size_t)(a + row) * ostride; }, lane, wave);
    SEC();
}
__device__ __forceinline__ void window_unit(LAS unsigned char* L, const bf16* proj, bf16* outB, int u, int tid, int lane, int wave SECPARM) {
    SEC_BEGIN(1);
    const int r32 = lane & 31, hi = lane >> 5;
    const int b = u >> 8, g = (u >> 6) & 3, qb = u & 63, q0 = qb * 64;
    const int head = r32 >> 3, s = q0 + 8 * wave + (r32 & 7);
    const bf16* prow = proj + (size_t)(b * SEQ + s) * LDP;
    const bf16* qrow = prow + OFF_QB + (g * 4 + head) * 128 + hi * 8;
    bf16x8 qr[8];
#pragma unroll
    for (int d0 = 0; d0 < 8; ++d0) qr[d0] = *(const bf16x8*)(qrow + d0 * 16);
    f32x16 o[4];
#pragma unroll
    for (int d = 0; d < 4; ++d)
#pragma unroll
        for (int e = 0; e < 16; ++e) o[d][e] = 0.f;
    float m_reg = -1e30f, l_reg = 0.f;
    const bf16* kvb = proj + (size_t)(b * SEQ) * LDP + g * 128;
    attn_stream(L, kvb + OFF_KW, kvb + OFF_VW, (size_t)LDP, qb >= 8 ? qb - 8 : 0, qb + 1, qr, MaskBand{s, WIN - 1, q0 + 8 * wave, q0 + 8 * wave + 7}, NeedAll{}, o, m_reg, l_reg, tid, lane, wave);
    LAS float* sc_l = (LAS float*)(L + A_WS + wave * 256);
    if (hi == 0) sc_l[r32] = 1.f / l_reg;
    asm volatile("s_waitcnt lgkmcnt(0)" ::: "memory");
    bf16* obase = outB + (size_t)(b * SEQ + q0 + 8 * wave) * 2048 + g * 512;
    store_tile(L, o, sc_l, [&](int row) { return obase + (size_t)(row & 7) * 2048 + (row >> 3) * 128; }, lane, wave);
}
__device__ __forceinline__ bf16x8 hfrag(int c0, int j) {
    bf16x8 f; const int d = c0 - 4 * j;
#pragma unroll
    for (int jj = 0; jj < 8; ++jj) f[jj] = ((unsigned)(d + jj + 1) <= 4u) ? (short)0x3F80 : (short)0;
    return f;
}
__device__ __forceinline__ void nsa_unit(LAS unsigned char* L, const bf16* proj, const bf16* kc, const bf16* vc, bf16* outC, bf16* outS, int b, int g, int qb, int tid, int lane, int wave SECPARM) {
    SEC_BEGIN(2);
    asm volatile("" : "+v"(tid), "+v"(lane));
    const int r32 = lane & 31, hi = lane >> 5;
    const int q0 = qb * 64, head = r32 >> 3, s = q0 + 8 * wave + (r32 & 7);
    const bf16* prow = proj + (size_t)(b * SEQ + s) * LDP;
    const bf16* qrow = prow + OFF_QB + (g * 4 + head) * 128 + hi * 8;
    bf16x8 qr[8];
#pragma unroll
    for (int d0 = 0; d0 < 8; ++d0) qr[d0] = *(const bf16x8*)(qrow + d0 * 16);
    {
        int tid_ = tid; asm volatile("" : "+v"(tid_));
        const int sr = tid_ >> 4, sc = (tid_ & 15) * 8;
        const bf16* kcb = kc + (size_t)(b * GB + g) * 256 * 128 + (size_t)sr * 128 + sc; const bf16* vcb = vc + (size_t)(b * GB + g) * 256 * 128 + (size_t)sr * 128 + sc;
#pragma unroll
        for (int tc = 0; tc < 4; ++tc) {
            const bf16x8 k0 = *(const bf16x8*)(kcb + tc * 8192), k1 = *(const bf16x8*)(kcb + tc * 8192 + 4096), v0 = *(const bf16x8*)(vcb + tc * 8192), v1 = *(const bf16x8*)(vcb + tc * 8192 + 4096);
            *(LAS bf16x8*)(L + A_KC + tc * SHM_T + KSWZ(sr, sc * 2)) = k0; *(LAS bf16x8*)(L + A_KC + tc * SHM_T + KSWZ(32 + sr, sc * 2)) = k1;
            *(LAS bf16x8*)(L + A_VC + tc * SHM_T + v_st(sr, sc)) = v0; *(LAS bf16x8*)(L + A_VC + tc * SHM_T + v_st(32 + sr, sc)) = v1;
        }
    }
    __syncthreads();
    LAS float* impw = (LAS float*)(L + A_IMP) + wave * 512;
    LAS float* sc_l = (LAS float*)(L + A_WS + wave * 256);
    f32x16 o[4];
    float m = -1e30f, l = 0.f;
#pragma unroll 1
    for (int tc = 0; tc < 4; ++tc) {
        f32x16 p0, p1; qkt(p0, p1, L + A_KC + tc * SHM_T, qr, r32, hi);
        const int kb = tc * 64 + 4 * hi; float pmax = -INFINITY;
#pragma unroll
        for (int r = 0; r < 16; ++r) { const int c = kb + (r & 3) + 8 * (r >> 2);
            p0[r] = (16 * c + 31 <= s) ? p0[r] : -INFINITY; p1[r] = (16 * (c + 32) + 31 <= s) ? p1[r] : -INFINITY; pmax = fmaxf(pmax, fmaxf(p0[r], p1[r])); }
        pmax = xhalf_max(pmax);
        const float mn = fmaxf(m, pmax), alpha = __builtin_amdgcn_exp2f((m - mn) * C2), mnC = -mn * C2; m = mn;
        float ps = 0.f;
#pragma unroll
        for (int r = 0; r < 16; ++r) ps += __builtin_amdgcn_exp2f(fmaf(p0[r], C2, mnC)) + __builtin_amdgcn_exp2f(fmaf(p1[r], C2, mnC));
        l = l * alpha + xhalf_sum(ps);
    }
    const float inv_l = l > 0.f ? 1.f / l : 0.f, mC = -m * C2;
    SEC();
#ifndef T_NOPASS2
    {
        f32x16 imp0, imp1;
#pragma unroll
        for (int e = 0; e < 16; ++e) { imp0[e] = 0.f; imp1[e] = 0.f; }
#pragma unroll 1
        for (int tc = 0; tc < 4; ++tc) {
            f32x16 p0, p1; qkt(p0, p1, L + A_KC + tc * SHM_T, qr, r32, hi);
            const int kb = tc * 64 + 4 * hi;
#pragma unroll
            for (int r = 0; r < 16; ++r) { const int c = kb + (r & 3) + 8 * (r >> 2);
                p0[r] = (16 * c + 31 <= s) ? __builtin_amdgcn_exp2f(fmaf(p0[r], C2, mC)) * inv_l : 0.f;
                p1[r] = (16 * (c + 32) + 31 <= s) ? __builtin_amdgcn_exp2f(fmaf(p1[r], C2, mC)) * inv_l : 0.f; }
#pragma unroll
            for (int ks = 0; ks < 4; ++ks) {
                unsigned hh[4], ll[4];
#pragma unroll
                for (int i = 0; i < 4; ++i) { const int r = 8 * (ks & 1) + 2 * i; const float a = (ks < 2) ? p0[r] : p1[r], bq = (ks < 2) ? p0[r + 1] : p1[r + 1];
                    hh[i] = cvtpk(a, bq); ll[i] = cvtpk(a - __uint_as_float(hh[i] << 16), bq - __uint_as_float(hh[i] & 0xffff0000u)); }
                const bf16x8 pah = pks(hh[0], hh[1], hh[2], hh[3]), pal = pks(ll[0], ll[1], ll[2], ll[3]);
                int jv = r32; asm volatile("" : "+v"(jv));
                const int c0 = tc * 64 + ks * 16 + 8 * hi;
                if (tc <= 1) { const bf16x8 hf = hfrag(c0, jv); imp0 = __builtin_amdgcn_mfma_f32_32x32x16_bf16(pah, hf, imp0, 0, 0, 0); imp0 = __builtin_amdgcn_mfma_f32_32x32x16_bf16(pal, hf, imp0, 0, 0, 0); }
                if (tc >= 1) { const bf16x8 hf = hfrag(c0, 32 + jv); imp1 = __builtin_amdgcn_mfma_f32_32x32x16_bf16(pah, hf, imp1, 0, 0, 0); imp1 = __builtin_amdgcn_mfma_f32_32x32x16_bf16(pal, hf, imp1, 0, 0, 0); }
            }
        }
        LAS float* impw0 = (LAS float*)(L + A_IMP) + wave * 512;
#pragma unroll
        for (int e = 0; e < 4; ++e) {
            impw0[(e + 4 * hi) * 64 + r32] = (imp0[e] + imp0[4 + e]) + (imp0[8 + e] + imp0[12 + e]);
            impw0[(e + 4 * hi) * 64 + 32 + r32] = (imp1[e] + imp1[4 + e]) + (imp1[8 + e] + imp1[12 + e]);
        }
    }
#endif
    SEC();
    LAS unsigned* selw = (LAS unsigned*)(L + A_SEL) + wave * 16;
    {
        unsigned key[8], T[8];
#pragma unroll
        for (int qi = 0; qi < 8; ++qi) {
            const int sq = q0 + 8 * wave + qi, j = lane;
            const float iv = impw[qi * 64 + lane];
            const bool forced = (j == 0) || (j == qb) || (j == qb - 1);
            const bool valid = (j * 64 <= sq);
            const float score = forced ? 1e6f : (valid ? iv : -INFINITY);
            key[qi] = (score == -INFINITY) ? 0u : (__float_as_uint(fmaxf(score, 0.f)) + 1u); T[qi] = 0u;
        }
#pragma unroll
        for (int bb = 30; bb >= 0; --bb)
#pragma unroll
            for (int qi = 0; qi < 8; ++qi) { const unsigned cand = T[qi] | (1u << bb); if (__popcll(__ballot(key[qi] >= cand)) >= NSEL) T[qi] = cand; }
#pragma unroll
        for (int qi = 0; qi < 8; ++qi) {
            const unsigned long long gt = __ballot(key[qi] > T[qi]), eq = __ballot(key[qi] == T[qi]);
            const int need = NSEL - (int)__popcll(gt);
            const int below = (int)__builtin_amdgcn_mbcnt_hi((unsigned)(eq >> 32), __builtin_amdgcn_mbcnt_lo((unsigned)eq, 0u));
            const bool sel = (key[qi] > T[qi]) || (key[qi] == T[qi] && T[qi] != 0u && below < need);
            const unsigned long long mk = __ballot(sel);
            if (lane == 0) { selw[2 * qi] = (unsigned)mk; selw[2 * qi + 1] = (unsigned)(mk >> 32); }
        }
    }
    asm volatile("s_waitcnt lgkmcnt(0)" ::: "memory");
    const unsigned mlo = selw[2 * (r32 & 7)], mhi = selw[2 * (r32 & 7) + 1];
    SEC();
#pragma unroll
    for (int e = 0; e < 16; ++e) { o[0][e] = 0.f; o[1][e] = 0.f; o[2][e] = 0.f; o[3][e] = 0.f; }
    const int vbc = (int)(unsigned)(uintptr_t)(L + A_VC) + v_rd_base(lane);
#pragma unroll 1
    for (int tc = 0; tc < 4; ++tc) {
        f32x16 p0, p1; qkt(p0, p1, L + A_KC + tc * SHM_T, qr, r32, hi);
        const int kb = tc * 64 + 4 * hi;
#pragma unroll
        for (int r = 0; r < 16; ++r) { const int c = kb + (r & 3) + 8 * (r >> 2);
            p0[r] = (16 * c + 31 <= s) ? __builtin_amdgcn_exp2f(fmaf(p0[r], C2, mC)) * inv_l : 0.f;
            p1[r] = (16 * (c + 32) + 31 <= s) ? __builtin_amdgcn_exp2f(fmaf(p1[r], C2, mC)) * inv_l : 0.f; }
        const bf16x8 pa0 = pks(cvtpk(p0[0], p0[1]), cvtpk(p0[2], p0[3]), cvtpk(p0[4], p0[5]), cvtpk(p0[6], p0[7]));
        const bf16x8 pa1 = pks(cvtpk(p0[8], p0[9]), cvtpk(p0[10], p0[11]), cvtpk(p0[12], p0[13]), cvtpk(p0[14], p0[15]));
        const bf16x8 pa2 = pks(cvtpk(p1[0], p1[1]), cvtpk(p1[2], p1[3]), cvtpk(p1[4], p1[5]), cvtpk(p1[6], p1[7]));
        const bf16x8 pa3 = pks(cvtpk(p1[8], p1[9]), cvtpk(p1[10], p1[11]), cvtpk(p1[12], p1[13]), cvtpk(p1[14], p1[15]));
        pv_d0_lean(o, vbc + tc * SHM_T, pa0, pa1, pa2, pa3);
    }
    SEC();
    asm volatile("s_waitcnt lgkmcnt(0)" ::: "memory");
    __builtin_amdgcn_s_barrier();
    asm volatile("" ::: "memory");
    float m_reg = -1e30f, l_reg = 0.f;
    const bf16* kvb = proj + (size_t)(b * SEQ) * LDP + g * 128;
    bf16* obaseC = outC + (size_t)(b * SEQ + q0 + 8 * wave) * 2048 + g * 512;
    auto pre = [&]() {
        if (hi == 0) sc_l[r32] = 1.f;
        asm volatile("s_waitcnt lgkmcnt(0)" ::: "memory");
        store_tile_direct(o, sc_l, [&](int row) { return obaseC + (size_t)(row & 7) * 2048 + (row >> 3) * 128; }, lane);
#pragma unroll
        for (int d = 0; d < 4; ++d)
#pragma unroll
            for (int e = 0; e < 16; ++e) o[d][e] = 0.f;
    };
    attn_stream<MaskSel, NeedAll, STD_VMOPS>(L, kvb + OFF_KS, kvb + OFF_VS, (size_t)LDP, 0, qb + 1, qr, MaskSel{mlo, mhi, s, qb}, NeedAll{}, o, m_reg, l_reg, tid, lane, wave, pre SSEC_ARG);
    SEC();
    if (hi == 0) sc_l[r32] = 1.f / l_reg;
    asm volatile("s_waitcnt lgkmcnt(0)" ::: "memory");
    {
        bf16* obase = outS + (size_t)(b * SEQ + q0 + 8 * wave) * 2048 + g * 512;
        store_tile_direct(o, sc_l, [&](int row) { return obase + (size_t)(row & 7) * 2048 + (row >> 3) * 128; }, lane);
    }
    SEC();
}
__device__ __forceinline__ void compress_unit(LAS unsigned char* L, const bf16* proj, int coloff, const bf16* W1T, const float* bias1, const float* w2, bf16* outkc,
                                              int b, int g, int cblk, int tid, int lane, int wave) {
    const int r32 = lane & 31, hi = lane >> 5, n = wave & 3, th = wave >> 2;
    const int tokbase = 16 * (32 * cblk + r32);
    f32x16 acc;
#pragma unroll
    for (int e = 0; e < 16; ++e) acc[e] = 0.f;
    const bf16* arow = proj + (size_t)(b * SEQ) * LDP + coloff + g * 128 + hi * 8;
    const bf16* brow = W1T + (size_t)(32 * n + r32) * 4096 + hi * 8;
#pragma unroll 2
    for (int t = 16 * th; t < 16 * th + 16; ++t) {
        int tok = tokbase + t; tok = tok < SEQ ? tok : SEQ - 1;
        const bf16* ap = arow + (size_t)tok * LDP; const bf16* bp = brow + t * 128;
#pragma unroll
        for (int ks = 0; ks < 8; ++ks) acc = __builtin_amdgcn_mfma_f32_32x32x16_bf16(*(const bf16x8*)(ap + 16 * ks), *(const bf16x8*)(bp + 16 * ks), acc, 0, 0, 0);
    }
    LAS float* part = (LAS float*)L + th * 4096;
#pragma unroll
    for (int r = 0; r < 16; ++r) part[crow(r, hi) * 128 + 32 * n + r32] = acc[r];
    __syncthreads();
    LAS float* hid = (LAS float*)L + 8192;
    for (int e = tid; e < 4096; e += NWAVES * 64) { const float v = ((LAS float*)L)[e] + ((LAS float*)L)[4096 + e] + bias1[e & 127];
        const float uu = 0.7978845608028654f * (v + 0.044715f * v * v * v); hid[e] = 0.5f * v * (1.f + tanhf(uu)); }
    __syncthreads();
    const int j2 = tid & 127, cg = tid >> 7;
    float oacc[8];
#pragma unroll
    for (int k = 0; k < 8; ++k) oacc[k] = 0.f;
#pragma unroll 16
    for (int j = 0; j < 128; ++j) { const float w = w2[j * 128 + j2];
#pragma unroll
        for (int k = 0; k < 8; ++k) oacc[k] += hid[(cg * 8 + k) * 128 + j] * w; }
#pragma unroll
    for (int k = 0; k < 8; ++k) { const int c = 32 * cblk + cg * 8 + k; outkc[((size_t)(b * GB + g) * 256 + c) * 128 + j2] = (c < NC) ? (bf16)f2bf(oacc[k]) : (bf16)0; }
    __syncthreads();
}
__device__ __forceinline__ void gate_unit(LAS unsigned char* L, const bf16* h, const bf16* Wg, const float* rowsq0, float* gates, int row0, int tid, int lane, int wave) {
    const int r32 = lane & 31, hi = lane >> 5, rt = wave & 1, kq = wave >> 1;
    f32x16 acc0, acc1;
#pragma unroll
    for (int e = 0; e < 16; ++e) { acc0[e] = 0.f; acc1[e] = 0.f; }
    const bf16* ap = h + (size_t)(row0 + 32 * rt + r32) * D_MODEL + kq * 1024 + hi * 8;
    const bf16* bp0 = Wg + (size_t)r32 * D_MODEL + kq * 1024 + hi * 8; const bf16* bp1 = bp0 + (size_t)32 * D_MODEL;
#pragma unroll 8
    for (int ks = 0; ks < 64; ++ks) {
        const bf16x8 a = *(const bf16x8*)(ap + 16 * ks), b0 = *(const bf16x8*)(bp0 + 16 * ks), b1 = *(const bf16x8*)(bp1 + 16 * ks);
        acc0 = __builtin_amdgcn_mfma_f32_32x32x16_bf16(a, b0, acc0, 0, 0, 0); acc1 = __builtin_amdgcn_mfma_f32_32x32x16_bf16(a, b1, acc1, 0, 0, 0);
    }
    LAS float* part = (LAS float*)L + wave * 2048;
#pragma unroll
    for (int r = 0; r < 16; ++r) { part[crow(r, hi) * 64 + r32] = acc0[r]; part[crow(r, hi) * 64 + 32 + r32] = acc1[r]; }
    __syncthreads();
    for (int e = tid; e < 64 * 48; e += NWAVES * 64) { const int row = e / 48, col = e % 48, rtt = row >> 5, rr = row & 31;
        const LAS float* p = (const LAS float*)L + rtt * 2048 + rr * 64 + col;
        const float v = (p[0] + p[2 * 2048]) + (p[4 * 2048] + p[6 * 2048]);
        gates[(size_t)(row0 + row) * 48 + col] = sigmoidf_(v / sqrtf(rowsq0[row0 + row] * (1.f / 4096.f) + EPS)); }
    __syncthreads();
}
}
__device__ __forceinline__ float wave_sum(float v) {
#pragma unroll
    for (int o = 1; o < 64; o <<= 1) v += __shfl_xor(v, o);
    return v;
}
__device__ __forceinline__ float wave_max(float v) {
#pragma unroll
    for (int o = 1; o < 64; o <<= 1) v = fmaxf(v, __shfl_xor(v, o));
    return v;
}
__device__ __forceinline__ void p0_transpose_item(const float* W, int N, int nvalid, bf16* WT, size_t ldt, int k0, int n0, int drow0, LAS float* scr, int lane, const float* kgain = nullptr, float fp8scale = 0.f) {
    const int rr = lane >> 3, c4 = lane & 7, nn = n0 + 4 * c4; const bool ok = nn < nvalid;
    const GAS f32x4* src = (const GAS f32x4*)(W + (size_t)(k0 + rr) * N + nn);
    f32x4 v[8];
#pragma unroll
    for (int i = 0; i < 8; ++i) v[i] = ok ? src[(size_t)i * 2 * N] : (f32x4){0.f, 0.f, 0.f, 0.f};
#pragma unroll
    for (int i = 0; i < 8; ++i) { LAS float* d = scr + (8 * i + rr) * 33 + 4 * c4; const float gk = kgain ? kgain[k0 + 8 * i + rr] : 1.f; d[0] = v[i].x * gk; d[1] = v[i].y * gk; d[2] = v[i].z * gk; d[3] = v[i].w * gk; }
    LDS_WAIT(); asm volatile("" ::: "memory");
    const int c = lane & 7;
#pragma unroll
    for (int j = 0; j < 4; ++j) { const int n = (lane >> 3) + 8 * j; const LAS float* s = scr + (8 * c) * 33 + n;
        if (fp8scale != 0.f) {
            int w0 = __builtin_amdgcn_cvt_pk_fp8_f32(s[0 * 33] * fp8scale, s[1 * 33] * fp8scale, 0, false); w0 = __builtin_amdgcn_cvt_pk_fp8_f32(s[2 * 33] * fp8scale, s[3 * 33] * fp8scale, w0, true);
            int w1 = __builtin_amdgcn_cvt_pk_fp8_f32(s[4 * 33] * fp8scale, s[5 * 33] * fp8scale, 0, false); w1 = __builtin_amdgcn_cvt_pk_fp8_f32(s[6 * 33] * fp8scale, s[7 * 33] * fp8scale, w1, true);
            *(GAS v2u*)((GAS unsigned char*)WT + (size_t)(drow0 + n) * ldt + k0 + 8 * c) = (v2u){(unsigned)w0, (unsigned)w1};
        } else {
        v4u o; o.x = pk2(s[0 * 33], s[1 * 33]); o.y = pk2(s[2 * 33], s[3 * 33]); o.z = pk2(s[4 * 33], s[5 * 33]); o.w = pk2(s[6 * 33], s[7 * 33]);
        *(GAS v4u*)(WT + (size_t)(drow0 + n) * ldt + k0 + 8 * c) = o; } }
    LDS_WAIT(); asm volatile("" ::: "memory");
}
__device__ __forceinline__ void row_to_bf16_sumsq(const float* xrow, bf16* orow, float* sumsq, int lane) {
    const GAS f32x4* xr = (const GAS f32x4*)xrow + lane;
    f32x4 v[16]; float s = 0.f;
#pragma unroll
    for (int j = 0; j < 16; ++j) { v[j] = xr[64 * j]; s += (v[j].x * v[j].x + v[j].y * v[j].y) + (v[j].z * v[j].z + v[j].w * v[j].w); }
    s = wave_sum(s);
    if (lane == 0) *sumsq = s;
    GAS v2u* o8 = (GAS v2u*)orow + lane;
#pragma unroll
    for (int j = 0; j < 16; ++j) { v2u w; w.x = pk2(v[j].x, v[j].y); w.y = pk2(v[j].z, v[j].w); o8[64 * j] = w; }
}
__device__ __forceinline__ void rms_row_inplace(float* xrow, const float* g, int lane) {
    GAS f32x4* xr = (GAS f32x4*)xrow + lane; const GAS f32x4* gr = (const GAS f32x4*)g + lane;
    f32x4 v[16]; float s = 0.f;
#pragma unroll
    for (int j = 0; j < 16; ++j) { v[j] = xr[64 * j]; s += (v[j].x * v[j].x + v[j].y * v[j].y) + (v[j].z * v[j].z + v[j].w * v[j].w); }
    const float rs = 1.f / sqrtf(wave_sum(s) * (1.f / 4096.f) + EPS);
#pragma unroll
    for (int j = 0; j < 16; ++j) { const f32x4 gg = gr[64 * j]; xr[64 * j] = v[j] * rs * gg; }
}

struct Args { const float* in[17]; float* out; unsigned char* ws; float inv[16]; int ph_lo, ph_hi, li, pad; };
constexpr int N_PHASES = 10;
__global__ void __launch_bounds__(NWAVES * 64, 2) mega(Args args) {
    extern __shared__ __attribute__((aligned(16))) unsigned char lds[];
    LAS unsigned char* L = (LAS unsigned char*)lds;
    volatile LAS unsigned* MISC = (volatile LAS unsigned*)(L + MISC_OFF);
    const int tid = threadIdx.x, lane = tid & 63, wave = __builtin_amdgcn_readfirstlane(tid >> 6);
    const int G = gridDim.x;
    unsigned char* ws = args.ws;
    gu32* ctl = (gu32*)(ws + WS_CTL);
    const float* x = args.in[0]; const float* norm_attn = args.in[1]; const float* w_in = args.in[2];
    const float* w_out = args.in[11]; const float* norm_ffn = args.in[12]; const float* w_gate = args.in[13]; const float* w_up = args.in[14]; const float* w_down = args.in[15];
    const float* norm_final = args.in[16];
    float* out = args.out;
    bf16* Win_t = (bf16*)(ws + WS_WIN); bf16* Wout_t = (bf16*)(ws + WS_WOUT); bf16* Wgu_t = (bf16*)(ws + WS_WGU); bf16* Wdn_t = (bf16*)(ws + WS_WDN);
    bf16* bufA = (bf16*)(ws + WS_BUFA); bf16* proj = (bf16*)(ws + WS_PROJ); bf16* mixed = proj; bf16* act = proj;
    float* cs = (float*)(ws + WS_CS);
    const float* ck_pe = args.in[3]; const float* ck_w1 = args.in[4]; const float* ck_w2 = args.in[5];
    const float* cv_pe = args.in[6]; const float* cv_w1 = args.in[7]; const float* cv_w2 = args.in[8];
    const float* out_norm_a = args.in[9]; const float* out_norm_b = args.in[10];
    bf16* kcb = (bf16*)(ws + WS_KCB); bf16* vcb = (bf16*)(ws + WS_KCB + 1 * MiB);
    bf16* ckW1T = (bf16*)(ws + WS_W1T); bf16* cvW1T = (bf16*)(ws + WS_W1T + 1 * MiB);
    float* bias1 = (float*)(ws + WS_BIAS1); float* lse = (float*)(ws + WS_LSE);
    bf16* partA = (bf16*)out;
    bf16* partC = (bf16*)out + (size_t)3 * T * 2048;
    bf16* partS = (bf16*)(ws + WS_PART); bf16* partW = partS + (size_t)T * 2048;
    unsigned char* x1f8 = ws + WS_PART;
    float* rowsq = (float*)(ws + WS_ROWSQ);
    float* gates = (float*)(ws + WS_GATES);
    for (int u = tid; u < (LDS_BYTES - LDSCTL_OFF) / 4; u += NWAVES * 64) ((LAS unsigned*)(L + LDSCTL_OFF))[u] = 0u;
    __syncthreads();
    const int lo = args.ph_lo, hi = args.ph_hi;
    const bool one_launch = (hi - lo) > 1;
    XcdBarrier bar; bar.bar = (unsigned*)(ctl + CW_BAR) + args.li * XCD_BAR_WORDS; bar.x = 0; bar.st = nullptr;
    if (one_launch) bar = xcd_barrier_post((unsigned*)(ctl + CW_BAR) + args.li * XCD_BAR_WORDS, MISC + 8);
#ifndef MK_PH
#define MK_PH 0x3ff
#endif
#define IN(k) ((((MK_PH) >> (k)) & 1) && lo <= (k) && (k) < hi)
#ifdef MK_TPROBE
    unsigned long long ts_a = 0, ts_b = 0, sec_acc = 0; int ts_n = 0;
#define TS() do { unsigned long long t_; asm volatile("s_memrealtime %0\n\ts_waitcnt lgkmcnt(0)" : "=s"(t_) :: "memory"); if (ts_n == MK_TPROBE) ts_a = t_; if (ts_n == MK_TPROBE + 1) ts_b = t_; ++ts_n; } while (0)
#else
#define TS() do { } while (0)
#endif
    TS();
#define BOTH(k) (IN(k) && IN((k) + 1))
    const int gw = blockIdx.x * NWAVES + wave, NGW = G * NWAVES;

    if (IN(0)) {
        LAS float* scr = (LAS float*)(L + RING_OFF + wave * 16384);
        constexpr int I_IN = 64 * 360, I_OUT = 64 * 128, I_G = 64 * 344, I_D = 172 * 128, I_W1 = 64 * 4;
        constexpr int NITEMS = I_IN + I_OUT + 2 * I_G + I_D + 2 * I_W1;
        for (int it = gw; it < NITEMS; it += NGW) {
            int r = it;
            if (r < I_IN) { const int kb = r / 360, nb = r % 360; p0_transpose_item(w_in, D_IN, D_IN, Win_t, 4096, 64 * kb, 32 * nb, 32 * nb, scr, lane, norm_attn); continue; } r -= I_IN;
            if (r < I_OUT) { const int kb = r / 128, nb = r % 128; p0_transpose_item(w_out, 4096, 4096, Wout_t, 4096, 64 * kb, 32 * nb, 32 * nb, scr, lane); continue; } r -= I_OUT;
            if (r < I_G) { const int kb = r / 344, nb = r % 344, n0 = 32 * nb; p0_transpose_item(w_gate, D_FF, D_FF, Wgu_t, 4096, 64 * kb, n0, 256 * (n0 >> 7) + (n0 & 127), scr, lane, norm_ffn, WGU_SCALE); continue; } r -= I_G;
            if (r < I_G) { const int kb = r / 344, nb = r % 344, n0 = 32 * nb; p0_transpose_item(w_up, D_FF, D_FF, Wgu_t, 4096, 64 * kb, n0, 256 * (n0 >> 7) + 128 + (n0 & 127), scr, lane, norm_ffn, WGU_SCALE); continue; } r -= I_G;
            if (r < I_D) { const int kb = r / 128, nb = r % 128; p0_transpose_item(w_down, 4096, 4096, Wdn_t, D_FF, 64 * kb, 32 * nb, 32 * nb, scr, lane, nullptr, WDN_SCALE); continue; } r -= I_D;
            if (r < I_W1) { const int kb = r / 4, nb = r % 4; p0_transpose_item(ck_w1, 128, 128, ckW1T, 4096, 64 * kb, 32 * nb, 32 * nb, scr, lane); continue; } r -= I_W1;
            { const int kb = r / 4, nb = r % 4; p0_transpose_item(cv_w1, 128, 128, cvW1T, 4096, 64 * kb, 32 * nb, 32 * nb, scr, lane); }
        }
        for (int o = gw; o < 256; o += NGW) {
            const int which = o >> 7, j = o & 127; const float* pe = which ? cv_pe : ck_pe; const float* w1 = which ? cv_w1 : ck_w1;
            float a = 0.f;
            for (int i = lane; i < 4096; i += 64) a += pe[i] * w1[(size_t)i * 128 + j];
            a = wave_sum(a);
            if (lane == 0) bias1[o] = a;
        }
        for (int idx = blockIdx.x * (NWAVES * 64) + tid; idx < SEQ * 16; idx += G * NWAVES * 64) {
            const int s = idx >> 4, i = idx & 15; const float ang = (float)s * args.inv[i]; const double a = (double)ang;
            cs[2 * idx] = (float)cos(a); cs[2 * idx + 1] = (float)sin(a);
        }
        for (int m = gw; m < T; m += NGW) row_to_bf16_sumsq(x + (size_t)m * D_MODEL, bufA + (size_t)m * D_MODEL, rowsq + 2 * T + m, lane);
        for (int i = blockIdx.x * (NWAVES * 64) + tid; i < 2 * T; i += G * NWAVES * 64) rowsq[i] = 0.f;
        if (BOTH(0)) xcd_barrier(bar);
        TS();
    }
    if (IN(1)) {
        pg8::Gemm g{bufA, Win_t, T, OFF_GL, D_MODEL}; pg8::StaticOrder S; S.init(T, OFF_GL, G, (int)blockIdx.x);
        pg8::EpiProj E{proj, LDP, cs, rowsq + 2 * T, 1.f / 4096.f, EPS};
        pg8::gemm_phase<pg8::EpiProj, pg8::StaticOrder, true, true>(L + RING_OFF, g, S, E);
        if (BOTH(1)) xcd_barrier(bar);
        TS();
    }
    if (IN(2)) {
        for (int cu = blockIdx.x; cu < 256; cu += G) { const int which = cu >> 7, r = cu & 127;
            att::compress_unit(L, proj, which ? OFF_VC : OFF_KC, which ? cvW1T : ckW1T, bias1 + which * 128, which ? cv_w2 : ck_w2, which ? vcb : kcb, r >> 5, (r >> 3) & 3, r & 7, tid, lane, wave); }
        TS();
        for (int u = blockIdx.x; u < T / 64; u += G) att::gate_unit(L, bufA, Win_t + (size_t)OFF_GL * D_MODEL, rowsq + 2 * T, gates, 64 * u, tid, lane, wave);
        TS();
        for (int u = blockIdx.x; u < 1024; u += G) att::window_unit(L, proj, partW, u, tid, lane, wave SECARG);
        TS();
        for (int u = blockIdx.x; u < 3072; u += G) att::dilated_unit(L, proj, partA, lse, u, tid, lane, wave SECARG);
        TS();
        if (BOTH(2)) xcd_barrier(bar);
        TS();
    }
    if (IN(3)) {
        for (int rd = 0; rd * G < 1024; ++rd) {
            const int idx = (rd & 1) ? rd * G + (G - 1 - (int)blockIdx.x) : rd * G + (int)blockIdx.x;
            if (idx < 1024) { const int qb = 63 - (idx >> 4), bg = idx & 15; att::nsa_unit(L, proj, kcb, vcb, partC, partS, bg >> 2, bg & 3, qb, tid, lane, wave SECARG); }
        }
        TS();
        if (BOTH(3)) xcd_barrier(bar);
        TS();
    }
    if (IN(4)) {
        for (int it = gw; it < 2 * T; it += NGW) {
            const int m = it >> 1, grp = it & 1;
            float ov[32]; float ss = 0.f;
            if (grp == 0) {
#pragma unroll
                for (int k = 0; k < 4; ++k) {
                    const int ch = lane + 64 * k, head = ch >> 4;
                    const float l0 = lse[((size_t)0 * T + m) * 16 + head], l1 = lse[((size_t)1 * T + m) * 16 + head], l2 = lse[((size_t)2 * T + m) * 16 + head];
                    const float mx = fmaxf(l0, fmaxf(l1, l2)); const float e0 = __expf(l0 - mx), e1 = __expf(l1 - mx), e2 = __expf(l2 - mx); const float inv = 1.f / (e0 + e1 + e2);
                    const float w0 = e0 * inv, w1 = e1 * inv, w2 = e2 * inv;
                    const size_t off = (size_t)m * 2048 + 8 * ch;
                    const v4u x0 = *(const v4u*)(partA + off), x1 = *(const v4u*)(partA + (size_t)T * 2048 + off), x2 = *(const v4u*)(partA + (size_t)2 * T * 2048 + off);
#pragma unroll
                    for (int e = 0; e < 4; ++e) {
                        const float alo = w0 * __uint_as_float(x0[e] << 16) + w1 * __uint_as_float(x1[e] << 16) + w2 * __uint_as_float(x2[e] << 16);
                        const float ahi = w0 * __uint_as_float(x0[e] & 0xffff0000u) + w1 * __uint_as_float(x1[e] & 0xffff0000u) + w2 * __uint_as_float(x2[e] & 0xffff0000u);
                        ov[8 * k + 2 * e] = alo; ov[8 * k + 2 * e + 1] = ahi; ss += alo * alo + ahi * ahi;
                    }
                }
            } else {
#pragma unroll
                for (int k = 0; k < 4; ++k) {
                    const int ch = lane + 64 * k, head = ch >> 4;
                    const size_t off = (size_t)m * 2048 + 8 * ch;
                    const float gc = gates[(size_t)m * 48 + head * 3], gs = gates[(size_t)m * 48 + head * 3 + 1], gw_ = gates[(size_t)m * 48 + head * 3 + 2];
                    const v4u y0 = *(const v4u*)(partC + off), y1 = *(const v4u*)(partS + off), y2 = *(const v4u*)(partW + off);
#pragma unroll
                    for (int e = 0; e < 4; ++e) {
                        const float blo = gc * __uint_as_float(y0[e] << 16) + gs * __uint_as_float(y1[e] << 16) + gw_ * __uint_as_float(y2[e] << 16);
                        const float bhi = gc * __uint_as_float(y0[e] & 0xffff0000u) + gs * __uint_as_float(y1[e] & 0xffff0000u) + gw_ * __uint_as_float(y2[e] & 0xffff0000u);
                        ov[8 * k + 2 * e] = blo; ov[8 * k + 2 * e + 1] = bhi; ss += blo * blo + bhi * bhi;
                    }
                }
            }
            const float rs = 1.f / sqrtf(wave_sum(ss) * (1.f / 2048.f) + EPS);
            const float* gn = grp ? out_norm_b : out_norm_a;
#pragma unroll
            for (int k = 0; k < 4; ++k) {
                const int ch = lane + 64 * k;
                const f32x4 g0 = *(const f32x4*)(gn + 8 * ch), g1 = *(const f32x4*)(gn + 8 * ch + 4);
                v4u w;
                w.x = pk2(ov[8 * k + 0] * rs * g0.x, ov[8 * k + 1] * rs * g0.y); w.y = pk2(ov[8 * k + 2] * rs * g0.z, ov[8 * k + 3] * rs * g0.w);
                w.z = pk2(ov[8 * k + 4] * rs * g1.x, ov[8 * k + 5] * rs * g1.y); w.w = pk2(ov[8 * k + 6] * rs * g1.z, ov[8 * k + 7] * rs * g1.w);
                *(v4u*)(mixed + (size_t)m * D_MODEL + grp * 2048 + 8 * ch) = w;
            }
        }
        if (BOTH(4)) xcd_barrier(bar);
        TS();
    }

    if (IN(5)) {
        pg8::Gemm g{mixed, Wout_t, T, D_MODEL, D_MODEL}; pg8::StaticOrder S; S.init(T, D_MODEL, G, (int)blockIdx.x);
        pg8::EpiResid<true> E{bufA, bufA, rowsq, x1f8, D_MODEL, 1.f};
        pg8::gemm_phase<pg8::EpiResid<true>, pg8::StaticOrder, true, true>(L + RING_OFF, g, S, E);
        if (IN(7)) xcd_barrier(bar);
        TS();
    }
    if (IN(7)) {
        pg8::Gemm g{(const bf16*)x1f8, Wgu_t, T, NGU, D_MODEL / 2}; pg8::StaticOrder S; S.init(T, NGU, G, (int)blockIdx.x);
        pg8::EpiSwiglu<true> E{act, D_FF, rowsq, 1.f / 4096.f, EPS, 1.f / WGU_SCALE};
        pg8::gemm_phase<pg8::EpiSwiglu<true>, pg8::StaticOrder, true, true, true>(L + RING_OFF, g, S, E);
        if (BOTH(7)) xcd_barrier(bar);
        TS();
    }
    if (IN(8)) {
        pg8::Gemm g{act, Wdn_t, T, D_MODEL, D_FF / 2}; pg8::StaticOrder S; S.init(T, D_MODEL, G, (int)blockIdx.x);
        pg8::EpiResid<true> E{bufA, bufA, rowsq + T, nullptr, D_MODEL, 1.f / WDN_SCALE};
        pg8::gemm_phase<pg8::EpiResid<true>, pg8::StaticOrder, true, P8_SP2, true>(L + RING_OFF, g, S, E);
        if (BOTH(8)) xcd_barrier(bar);
        TS();
    }
    if (IN(9)) {
        for (int m = gw; m < T; m += NGW) {
            const float rs = 1.f / sqrtf(rowsq[T + m] * (1.f / 4096.f) + EPS);
            const GAS v2u* xr = (const GAS v2u*)(bufA + (size_t)m * D_MODEL) + lane; const GAS f32x4* gr = (const GAS f32x4*)norm_final + lane; GAS f32x4* orow = (GAS f32x4*)(out + (size_t)m * D_MODEL) + lane;
            v2u v[16];
#pragma unroll
            for (int j = 0; j < 16; ++j) v[j] = xr[64 * j];
#pragma unroll
            for (int j = 0; j < 16; ++j) { const f32x4 gg = gr[64 * j];
                orow[64 * j] = (f32x4){__uint_as_float(v[j].x << 16) * rs * gg.x, __uint_as_float(v[j].x & 0xffff0000u) * rs * gg.y, __uint_as_float(v[j].y << 16) * rs * gg.z, __uint_as_float(v[j].y & 0xffff0000u) * rs * gg.w}; }
        }
    }
    TS();
#ifdef MK_TPROBE
    if (blockIdx.x == 0) {
        unsigned long long d = 4ull * (MK_TSEC >= 0 ? sec_acc : (ts_b - ts_a)); if (d > 2000000ull) d = 2000000ull;
        unsigned long long t0_; asm volatile("s_memrealtime %0\n\ts_waitcnt lgkmcnt(0)" : "=s"(t0_) :: "memory");
        for (;;) { unsigned long long t1_; asm volatile("s_memrealtime %0\n\ts_waitcnt lgkmcnt(0)" : "=s"(t1_) :: "memory"); if (t1_ - t0_ >= d) break; __builtin_amdgcn_s_sleep(8); }
    }
#endif
#undef IN
#undef BOTH
}

extern "C" void kernel_launch(void* const* d_in, const int* in_sizes, int n_in, void* d_out, int out_size, void* d_ws, size_t ws_size, hipStream_t stream) {
    static int grid = 0;
    if (grid == 0) {
        if (n_in != 17 || out_size != T * D_MODEL || ws_size < WS_END) { fprintf(stderr, "kernel_launch: unexpected shapes (n_in %d out %d ws %zu); nothing launched\n", n_in, out_size, ws_size); grid = -1; return; }
        int dev = 0, cus = 0, per_cu = 0;
        if (hipGetDevice(&dev) != hipSuccess || hipDeviceGetAttribute(&cus, hipDeviceAttributeMultiprocessorCount, dev) != hipSuccess) { grid = -1; return; }
        if (hipFuncSetAttribute((const void*)mega, hipFuncAttributeMaxDynamicSharedMemorySize, LDS_BYTES) != hipSuccess) { fprintf(stderr, "kernel_launch: hipFuncSetAttribute failed\n"); grid = -1; return; }
        if (hipOccupancyMaxActiveBlocksPerMultiprocessor(&per_cu, (const void*)mega, NWAVES * 64, LDS_BYTES) != hipSuccess || per_cu < 1)
            fprintf(stderr, "kernel_launch: note: occupancy query reports %d workgroups per CU\n", per_cu);
        (void)hipGetLastError();
        grid = cus;
    }
    if (grid < 0) return;
    if (hipMemsetAsync((char*)d_ws + WS_CTL, 0, CTL_ZERO_BYTES, stream) != hipSuccess) return;
    Args a{};
    for (int i = 0; i < 17; ++i) a.in[i] = (const float*)d_in[i];
    a.out = (float*)d_out; a.ws = (unsigned char*)d_ws;
    for (int i = 0; i < 16; ++i) a.inv[i] = (float)pow(500000.0, -(double)(2 * i) / 32.0);
    unsigned char* ws = (unsigned char*)d_ws;
    int n_launch = 0;
    auto launch = [&](int lo, int hi) { a.ph_lo = lo; a.ph_hi = hi; a.li = n_launch++; hipLaunchKernelGGL(mega, dim3(grid), dim3(NWAVES * 64), LDS_BYTES, stream, a); };
#if MK_BUILD == 2
    for (int ph = 0; ph < N_PHASES; ++ph) launch(ph, ph + 1);
#elif MK_BUILD == 3
    launch(0, N_PHASES);
#else
#if MK_PROBE == 0
    launch(0, N_PHASES); launch(0, 1);
#elif MK_PROBE == 7
    launch(0, N_PHASES); launch(7, 8);
#else
    launch(0, MK_PROBE + 1); launch(MK_PROBE, MK_PROBE + 1); launch(MK_PROBE + 1, N_PHASES);
#endif
#endif
    const hipError_t le = hipPeekAtLastError();
    if (le != hipSuccess) fprintf(stderr, "kernel_launch: launch failed: %s\n", hipGetErrorName(le));
}
```

```cpp
#include <hip/hip_runtime.h>
#include <cstdio>
#include <cstdint>
#include <math.h>

#ifndef MK_TSEC
#define MK_TSEC -1
#endif
#ifndef MK_TWAVE
#define MK_TWAVE 0
#endif
#ifndef MK_TUNIT
#define MK_TUNIT 2
#endif
#ifndef MK_BUILD
#define MK_BUILD 3
#endif
namespace pg8 {
#define PG8_LAS __attribute__((address_space(3)))
typedef unsigned short bf16_t;
typedef short bf16x8 __attribute__((ext_vector_type(8)));
typedef float f32x4 __attribute__((ext_vector_type(4)));
typedef unsigned u32x4 __attribute__((ext_vector_type(4)));
constexpr int BM = 256, BK = 64, HALF = 128, HTB = HALF * BK * 2  , STAGE_BYTES = 8 * HTB, NXCD = 8, WGM = 8;

__host__ __device__ __forceinline__ int lds_byte(int r, int c) { const int st = (r >> 4) * 2 + (c >> 5), rr = r & 15, cc = c & 31, ob = rr * 64 + cc * 2; return st * 1024 + (ob ^ (((ob >> 9) & 1) << 5)); }
__host__ __device__ __forceinline__ void stage_rc(int b, int& R, int& C) { const int st = b / 1024, sb = b % 1024, swz = sb ^ (((sb >> 9) & 1) << 5); R = (st >> 1) * 16 + swz / 64; C = (st & 1) * 32 + (swz % 64) / 2; }
__host__ __device__ __forceinline__ int perm32(int rho) { const int n = rho >> 4, i = rho & 15; return 8 * (i >> 2) + 4 * n + (i & 3); }

struct Unit { int pm, pn; };
struct Gemm { const bf16_t* A; const bf16_t* Bt; int M, N, K; };

struct StaticOrder {
    int nM, nN, nwg, G, c;
    __host__ __device__ void init(int M, int N, int G_, int c_) { nM = M / BM; nN = N / BM; nwg = nM * nN; G = G_; c = c_; }
    __host__ __device__ bool next(int i, Unit& u) const {
        const long L = (long)i * G + c; if (L >= nwg) return false;
        int wgid = (int)L; { const int q = nwg / NXCD, r = nwg % NXCD, xcd = wgid % NXCD, off = wgid / NXCD; wgid = (xcd < r ? xcd * (q + 1) : r * (q + 1) + (xcd - r) * q) + off; }
        const int nig = WGM * nN, gid = wgid / nig, fm = gid * WGM, gsz = (nM - fm) < WGM ? (nM - fm) : WGM;
        u.pm = fm + ((wgid % nig) % gsz); u.pn = (wgid % nig) / gsz; return true;
    }
    __device__ __forceinline__ void a_ready(const Unit&) const {}
    __device__ __forceinline__ void done(const Unit&) const {}
};
__device__ __forceinline__ unsigned cvt_pk_bf16(float lo, float hi) { unsigned r; asm volatile("v_cvt_pk_bf16_f32 %0, %1, %2" : "=v"(r) : "v"(lo), "v"(hi)); return r; }
typedef unsigned u32x4 __attribute__((ext_vector_type(4)));
typedef unsigned u32x2 __attribute__((ext_vector_type(2)));
struct EpiProj {
    static constexpr bool PERM = true, AFTER_DRAIN = false;
    bf16_t* O; int ldc; const float* cs; const float* rowsq; float inv_k, eps;
    __device__ __forceinline__ void operator()(const f32x4 (&acc)[2][2][4][2], const Unit& u, int wr, int wc, int fr, int fq) const {
        const int row0 = u.pm * BM + wr * 64 + fr;
        const int col0 = u.pn * BM + wc * 32 + 8 * fq;
#pragma unroll
        for (int bj = 0; bj < 2; ++bj) {
            const int hd = u.pn * 2 + bj;
            const bool rope = (wc == 0) && (hd < 32 || (hd >= 48 && hd < 68) || (hd >= 72 && hd < 76) || (hd >= 80 && hd < 84));
#pragma unroll
            for (int ai = 0; ai < 2; ++ai)
#pragma unroll
                for (int m = 0; m < 4; ++m) {
                    const int row = row0 + ai * HALF + m * 16;
                    const float rs = 1.f / sqrtf(rowsq[row] * inv_k + eps);
                    f32x4 v0 = acc[ai][bj][m][0] * rs, v1 = acc[ai][bj][m][1] * rs;
                    if (rope) {
                        f32x4 w0, w1;
#pragma unroll
                        for (int e = 0; e < 4; ++e) { w0[e] = __shfl_xor(v0[e], 32); w1[e] = __shfl_xor(v1[e], 32); }
                        const float* c = cs + ((size_t)(row & 4095) * 16 + 8 * (fq & 1)) * 2;
                        const f32x4 c0 = *(const f32x4*)c, c1 = *(const f32x4*)(c + 4), c2 = *(const f32x4*)(c + 8), c3 = *(const f32x4*)(c + 12);
                        const float cosv[8] = {c0[0], c0[2], c1[0], c1[2], c2[0], c2[2], c3[0], c3[2]};
                        const float sinv[8] = {c0[1], c0[3], c1[1], c1[3], c2[1], c2[3], c3[1], c3[3]};
                        if (fq < 2) {
#pragma unroll
                            for (int e = 0; e < 4; ++e) { v0[e] = v0[e] * cosv[e] - w0[e] * sinv[e]; v1[e] = v1[e] * cosv[4 + e] - w1[e] * sinv[4 + e]; }
                        } else {
#pragma unroll
                            for (int e = 0; e < 4; ++e) { v0[e] = w0[e] * sinv[e] + v0[e] * cosv[e]; v1[e] = w1[e] * sinv[4 + e] + v1[e] * cosv[4 + e]; }
                        }
                    }
                    u32x4 w; w.x = cvt_pk_bf16(v0[0], v0[1]); w.y = cvt_pk_bf16(v0[2], v0[3]); w.z = cvt_pk_bf16(v1[0], v1[1]); w.w = cvt_pk_bf16(v1[2], v1[3]);
                    *(u32x4*)(O + (size_t)row * ldc + col0 + bj * HALF) = w;
                }
        }
    }
};
template <bool R_BF16> struct EpiResid {
    static constexpr bool PERM = true, AFTER_DRAIN = false;
    const void* R; bf16_t* Ob; float* rowsq; unsigned char* O8; int ldc; float ascale;
    __device__ __forceinline__ void operator()(const f32x4 (&acc)[2][2][4][2], const Unit& u, int wr, int wc, int fr, int fq) const {
        const int row0 = u.pm * BM + wr * 64 + fr;
        const int col0 = u.pn * BM + wc * 32 + 8 * fq;
#pragma unroll
        for (int ai = 0; ai < 2; ++ai)
#pragma unroll
            for (int m = 0; m < 4; ++m) {
                const size_t ro = (size_t)(row0 + ai * HALF + m * 16) * ldc + col0;
                float ss = 0.f;
#pragma unroll
                for (int bj = 0; bj < 2; ++bj) {
                    f32x4 r0, r1;
                    if constexpr (R_BF16) { const u32x4 rb = *(const u32x4*)((const bf16_t*)R + ro + bj * HALF);
                        r0 = (f32x4){__builtin_bit_cast(float, rb.x << 16), __builtin_bit_cast(float, rb.x & 0xffff0000u), __builtin_bit_cast(float, rb.y << 16), __builtin_bit_cast(float, rb.y & 0xffff0000u)};
                        r1 = (f32x4){__builtin_bit_cast(float, rb.z << 16), __builtin_bit_cast(float, rb.z & 0xffff0000u), __builtin_bit_cast(float, rb.w << 16), __builtin_bit_cast(float, rb.w & 0xffff0000u)}; }
                    else { r0 = *(const f32x4*)((const float*)R + ro + bj * HALF); r1 = *(const f32x4*)((const float*)R + ro + bj * HALF + 4); }
                    const f32x4 o0 = r0 + acc[ai][bj][m][0] * ascale, o1 = r1 + acc[ai][bj][m][1] * ascale;
                    u32x4 w; w.x = cvt_pk_bf16(o0[0], o0[1]); w.y = cvt_pk_bf16(o0[2], o0[3]); w.z = cvt_pk_bf16(o1[0], o1[1]); w.w = cvt_pk_bf16(o1[2], o1[3]);
                    *(u32x4*)(Ob + ro + bj * HALF) = w;
                    if (O8) { int w0 = __builtin_amdgcn_cvt_pk_fp8_f32(o0[0], o0[1], 0, false); w0 = __builtin_amdgcn_cvt_pk_fp8_f32(o0[2], o0[3], w0, true);
                        int w1 = __builtin_amdgcn_cvt_pk_fp8_f32(o1[0], o1[1], 0, false); w1 = __builtin_amdgcn_cvt_pk_fp8_f32(o1[2], o1[3], w1, true);
                        *(u32x2*)(O8 + ro + bj * HALF) = (u32x2){(unsigned)w0, (unsigned)w1}; }
                    ss += (o0[0] * o0[0] + o0[1] * o0[1]) + (o0[2] * o0[2] + o0[3] * o0[3]) + (o1[0] * o1[0] + o1[1] * o1[1]) + (o1[2] * o1[2] + o1[3] * o1[3]);
                }
                ss += __shfl_xor(ss, 16); ss += __shfl_xor(ss, 32); if (fq == 0) atomicAdd(rowsq + (row0 + ai * HALF + m * 16), ss);
            }
    }
};
template <bool FP8OUT> struct EpiSwiglu {
    static constexpr bool PERM = true, AFTER_DRAIN = false;
    bf16_t* O; int ldc; const float* rowsq; float inv_k, eps, ascale;
    __device__ __forceinline__ static float silu_mul(float g, float uu) { return g * __builtin_amdgcn_rcpf(1.f + __builtin_amdgcn_exp2f(-1.4426950408889634f * g)) * uu; }
    __device__ __forceinline__ void operator()(const f32x4 (&acc)[2][2][4][2], const Unit& u, int wr, int wc, int fr, int fq) const {
        const int row0 = u.pm * BM + wr * 64 + fr;
        const int col0 = u.pn * HALF + wc * 32 + 8 * fq;
#pragma unroll
        for (int ai = 0; ai < 2; ++ai)
#pragma unroll
            for (int m = 0; m < 4; ++m) {
                const float rs = ascale / sqrtf(rowsq[row0 + ai * HALF + m * 16] * inv_k + eps);
                const f32x4 g0 = acc[ai][0][m][0] * rs, g1 = acc[ai][0][m][1] * rs, u0 = acc[ai][1][m][0] * rs, u1 = acc[ai][1][m][1] * rs;
                if constexpr (FP8OUT) {
                    int w0 = __builtin_amdgcn_cvt_pk_fp8_f32(silu_mul(g0[0], u0[0]), silu_mul(g0[1], u0[1]), 0, false); w0 = __builtin_amdgcn_cvt_pk_fp8_f32(silu_mul(g0[2], u0[2]), silu_mul(g0[3], u0[3]), w0, true);
                    int w1 = __builtin_amdgcn_cvt_pk_fp8_f32(silu_mul(g1[0], u1[0]), silu_mul(g1[1], u1[1]), 0, false); w1 = __builtin_amdgcn_cvt_pk_fp8_f32(silu_mul(g1[2], u1[2]), silu_mul(g1[3], u1[3]), w1, true);
                    *(u32x2*)((unsigned char*)O + (size_t)(row0 + ai * HALF + m * 16) * ldc + col0) = (u32x2){(unsigned)w0, (unsigned)w1};
                } else {
                u32x4 w;
                w.x = cvt_pk_bf16(silu_mul(g0[0], u0[0]), silu_mul(g0[1], u0[1])); w.y = cvt_pk_bf16(silu_mul(g0[2], u0[2]), silu_mul(g0[3], u0[3]));
                w.z = cvt_pk_bf16(silu_mul(g1[0], u1[0]), silu_mul(g1[1], u1[1])); w.w = cvt_pk_bf16(silu_mul(g1[2], u1[2]), silu_mul(g1[3], u1[3]));
                *(u32x4*)(O + (size_t)(row0 + ai * HALF + m * 16) * ldc + col0) = w; }
            }
    }
};
typedef int v8i_t __attribute__((ext_vector_type(8)));
typedef int v4i_t __attribute__((ext_vector_type(4)));
__device__ __forceinline__ v8i_t cat8(bf16x8 lo, bf16x8 hi) { const v4i_t a = __builtin_bit_cast(v4i_t, lo), b = __builtin_bit_cast(v4i_t, hi); return __builtin_shufflevector(a, b, 0, 1, 2, 3, 4, 5, 6, 7); }
template <class Epi, class Sched, bool ALIGN_EPI = false, bool SP2 = false, bool FP8 = false>
__device__ __forceinline__ void gemm_phase(PG8_LAS unsigned char* lds, const Gemm g, const Sched& S, const Epi& E) {
    const int tid = threadIdx.x, wid = __builtin_amdgcn_readfirstlane(tid >> 6), lane = tid & 63, wr = wid >> 2, wc = wid & 3, fr = lane & 15, fq = lane >> 4;
    const int K = g.K, nt = K / BK;
    unsigned voffA[2], voffB[2];
#pragma unroll
    for (int i = 0; i < 2; ++i) { int R, C; stage_rc(tid * 16 + i * 8192, R, C); const int Rb = Epi::PERM ? ((R & ~31) + perm32(R & 31)) : R;
        voffA[i] = (unsigned)(R * K + C) * 2u; voffB[i] = (unsigned)(Rb * K + C) * 2u; }
    const size_t kstep = (size_t)(BK * 2);
    const size_t hstep = (size_t)HALF * K * 2;
    const size_t tstep = 2 * hstep;
    const unsigned ldsw = (unsigned)wid * 1024u;
    const int aoff = lds_byte(wr * 64 + fr, fq * 8), boff = lds_byte(wc * 32 + fr, fq * 8);
#define PG8_SA(b, h) (((b) * 2 + (h)) * HTB)
#define PG8_SB(b, h) ((4 + (b) * 2 + (h)) * HTB)
#define PG8_STAGE(bufoff, gbase, voff) do { _Pragma("unroll") for (int _i = 0; _i < 2; ++_i) \
        __builtin_amdgcn_global_load_lds((const unsigned*)((const char*)(gbase) + (voff)[_i]), (PG8_LAS unsigned*)(lds + (bufoff) + ldsw + _i * 8192), 16, 0, 0); } while (0)
#define PG8_LDA(dst, b, h) do { if constexpr (FP8) { _Pragma("unroll") for (int m = 0; m < 4; ++m) dst##8[m] = cat8(*(const PG8_LAS bf16x8*)(lds + PG8_SA(b, h) + aoff + m * 2048), *(const PG8_LAS bf16x8*)(lds + PG8_SA(b, h) + aoff + m * 2048 + 1024)); } else { \
        _Pragma("unroll") for (int m = 0; m < 4; ++m) _Pragma("unroll") for (int k = 0; k < 2; ++k) dst[m][k] = *(const PG8_LAS bf16x8*)(lds + PG8_SA(b, h) + aoff + m * 2048 + k * 1024); } } while (0)
#define PG8_LDB(dst, b, h) do { if constexpr (FP8) { _Pragma("unroll") for (int n = 0; n < 2; ++n) dst##8[n] = cat8(*(const PG8_LAS bf16x8*)(lds + PG8_SB(b, h) + boff + n * 2048), *(const PG8_LAS bf16x8*)(lds + PG8_SB(b, h) + boff + n * 2048 + 1024)); } else { \
        _Pragma("unroll") for (int n = 0; n < 2; ++n) _Pragma("unroll") for (int k = 0; k < 2; ++k) dst[n][k] = *(const PG8_LAS bf16x8*)(lds + PG8_SB(b, h) + boff + n * 2048 + k * 1024); } } while (0)
#define PG8_MMA(ai, bj, At, Bt) do { __builtin_amdgcn_s_setprio(1); if constexpr (FP8) { _Pragma("unroll") for (int m = 0; m < 4; ++m) _Pragma("unroll") for (int n = 0; n < 2; ++n) \
        asm volatile("v_mfma_scale_f32_16x16x128_f8f6f4 %0, %1, %2, %0, %3, %3 op_sel_hi:[0,0,0]" : "+v"(acc[ai][bj][m][n]) : "v"(Bt##8[n]), "v"(At##8[m]), "v"(fp8_unit_scale)); } else { \
        _Pragma("unroll") for (int m = 0; m < 4; ++m) _Pragma("unroll") for (int n = 0; n < 2; ++n) _Pragma("unroll") for (int k = 0; k < 2; ++k) \
        acc[ai][bj][m][n] = __builtin_amdgcn_mfma_f32_16x16x32_bf16(Bt[n][k], At[m][k], acc[ai][bj][m][n], 0, 0, 0); } __builtin_amdgcn_s_setprio(0); } while (0)
#define PG8_WAIT_V(n) asm volatile("s_waitcnt vmcnt(" #n ")" ::: "memory")
#define PG8_WAIT_L(n) asm volatile("s_waitcnt lgkmcnt(" #n ")" ::: "memory")
#define PG8_BAR __builtin_amdgcn_s_barrier()
#define PG8_SCHED __builtin_amdgcn_sched_barrier(0)
    Unit cur, nxt; int ui = 0;
    if (!S.next(0, cur)) return;
    f32x4 acc[2][2][4][2];
#pragma unroll
    for (int a = 0; a < 2; ++a)
#pragma unroll
        for (int b = 0; b < 2; ++b)
#pragma unroll
            for (int m = 0; m < 4; ++m)
#pragma unroll
                for (int n = 0; n < 2; ++n) acc[a][b][m][n] = (f32x4){0.f, 0.f, 0.f, 0.f};
    const int fp8_unit_scale = 0x7F7F7F7F;
    bf16x8 At[4][2], B0[2][2], B1[2][2]; v8i_t At8[4], B08[2], B18[2];
    const char* cA = (const char*)g.A + (size_t)cur.pm * tstep; const char* cB = (const char*)g.Bt + (size_t)cur.pn * tstep;
    S.a_ready(cur);
    if constexpr (SP2) {
        PG8_STAGE(PG8_SB(0, 0), cB, voffB); PG8_STAGE(PG8_SB(0, 1), cB + hstep, voffB); PG8_STAGE(PG8_SA(0, 0), cA, voffA); PG8_STAGE(PG8_SA(0, 1), cA + hstep, voffA);
        if (wr == 1) PG8_BAR;
        PG8_WAIT_V(2); PG8_BAR;
        PG8_STAGE(PG8_SB(1, 0), cB + kstep, voffB); PG8_STAGE(PG8_SA(1, 0), cA + kstep, voffA); PG8_STAGE(PG8_SB(1, 1), cB + hstep + kstep, voffB);
        PG8_WAIT_V(6); PG8_BAR;
    } else {
        PG8_STAGE(PG8_SB(0, 0), cB, voffB); PG8_STAGE(PG8_SA(0, 0), cA, voffA); PG8_STAGE(PG8_SB(0, 1), cB + hstep, voffB); PG8_STAGE(PG8_SA(0, 1), cA + hstep, voffA);
        if (wr == 1) PG8_BAR;
        PG8_WAIT_V(4); PG8_BAR;
        PG8_STAGE(PG8_SB(1, 0), cB + kstep, voffB); PG8_STAGE(PG8_SA(1, 0), cA + kstep, voffA); PG8_STAGE(PG8_SB(1, 1), cB + hstep + kstep, voffB);
        PG8_WAIT_V(6); PG8_BAR;
    }
    for (;;) {
        const bool has_next = S.next(ui + 1, nxt);
        const char* nA = has_next ? (const char*)g.A + (size_t)nxt.pm * tstep : cA; const char* nB = has_next ? (const char*)g.Bt + (size_t)nxt.pn * tstep : cB;
        for (int t = 0; t < nt; t += 2) {
            const bool last = (t == nt - 2);
            const char* a1 = cA + (size_t)(t + 1) * kstep;
            const char* a2 = last ? nA : cA + (size_t)(t + 2) * kstep; const char* b2 = last ? nB : cB + (size_t)(t + 2) * kstep;
            const char* a3 = a2 + kstep; const char* b3 = b2 + kstep;
            if (last && has_next) S.a_ready(nxt);
            if constexpr (SP2) {
            PG8_LDB(B0, 0, 0); PG8_LDB(B1, 0, 1); PG8_SCHED; PG8_LDA(At, 0, 0); PG8_STAGE(PG8_SA(1, 1), a1 + hstep, voffA);
            PG8_WAIT_V(8); PG8_WAIT_L(0); PG8_BAR; PG8_MMA(0, 0, At, B0); PG8_MMA(0, 1, At, B1); PG8_BAR; PG8_SCHED;
            PG8_LDA(At, 0, 1); PG8_STAGE(PG8_SB(0, 0), b2, voffB); PG8_STAGE(PG8_SB(0, 1), b2 + hstep, voffB); PG8_STAGE(PG8_SA(0, 0), a2, voffA);
            PG8_WAIT_V(8); PG8_WAIT_L(0); PG8_BAR; PG8_MMA(1, 0, At, B0); PG8_MMA(1, 1, At, B1); PG8_BAR; PG8_SCHED;
            PG8_LDB(B0, 1, 0); PG8_LDB(B1, 1, 1); PG8_SCHED; PG8_LDA(At, 1, 0); PG8_STAGE(PG8_SA(0, 1), a2 + hstep, voffA);
            PG8_WAIT_V(8); PG8_WAIT_L(0); PG8_BAR; PG8_MMA(0, 0, At, B0); PG8_MMA(0, 1, At, B1); PG8_BAR; PG8_SCHED;
            PG8_LDA(At, 1, 1); PG8_STAGE(PG8_SB(1, 0), b3, voffB); PG8_STAGE(PG8_SB(1, 1), b3 + hstep, voffB); PG8_STAGE(PG8_SA(1, 0), a3, voffA);
            PG8_WAIT_V(8); PG8_WAIT_L(0); PG8_BAR; PG8_MMA(1, 0, At, B0); PG8_MMA(1, 1, At, B1); PG8_BAR; PG8_SCHED;
            } else {
            PG8_LDB(B0, 0, 0); PG8_SCHED; PG8_LDA(At, 0, 0); PG8_STAGE(PG8_SA(1, 1), a1 + hstep, voffA);
            PG8_WAIT_L(8); PG8_BAR; PG8_WAIT_L(0); PG8_MMA(0, 0, At, B0); PG8_BAR; PG8_SCHED;
            PG8_LDB(B1, 0, 1); PG8_STAGE(PG8_SB(0, 0), b2, voffB);
            PG8_BAR; PG8_WAIT_L(0); PG8_MMA(0, 1, At, B1); PG8_BAR;
            PG8_LDA(At, 0, 1); PG8_STAGE(PG8_SA(0, 0), a2, voffA);
            PG8_BAR; PG8_WAIT_L(0); PG8_MMA(1, 0, At, B0); PG8_BAR; PG8_SCHED;
            PG8_STAGE(PG8_SB(0, 1), b2 + hstep, voffB);
            PG8_WAIT_V(6); PG8_BAR; PG8_MMA(1, 1, At, B1); PG8_BAR;
            PG8_LDB(B0, 1, 0); PG8_SCHED; PG8_LDA(At, 1, 0); PG8_STAGE(PG8_SA(0, 1), a2 + hstep, voffA);
            PG8_WAIT_L(8); PG8_BAR; PG8_WAIT_L(0); PG8_MMA(0, 0, At, B0); PG8_BAR; PG8_SCHED;
            PG8_LDB(B1, 1, 1); PG8_STAGE(PG8_SB(1, 0), b3, voffB);
            PG8_BAR; PG8_WAIT_L(0); PG8_MMA(0, 1, At, B1); PG8_BAR;
            PG8_LDA(At, 1, 1); PG8_STAGE(PG8_SA(1, 0), a3, voffA);
            PG8_BAR; PG8_WAIT_L(0); PG8_MMA(1, 0, At, B0); PG8_BAR; PG8_SCHED;
            PG8_STAGE(PG8_SB(1, 1), b3 + hstep, voffB);
            PG8_WAIT_V(6); PG8_BAR; PG8_MMA(1, 1, At, B1); PG8_BAR;
            }
        }
        if constexpr (ALIGN_EPI) { if (wr == 0) PG8_BAR; }
        if constexpr (FP8) asm volatile("s_nop 15\n\ts_nop 15\n\ts_nop 15" ::: "memory");
        if constexpr (!Epi::AFTER_DRAIN) { E(acc, cur, wr, wc, fr, fq); S.done(cur); }
        if (!has_next) break;
#pragma unroll
        for (int a = 0; a < 2; ++a)
#pragma unroll
            for (int b = 0; b < 2; ++b)
#pragma unroll
                for (int m = 0; m < 4; ++m)
#pragma unroll
                    for (int n = 0; n < 2; ++n) acc[a][b][m][n] = (f32x4){0.f, 0.f, 0.f, 0.f};
        if constexpr (FP8) asm volatile("s_nop 7" ::: "memory");
        cur = nxt; cA = nA; cB = nB; ++ui;
        if constexpr (ALIGN_EPI) { if (wr == 1) PG8_BAR; }
    }
    PG8_WAIT_V(0);
    if constexpr (!ALIGN_EPI) { if (wr == 0) PG8_BAR; }
    PG8_BAR;
    if constexpr (Epi::AFTER_DRAIN) { E.fused(acc, cur, wr, wc, fr, fq, lds, wid, lane); S.done(cur); }
#undef PG8_SA
#undef PG8_SB
#undef PG8_STAGE
#undef PG8_LDA
#undef PG8_LDB
#undef PG8_MMA
#undef PG8_WAIT_V
#undef PG8_WAIT_L
#undef PG8_BAR
#undef PG8_SCHED
}
}
constexpr int D_MODEL = 4096, BATCH = 4, SEQ = 4096, T = BATCH * SEQ;
constexpr int HA = 16, HB = 16, GB = 4, RB = 4;
constexpr int D_IN = 11312, LDP = 11520, D_FF = 11008, NGU = 2 * D_FF;
constexpr int OFF_QA = 0, OFF_KA = 2048, OFF_VA = 4096, OFF_QB = 6144, OFF_KC = 8192, OFF_VC = 8704,
              OFF_KS = 9216, OFF_VS = 9728, OFF_KW = 10240, OFF_VW = 10752, OFF_GL = 11264;
constexpr int NC = 255, NS = 64, CMP_LEN = 32, CMP_STRIDE = 16, NSEL = 16, WIN = 512;
constexpr float EPS = 1e-5f;
constexpr float QSCALE = 0.08838834764831845f;
constexpr int NWAVES = 8;
#ifndef PG8_FP8_SCALE
#define PG8_FP8_SCALE 0x7F7F7F7F
#endif
#ifndef P8_SP2
#define P8_SP2 true
#endif
constexpr float WGU_SCALE = 64.f;
constexpr float WDN_SCALE = 64.f;

constexpr size_t MiB = 1u << 20;
constexpr size_t WS_CTL = 0, CTL_ZERO_BYTES = 1 * MiB;
constexpr size_t WS_WIN = 1 * MiB;
constexpr size_t WS_WOUT = 91 * MiB;
constexpr size_t WS_WGU = 123 * MiB;
constexpr size_t WS_WDN = 295 * MiB;
constexpr size_t WS_BUFA = 381 * MiB;
constexpr size_t WS_PROJ = 509 * MiB;
constexpr size_t WS_SMALL = 869 * MiB;
constexpr size_t WS_CS = WS_SMALL;
constexpr size_t WS_KCF = WS_SMALL + 1 * MiB;
constexpr size_t WS_KCB = WS_SMALL + 5 * MiB;
constexpr size_t WS_W1T = WS_SMALL + 7 * MiB;
constexpr size_t WS_BIAS1 = WS_SMALL + 9 * MiB;
constexpr size_t WS_LSE = WS_SMALL + 10 * MiB;
constexpr size_t WS_GATES = WS_SMALL + 13 * MiB;
constexpr size_t WS_ROWSQ = WS_SMALL + 16 * MiB;
constexpr size_t WS_PART = 888 * MiB;
constexpr size_t WS_END = 1016 * MiB;
static_assert(WS_WIN + (size_t)LDP * 4096 * 2 <= WS_WOUT && WS_WOUT + (size_t)4096 * 4096 * 2 <= WS_WGU && WS_WGU + (size_t)NGU * 4096 * 2 <= WS_WDN &&
              WS_WDN + (size_t)4096 * D_FF * 2 <= WS_BUFA && WS_BUFA + (size_t)T * 4096 * 2 <= WS_PROJ && WS_PROJ + (size_t)T * LDP * 2 <= WS_SMALL, "d_ws map");
constexpr int CW_TMO = 0, CW_CODE = 1;
constexpr int CW_BAR = 4096;

constexpr int RING_OFF = 0, RING_BYTES = 131072;
constexpr int LDSCTL_OFF = RING_BYTES, MISC_OFF = LDSCTL_OFF + 320;
constexpr int LDS_BYTES = 155648;

#define GAS __attribute__((address_space(1)))
#define LAS __attribute__((address_space(3)))
typedef unsigned short bf16;
typedef unsigned v4u __attribute__((ext_vector_type(4)));
typedef unsigned v2u __attribute__((ext_vector_type(2)));
typedef float f32x4 __attribute__((ext_vector_type(4)));
typedef short bf16x8 __attribute__((ext_vector_type(8)));
typedef GAS unsigned gu32;
#define RLX_AGENT __ATOMIC_RELAXED, __HIP_MEMORY_SCOPE_AGENT
#define LDS_WAIT() asm volatile("s_waitcnt lgkmcnt(0)" ::: "memory")
#define VM_WAIT() asm volatile("s_waitcnt vmcnt(0)" ::: "memory")
__device__ __forceinline__ unsigned f2bf(float f) { unsigned u = __builtin_bit_cast(unsigned, f); return (u + 0x7fffu + ((u >> 16) & 1u)) >> 16; }
__device__ __forceinline__ unsigned pk2(float lo, float hi) { return f2bf(lo) | (f2bf(hi) << 16); }
__device__ __forceinline__ float bf2f(bf16 v) { return __builtin_bit_cast(float, (unsigned)v << 16); }
#define XB_TMO      128
#define XB_XCNT(j)  (256  + 64 * (j))
#define XB_XSUB(j)  (1280 + 64 * (j))
#define XB_XGEN(j)  (2304 + 64 * (j))
#define XB_TOP      3328
#define XB_TOPGEN   3392
#define XCD_BAR_WORDS 3456
#define XB_SPIN_CAP (1u << 18)

__device__ __forceinline__ unsigned xb_ld(unsigned* p)              { return __hip_atomic_load(p, __ATOMIC_RELAXED, __HIP_MEMORY_SCOPE_AGENT); }
__device__ __forceinline__ unsigned xb_add(unsigned* p, unsigned v) { return __hip_atomic_fetch_add(p, v, __ATOMIC_RELAXED, __HIP_MEMORY_SCOPE_AGENT); }
__device__ __forceinline__ unsigned xb_xcc_id() { return (unsigned)__builtin_amdgcn_s_getreg((3 << 11) | 20) & 0xFu; }
#define XB_SPIN(cond, bar) do { unsigned _sp = 0; while (cond) { __builtin_amdgcn_s_sleep(1); \
    if ((++_sp & 255u) == 0u) { if (xb_ld(&(bar)[XB_TMO])) break; if (_sp > XB_SPIN_CAP) { atomicAdd(&(bar)[XB_TMO], 1u); break; } } } } while (0)

struct XcdBarrier {
    unsigned* bar; unsigned x;
    volatile LAS unsigned* st;
};

__device__ __forceinline__ XcdBarrier xcd_barrier_post(unsigned* bar, volatile LAS unsigned* st) {
    XcdBarrier b; b.bar = bar; b.x = xb_xcc_id(); b.st = st;
    if (threadIdx.x == 0) (void)xb_add(&bar[XB_XCNT(b.x)], 1u);
    return b;
}
__device__ __forceinline__ void xcd_barrier_complete(unsigned* bar, unsigned x, unsigned& nloc, unsigned& nx) {
    const unsigned G = gridDim.x * gridDim.y * gridDim.z;
    unsigned sum, cnt, mine, sp = 0u;
    for (;;) {
        sum = 0u; cnt = 0u; mine = 0u;
#pragma unroll
        for (unsigned j = 0; j < 16; ++j) { const unsigned c = xb_ld(&bar[XB_XCNT(j)]); sum += c; cnt += (c > 0u) ? 1u : 0u; mine = (j == x) ? c : mine; }
        if (sum == G) break;
        __builtin_amdgcn_s_sleep(1);
        if ((++sp & 255u) == 0u) { if (xb_ld(&bar[XB_TMO])) break; if (sp > XB_SPIN_CAP) { atomicAdd(&bar[XB_TMO], 1u); break; } }
    }
    nloc = mine > 0u ? mine : 1u; nx = cnt > 0u ? cnt : 1u;
}

__device__ __forceinline__ void xcd_barrier(const XcdBarrier& b) {
    asm volatile("s_waitcnt vmcnt(0)" ::: "memory");
    __syncthreads();
    if (threadIdx.x == 0) {
        unsigned* bar = b.bar;
        __builtin_amdgcn_s_waitcnt(0);
        unsigned nloc = b.st[0], nx = b.st[1];
        if (nloc == 0u) { xcd_barrier_complete(bar, b.x, nloc, nx); b.st[0] = nloc; b.st[1] = nx; }
        const unsigned old = xb_add(&bar[XB_XSUB(b.x)], 1u);
        const unsigned gen = old / nloc;
        if (old + 1u == (gen + 1u) * nloc) {
            __builtin_amdgcn_fence(__ATOMIC_RELEASE, "agent");
            asm volatile("s_waitcnt vmcnt(0)" ::: "memory");
            const unsigned og = xb_add(&bar[XB_TOP], 1u);
            const unsigned tg = og / nx;
            if (og + 1u == (tg + 1u) * nx) xb_add(&bar[XB_TOPGEN], 1u);
            else XB_SPIN(xb_ld(&bar[XB_TOPGEN]) == tg, bar);
            __builtin_amdgcn_fence(__ATOMIC_ACQUIRE, "agent");
            xb_add(&bar[XB_XGEN(b.x)], 1u);
            asm volatile("s_waitcnt vmcnt(0)" ::: "memory");
        } else {
            XB_SPIN(xb_ld(&bar[XB_XGEN(b.x)]) == gen, bar);
            __builtin_amdgcn_fence(__ATOMIC_ACQUIRE, "agent");
            asm volatile("s_waitcnt vmcnt(0)" ::: "memory");
        }
    }
    __syncthreads();
}
namespace att {
#ifdef MK_TPROBE
#define SECARG , sec_acc
#define SECPARM , unsigned long long& sec_acc
#define SEC_BEGIN(kind) unsigned long long sec_t; asm volatile("s_memrealtime %0\n\ts_waitcnt lgkmcnt(0)" : "=s"(sec_t) :: "memory"); int sec_n = 0; const bool sec_on = (kind) == MK_TUNIT
#define SSEC(k) do { unsigned long long t_; asm volatile("s_memrealtime %0\n\ts_waitcnt lgkmcnt(0)" : "=s"(t_) :: "memory"); if (ssec_on && MK_TSEC == (k) && wave == MK_TWAVE) *ssec_acc += t_ - ssec_t; ssec_t = t_; } while (0)
#define SSEC_PARM , unsigned long long* ssec_acc = nullptr, bool ssec_on = false
#define SSEC_ARG , &sec_acc, sec_on
#define SSEC_INIT unsigned long long ssec_t; asm volatile("s_memrealtime %0\n\ts_waitcnt lgkmcnt(0)" : "=s"(ssec_t) :: "memory")
#define SEC() do { unsigned long long t_; asm volatile("s_memrealtime %0\n\ts_waitcnt lgkmcnt(0)" : "=s"(t_) :: "memory"); if (sec_on && sec_n == MK_TSEC) sec_acc += t_ - sec_t; sec_t = t_; ++sec_n; } while (0)
#else
#define SECARG
#define SECPARM
#define SEC_BEGIN(kind) do { } while (0)
#define SEC() do { } while (0)
#define SSEC(k) do { } while (0)
#define SSEC_PARM
#define SSEC_ARG
#define SSEC_INIT do { } while (0)
#endif
typedef float f32x16 __attribute__((ext_vector_type(16)));
typedef short s16x4 __attribute__((ext_vector_type(4)));
constexpr int SHM_T = 16384;
constexpr int A_V = 0, A_K = 4 * SHM_T;
constexpr int A_KC = 0, A_VC = 4 * SHM_T;
constexpr int A_WS = 131072 + 1024;
constexpr int A_IMP = A_WS + 2048;
constexpr int A_SEL = A_IMP + 16384;
constexpr int A_END = A_SEL + 512;
constexpr float C2 = QSCALE * 1.4426950408889634f;
constexpr float THR_RAW = 8.f / QSCALE;
#define KSWZ(row, colB) ((row) * 256 + ((colB) ^ (((row) & 7) << 4)))
__device__ __forceinline__ int crow(int r, int hi) { return (r & 3) + 8 * (r >> 2) + 4 * hi; }
__device__ __forceinline__ unsigned cvtpk(float lo, float hi) { unsigned r; asm volatile("v_cvt_pk_bf16_f32 %0, %1, %2" : "=v"(r) : "v"(lo), "v"(hi)); return r; }
__device__ __forceinline__ int v_st(int k, int c) { const int kk = (k & ~0xC) | ((k & 4) << 1) | ((k & 8) >> 1); return ((kk >> 3) * 4 + (c >> 5)) * 512 + ((kk & 7) * 32 + (c & 31)) * 2; }
__device__ __forceinline__ int v_rd_base(int lane) { return ((lane & 3) << 3) | (((lane >> 2) & 3) << 6) | (((lane >> 4) & 1) << 5) | (((lane >> 5) & 1) << 8); }
constexpr int v_rd_off(int d0, int ks, int half) { return d0 * 512 + ks * 4096 + half * 2048; }
template <int OFF> __device__ __forceinline__ s16x4 tr_read(int vb) {
    s16x4 r; asm volatile("ds_read_b64_tr_b16 %0, %1 offset:%2" : "=&v"(r) : "v"(vb), "i"(OFF) : "memory"); return r;
}
struct VFrag { s16x4 l0, h0, l1, h1, l2, h2, l3, h3; };
template <int D0> __device__ __forceinline__ void v_reads(VFrag& f, int vb) {
    f.l0 = tr_read<v_rd_off(D0, 0, 0)>(vb); f.h0 = tr_read<v_rd_off(D0, 0, 1)>(vb); f.l1 = tr_read<v_rd_off(D0, 1, 0)>(vb); f.h1 = tr_read<v_rd_off(D0, 1, 1)>(vb);
    f.l2 = tr_read<v_rd_off(D0, 2, 0)>(vb); f.h2 = tr_read<v_rd_off(D0, 2, 1)>(vb); f.l3 = tr_read<v_rd_off(D0, 3, 0)>(vb); f.h3 = tr_read<v_rd_off(D0, 3, 1)>(vb);
}
#define ATT_PK(Lx, Hx) (bf16x8){Lx[0], Lx[1], Lx[2], Lx[3], Hx[0], Hx[1], Hx[2], Hx[3]}
__device__ __forceinline__ void pv_mma(f32x16& od, const VFrag& f, bf16x8 pa0, bf16x8 pa1, bf16x8 pa2, bf16x8 pa3) {
    od = __builtin_amdgcn_mfma_f32_32x32x16_bf16(pa0, ATT_PK(f.l0, f.h0), od, 0, 0, 0);
    od = __builtin_amdgcn_mfma_f32_32x32x16_bf16(pa1, ATT_PK(f.l1, f.h1), od, 0, 0, 0);
    od = __builtin_amdgcn_mfma_f32_32x32x16_bf16(pa2, ATT_PK(f.l2, f.h2), od, 0, 0, 0);
    od = __builtin_amdgcn_mfma_f32_32x32x16_bf16(pa3, ATT_PK(f.l3, f.h3), od, 0, 0, 0);
}
__device__ __forceinline__ void pv_d0(f32x16 (&o)[4], int vb, bf16x8 pa0, bf16x8 pa1, bf16x8 pa2, bf16x8 pa3) {
    VFrag fa, fb;
    v_reads<0>(fa, vb); v_reads<1>(fb, vb);
    asm volatile("s_waitcnt lgkmcnt(8)" ::: "memory"); __builtin_amdgcn_sched_barrier(0);
    pv_mma(o[0], fa, pa0, pa1, pa2, pa3); __builtin_amdgcn_sched_barrier(0);
    v_reads<2>(fa, vb);
    asm volatile("s_waitcnt lgkmcnt(8)" ::: "memory"); __builtin_amdgcn_sched_barrier(0);
    pv_mma(o[1], fb, pa0, pa1, pa2, pa3); __builtin_amdgcn_sched_barrier(0);
    v_reads<3>(fb, vb);
    asm volatile("s_waitcnt lgkmcnt(8)" ::: "memory"); __builtin_amdgcn_sched_barrier(0);
    pv_mma(o[2], fa, pa0, pa1, pa2, pa3); __builtin_amdgcn_sched_barrier(0);
    asm volatile("s_waitcnt lgkmcnt(0)" ::: "memory"); __builtin_amdgcn_sched_barrier(0);
    pv_mma(o[3], fb, pa0, pa1, pa2, pa3);
}
#undef ATT_PK
__device__ __forceinline__ void pv_d0_lean(f32x16 (&o)[4], int vb, bf16x8 pa0, bf16x8 pa1, bf16x8 pa2, bf16x8 pa3) {
    VFrag f;
    v_reads<0>(f, vb); asm volatile("s_waitcnt lgkmcnt(0)" ::: "memory"); __builtin_amdgcn_sched_barrier(0); pv_mma(o[0], f, pa0, pa1, pa2, pa3); __builtin_amdgcn_sched_barrier(0);
    v_reads<1>(f, vb); asm volatile("s_waitcnt lgkmcnt(0)" ::: "memory"); __builtin_amdgcn_sched_barrier(0); pv_mma(o[1], f, pa0, pa1, pa2, pa3); __builtin_amdgcn_sched_barrier(0);
    v_reads<2>(f, vb); asm volatile("s_waitcnt lgkmcnt(0)" ::: "memory"); __builtin_amdgcn_sched_barrier(0); pv_mma(o[2], f, pa0, pa1, pa2, pa3); __builtin_amdgcn_sched_barrier(0);
    v_reads<3>(f, vb); asm volatile("s_waitcnt lgkmcnt(0)" ::: "memory"); __builtin_amdgcn_sched_barrier(0); pv_mma(o[3], f, pa0, pa1, pa2, pa3);
}
#define ATT_KRD(B, d0) do { const int cb_ = ((d0) * 16 + hi * 8) * 2; B##0 = *(const LAS bf16x8*)(Ks + KSWZ(r32, cb_)); B##1 = *(const LAS bf16x8*)(Ks + KSWZ(32 + r32, cb_)); } while (0)
#define ATT_KMM(B, d0) do { p0 = __builtin_amdgcn_mfma_f32_32x32x16_bf16(B##0, qr[d0], p0, 0, 0, 0); p1 = __builtin_amdgcn_mfma_f32_32x32x16_bf16(B##1, qr[d0], p1, 0, 0, 0); } while (0)
__device__ __forceinline__ void qkt(f32x16& p0, f32x16& p1, const LAS unsigned char* Ks, const bf16x8 (&qr)[8], int r32, int hi) {
    bf16x8 a0, a1, b0, b1, c0, c1, e0, e1;
    ATT_KRD(a, 0); ATT_KRD(b, 1); ATT_KRD(c, 2); ATT_KRD(e, 3);
#pragma unroll
    for (int r = 0; r < 16; ++r) { p0[r] = 0.f; p1[r] = 0.f; }
    __builtin_amdgcn_sched_barrier(0);
    ATT_KMM(a, 0); ATT_KMM(b, 1); __builtin_amdgcn_sched_barrier(0);
    ATT_KRD(a, 4); ATT_KRD(b, 5); __builtin_amdgcn_sched_barrier(0);
    ATT_KMM(c, 2); ATT_KMM(e, 3); __builtin_amdgcn_sched_barrier(0);
    ATT_KRD(c, 6); ATT_KRD(e, 7); __builtin_amdgcn_sched_barrier(0);
    ATT_KMM(a, 4); ATT_KMM(b, 5); __builtin_amdgcn_sched_barrier(0);
    ATT_KMM(c, 6); ATT_KMM(e, 7);
}
#undef ATT_KRD
#undef ATT_KMM
__device__ __forceinline__ float xhalf_max(float v) { auto rr = __builtin_amdgcn_permlane32_swap(__float_as_uint(v), __float_as_uint(v), false, false); return fmaxf(__uint_as_float(rr[0]), __uint_as_float(rr[1])); }
__device__ __forceinline__ float xhalf_sum(float v) { auto rr = __builtin_amdgcn_permlane32_swap(__float_as_uint(v), __float_as_uint(v), false, false); return __uint_as_float(rr[0]) + __uint_as_float(rr[1]); }
__device__ __forceinline__ bf16x8 pks(unsigned a0, unsigned a1, unsigned b0, unsigned b1) {
    auto r0 = __builtin_amdgcn_permlane32_swap(a0, b0, false, false); auto r1 = __builtin_amdgcn_permlane32_swap(a1, b1, false, false);
    v4u w = {r0[0], r1[0], r0[1], r1[1]}; return __builtin_bit_cast(bf16x8, w);
}
__device__ __forceinline__ void softmax_tile(f32x16& p0, f32x16& p1, float& m_reg, float& l_reg, float& alpha, bf16x8& pa0, bf16x8& pa1, bf16x8& pa2, bf16x8& pa3) {
    float pmax = fmaxf(p0[0], p1[0]);
#pragma unroll
    for (int r = 1; r < 16; ++r) pmax = fmaxf(fmaxf(pmax, p0[r]), p1[r]);
    pmax = xhalf_max(pmax);
    float mn;
    if (__all(pmax - m_reg <= THR_RAW)) { mn = m_reg; alpha = 1.f; }
    else { mn = fmaxf(m_reg, pmax); alpha = __builtin_amdgcn_exp2f((m_reg - mn) * C2); m_reg = mn; }
    const float mnC = -mn * C2;
    float ps = 0.f;
#pragma unroll
    for (int r = 0; r < 16; ++r) { p0[r] = __builtin_amdgcn_exp2f(fmaf(p0[r], C2, mnC)); p1[r] = __builtin_amdgcn_exp2f(fmaf(p1[r], C2, mnC)); ps += p0[r] + p1[r]; }
    ps = xhalf_sum(ps);
    l_reg = l_reg * alpha + ps;
    pa0 = pks(cvtpk(p0[0], p0[1]), cvtpk(p0[2], p0[3]), cvtpk(p0[4], p0[5]), cvtpk(p0[6], p0[7]));
    pa1 = pks(cvtpk(p0[8], p0[9]), cvtpk(p0[10], p0[11]), cvtpk(p0[12], p0[13]), cvtpk(p0[14], p0[15]));
    pa2 = pks(cvtpk(p1[0], p1[1]), cvtpk(p1[2], p1[3]), cvtpk(p1[4], p1[5]), cvtpk(p1[6], p1[7]));
    pa3 = pks(cvtpk(p1[8], p1[9]), cvtpk(p1[10], p1[11]), cvtpk(p1[12], p1[13]), cvtpk(p1[14], p1[15]));
}
struct MaskBand { int qi, W, amin, amax;
    __device__ __forceinline__ bool interior(int t) const { return (t * 64 + 63 <= amin) && (t * 64 >= amax - W); }
    __device__ __forceinline__ void operator()(f32x16& p0, f32x16& p1, int t, int hi) const {
        const int kb = t * 64 + 4 * hi;
#pragma unroll
        for (int r = 0; r < 16; ++r) { const int k = kb + (r & 3) + 8 * (r >> 2);
            p0[r] = ((unsigned)(qi - k) <= (unsigned)W) ? p0[r] : -INFINITY; p1[r] = ((unsigned)(qi - k - 32) <= (unsigned)W) ? p1[r] : -INFINITY; }
    } };
struct NeedBand { int a, W;
    __device__ __forceinline__ bool operator()(int t) const { return (t * 64 + 63 >= a - W) && (t * 64 <= a + 31); } };
struct NeedAll { __device__ __forceinline__ bool operator()(int) const { return true; } };
struct MaskSel { unsigned mlo, mhi; int s, qb;
    __device__ __forceinline__ bool interior(int) const { return false; }
    __device__ __forceinline__ void operator()(f32x16& p0, f32x16& p1, int t, int hi) const {
        const bool bit = ((t < 32 ? (mlo >> t) : (mhi >> (t - 32))) & 1u) != 0u;
        const int lim = (bit ? s : -1) - (t * 64 + 4 * hi);
#pragma unroll
        for (int r = 0; r < 16; ++r) { const int c = (r & 3) + 8 * (r >> 2);
            p0[r] = (c <= lim) ? p0[r] : -INFINITY; p1[r] = (c + 32 <= lim) ? p1[r] : -INFINITY; }
    } };
struct NeedSel { unsigned mlo, mhi;
    __device__ __forceinline__ bool operator()(int t) const { const bool bit = ((t < 32 ? (mlo >> t) : (mhi >> (t - 32))) & 1u) != 0u; return __any(bit) != 0; } };

struct NoPre { __device__ __forceinline__ void operator()() const {} };
template <class Mask, class Need, int PRE = 0, class Pre = NoPre>
__device__ __forceinline__ void attn_stream(LAS unsigned char* L, const bf16* Kg, const bf16* Vg, size_t stride, int t_lo, int t_hi, const bf16x8 (&qr)[8],
                                            const Mask& mask, const Need& need, f32x16 (&o)[4], float& m_reg, float& l_reg, int tid, int lane, int wave, const Pre& pre = Pre() SSEC_PARM) {
    SSEC_INIT;
    asm volatile("" : "+v"(tid), "+v"(lane));
    const bool late = wave >= 4;
    const bf16* kp; const bf16* vp;
    { const int krow = 4 * wave + (lane >> 4), kch = (lane & 15) ^ (krow & 7);
      const int vsub = 2 * wave + (lane >> 5), vkk = 8 * (vsub >> 2) + ((lane & 31) >> 2), vk = (vkk & ~0xC) | ((vkk & 4) << 1) | ((vkk & 8) >> 1);
      kp = Kg + ((size_t)t_lo * 64 + krow) * stride + kch * 8;
      vp = Vg + ((size_t)t_lo * 64 + vk) * stride + (vsub & 3) * 32 + (lane & 3) * 8; }
    const size_t s32 = 32 * stride, s64 = 64 * stride;
#define ATT_DMA(kslot, vslot) do { \
        __builtin_amdgcn_global_load_lds((const unsigned*)kp, (LAS unsigned*)(L + A_K + (kslot) * SHM_T + wave * 1024), 16, 0, 0); \
        __builtin_amdgcn_global_load_lds((const unsigned*)(kp + s32), (LAS unsigned*)(L + A_K + (kslot) * SHM_T + 8192 + wave * 1024), 16, 0, 0); \
        __builtin_amdgcn_global_load_lds((const unsigned*)vp, (LAS unsigned*)(L + A_V + (vslot) * SHM_T + wave * 1024), 16, 0, 0); \
        __builtin_amdgcn_global_load_lds((const unsigned*)(vp + s32), (LAS unsigned*)(L + A_V + (vslot) * SHM_T + 8192 + wave * 1024), 16, 0, 0); \
        kp += s64; vp += s64; } while (0)
#define ATT_RESC() do { if (__any(alpha < 1.f)) { if (hi == 0) al_l[r32] = alpha; asm volatile("s_waitcnt lgkmcnt(0)" ::: "memory"); \
        _Pragma("unroll") for (int d = 0; d < 4; ++d) _Pragma("unroll") for (int r = 0; r < 16; ++r) o[d][r] *= al_l[crow(r, hi)]; } } while (0)
    ATT_DMA(0, 0);
    if (t_lo + 1 < t_hi) ATT_DMA(1, 1);
    pre();
    asm volatile("" : "+v"(lane));
    const int r32 = lane & 31, hi = lane >> 5;
    LAS float* al_l = (LAS float*)(L + A_WS + wave * 256) + 32;
    const int vb0 = (int)(unsigned)(uintptr_t)(L + A_V) + v_rd_base(lane);
    int ks = 0, vs = 0, vsp = 0; bool pend = false;
    bf16x8 pa0, pa1, pa2, pa3;
    for (int t = t_lo; t < t_hi; ++t) {
        if (PRE > 0 && t - t_lo < 2 && t + 1 < t_hi) asm volatile("s_waitcnt vmcnt(%0)" :: "n"(4 + PRE) : "memory");
        else if (t + 1 < t_hi) asm volatile("s_waitcnt vmcnt(4)" ::: "memory"); else asm volatile("s_waitcnt vmcnt(0)" ::: "memory");
        __builtin_amdgcn_s_barrier();
        asm volatile("" ::: "memory");
        SSEC(10);
        if (t + 2 < t_hi) { const int k2 = ks >= 1 ? ks - 1 : 2, v2 = vs >= 2 ? vs - 2 : vs + 2; ATT_DMA(k2, v2); }
        SSEC(11);
        if (pend) { pv_d0(o, vb0 + vsp * SHM_T, pa0, pa1, pa2, pa3); pend = false; }
        SSEC(12);
        if (need(t)) {
            f32x16 p0, p1; qkt(p0, p1, L + A_K + ks * SHM_T, qr, r32, hi);
            SSEC(13);
            if (!mask.interior(t)) mask(p0, p1, t, hi);
            float alpha;
            softmax_tile(p0, p1, m_reg, l_reg, alpha, pa0, pa1, pa2, pa3);
            ATT_RESC();
            SSEC(14);
            if (late) { pend = true; vsp = vs; }
            else pv_d0(o, vb0 + vs * SHM_T, pa0, pa1, pa2, pa3);
        }
        SSEC(15);
        ks = ks == 2 ? 0 : ks + 1; vs = (vs + 1) & 3;
    }
    if (pend) pv_d0(o, vb0 + vsp * SHM_T, pa0, pa1, pa2, pa3);
#undef ATT_DMA
#undef ATT_RESC
    asm volatile("s_waitcnt lgkmcnt(0)" ::: "memory");
    __builtin_amdgcn_s_barrier();
}
__device__ __forceinline__ int st_img(int wave) { return wave < 4 ? 2 * SHM_T + wave * 8192 : A_K + 2 * SHM_T + (wave - 4) * 8192; }
constexpr int ST_VMOPS = 8;
template <class RowPtr>
__device__ __forceinline__ void store_tile(LAS unsigned char* L, const f32x16 (&o)[4], const LAS float* sc_l, const RowPtr& rowptr, int lane, int wave) {
    const int r32 = lane & 31, hi = lane >> 5, odd = lane & 1;
    LAS unsigned char* img = L + st_img(wave);
#pragma unroll
    for (int rp = 0; rp < 8; ++rp) {
        const int r = 2 * rp;
        const float s0 = sc_l[crow(r, hi)], s1 = sc_l[crow(r + 1, hi)];
        const int row = crow(r + odd, hi);
#pragma unroll
        for (int d0 = 0; d0 < 4; ++d0) {
            const float a = o[d0][r] * s0, b = o[d0][r + 1] * s1;
            const float send = odd ? a : b;
            const float recv = __shfl_xor(send, 1);
            const unsigned w = cvtpk(odd ? recv : a, odd ? b : recv);
            *(LAS unsigned*)(img + row * 256 + (((32 * d0 + (r32 & ~1)) * 2) ^ ((row & 7) << 4))) = w;
        }
    }
    asm volatile("s_waitcnt lgkmcnt(0)" ::: "memory");
#pragma unroll
    for (int i = 0; i < 8; ++i) {
        const int row = 4 * i + (lane >> 4), ch = lane & 15;
        const v4u v = *(const LAS v4u*)(img + row * 256 + ((ch * 16) ^ ((row & 7) << 4)));
        *(v4u*)(rowptr(row) + ch * 8) = v;
    }
}
constexpr int STD_VMOPS = 32;
template <class RowPtr>
__device__ __forceinline__ void store_tile_direct(const f32x16 (&o)[4], const LAS float* sc_l, const RowPtr& rowptr, int lane) {
    const int r32 = lane & 31, hi = lane >> 5, odd = lane & 1;
#pragma unroll
    for (int rp = 0; rp < 8; ++rp) {
        const int r = 2 * rp;
        const float s0 = sc_l[crow(r, hi)], s1 = sc_l[crow(r + 1, hi)];
        bf16* prow = rowptr(crow(r + odd, hi)) + (r32 & ~1);
#pragma unroll
        for (int d0 = 0; d0 < 4; ++d0) {
            const float a = o[d0][r] * s0, b = o[d0][r + 1] * s1;
            const float send = odd ? a : b;
            const float recv = __shfl_xor(send, 1);
            *(unsigned*)(prow + 32 * d0) = cvtpk(odd ? recv : a, odd ? b : recv);
        }
    }
}
__device__ __forceinline__ float sigmoidf_(float v) { return 1.f / (1.f + __expf(-v)); }

__device__ __forceinline__ void dilated_unit(LAS unsigned char* L, const bf16* proj, bf16* outA, float* lse, int u, int tid, int lane, int wave SECPARM) {
    SEC_BEGIN(0);
    const int r32 = lane & 31, hi = lane >> 5;
    const int cfg = u >> 10, r = u & 1023, sh = 2 * cfg, dil = 1 << sh;
    const int b = r >> 8, h = (r >> 4) & 15, rb = r & 15, res = rb & (dil - 1), blk = rb >> sh;
    const int i0 = blk * 256, a = i0 + 32 * wave, qi = a + r32;
    const bf16* base = proj + (size_t)(b * SEQ + res) * LDP + h * 128;
    const size_t stride = (size_t)dil * LDP;
    const bf16* qrow = base + OFF_QA + (size_t)qi * stride + hi * 8;
    bf16x8 qr[8];
#pragma unroll
    for (int d0 = 0; d0 < 8; ++d0) qr[d0] = *(const bf16x8*)(qrow + d0 * 16);
    f32x16 o[4];
#pragma unroll
    for (int d = 0; d < 4; ++d)
#pragma unroll
        for (int e = 0; e < 16; ++e) o[d][e] = 0.f;
    float m_reg = -1e30f, l_reg = 0.f;
    const int t_lo = (i0 >= 128) ? (i0 - 128) >> 6 : 0, t_hi = (i0 >> 6) + 4;
    SEC();
    attn_stream(L, base + OFF_KA, base + OFF_VA, stride, t_lo, t_hi, qr, MaskBand{qi, 128, a, a + 31}, NeedBand{a, 128}, o, m_reg, l_reg, tid, lane, wave, NoPre() SSEC_ARG);
    SEC();
    LAS float* sc_l = (LAS float*)(L + A_WS + wave * 256);
    const int tok = qi * dil + res;
    if (hi == 0) { sc_l[r32] = 1.f / l_reg; lse[((size_t)cfg * T + (size_t)b * SEQ + tok) * 16 + h] = m_reg * QSCALE + __logf(l_reg); }
    asm volatile("s_waitcnt lgkmcnt(0)" ::: "memory");
    bf16* obase = outA + (size_t)cfg * T * 2048 + (size_t)(b * SEQ + res) * 2048 + h * 128;
    const size_t ostride = (size_t)dil * 2048;
    store_tile(L, o, sc_l, [&](int row) { return obase + (size_t)(a + row) * ostride; }, lane, wave);
    SEC();
}
__device__ __forceinline__ void window_unit(LAS unsigned char* L, const bf16* proj, bf16* outB, int u, int tid, int lane, int wave SECPARM) {
    SEC_BEGIN(1);
    const int r32 = lane & 31, hi = lane >> 5;
    const int b = u >> 8, g = (u >> 6) & 3, qb = u & 63, q0 = qb * 64;
    const int head = r32 >> 3, s = q0 + 8 * wave + (r32 & 7);
    const bf16* prow = proj + (size_t)(b * SEQ + s) * LDP;
    const bf16* qrow = prow + OFF_QB + (g * 4 + head) * 128 + hi * 8;
    bf16x8 qr[8];
#pragma unroll
    for (int d0 = 0; d0 < 8; ++d0) qr[d0] = *(const bf16x8*)(qrow + d0 * 16);
    f32x16 o[4];
#pragma unroll
    for (int d = 0; d < 4; ++d)
#pragma unroll
        for (int e = 0; e < 16; ++e) o[d][e] = 0.f;
    float m_reg = -1e30f, l_reg = 0.f;
    const bf16* kvb = proj + (size_t)(b * SEQ) * LDP + g * 128;
    attn_stream(L, kvb + OFF_KW, kvb + OFF_VW, (size_t)LDP, qb >= 8 ? qb - 8 : 0, qb + 1, qr, MaskBand{s, WIN - 1, q0 + 8 * wave, q0 + 8 * wave + 7}, NeedAll{}, o, m_reg, l_reg, tid, lane, wave);
    LAS float* sc_l = (LAS float*)(L + A_WS + wave * 256);
    if (hi == 0) sc_l[r32] = 1.f / l_reg;
    asm volatile("s_waitcnt lgkmcnt(0)" ::: "memory");
    bf16* obase = outB + (size_t)(b * SEQ + q0 + 8 * wave) * 2048 + g * 512;
    store_tile(L, o, sc_l, [&](int row) { return obase + (size_t)(row & 7) * 2048 + (row >> 3) * 128; }, lane, wave);
}
__device__ __forceinline__ bf16x8 hfrag(int c0, int j) {
    bf16x8 f; const int d = c0 - 4 * j;
#pragma unroll
    for (int jj = 0; jj < 8; ++jj) f[jj] = ((unsigned)(d + jj + 1) <= 4u) ? (short)0x3F80 : (short)0;
    return f;
}
__device__ __forceinline__ void nsa_unit(LAS unsigned char* L, const bf16* proj, const bf16* kc, const bf16* vc, bf16* outC, bf16* outS, int b, int g, int qb, int tid, int lane, int wave SECPARM) {
    SEC_BEGIN(2);
    asm volatile("" : "+v"(tid), "+v"(lane));
    const int r32 = lane & 31, hi = lane >> 5;
    const int q0 = qb * 64, head = r32 >> 3, s = q0 + 8 * wave + (r32 & 7);
    const bf16* prow = proj + (size_t)(b * SEQ + s) * LDP;
    const bf16* qrow = prow + OFF_QB + (g * 4 + head) * 128 + hi * 8;
    bf16x8 qr[8];
#pragma unroll
    for (int d0 = 0; d0 < 8; ++d0) qr[d0] = *(const bf16x8*)(qrow + d0 * 16);
    {
        int tid_ = tid; asm volatile("" : "+v"(tid_));
        const int sr = tid_ >> 4, sc = (tid_ & 15) * 8;
        const bf16* kcb = kc + (size_t)(b * GB + g) * 256 * 128 + (size_t)sr * 128 + sc; const bf16* vcb = vc + (size_t)(b * GB + g) * 256 * 128 + (size_t)sr * 128 + sc;
#pragma unroll
        for (int tc = 0; tc < 4; ++tc) {
            const bf16x8 k0 = *(const bf16x8*)(kcb + tc * 8192), k1 = *(const bf16x8*)(kcb + tc * 8192 + 4096), v0 = *(const bf16x8*)(vcb + tc * 8192), v1 = *(const bf16x8*)(vcb + tc * 8192 + 4096);
            *(LAS bf16x8*)(L + A_KC + tc * SHM_T + KSWZ(sr, sc * 2)) = k0; *(LAS bf16x8*)(L + A_KC + tc * SHM_T + KSWZ(32 + sr, sc * 2)) = k1;
            *(LAS bf16x8*)(L + A_VC + tc * SHM_T + v_st(sr, sc)) = v0; *(LAS bf16x8*)(L + A_VC + tc * SHM_T + v_st(32 + sr, sc)) = v1;
        }
    }
    __syncthreads();
    LAS float* impw = (LAS float*)(L + A_IMP) + wave * 512;
    LAS float* sc_l = (LAS float*)(L + A_WS + wave * 256);
    f32x16 o[4];
#pragma unroll
    for (int e = 0; e < 16; ++e) { o[0][e] = 0.f; o[1][e] = 0.f; o[2][e] = 0.f; o[3][e] = 0.f; }
    float m = -1e30f, l = 0.f;
    {
        const int vbc = (int)(unsigned)(uintptr_t)(L + A_VC) + v_rd_base(lane);
        LAS float* al_c = (LAS float*)(L + A_WS + wave * 256) + 32;
#pragma unroll 1
        for (int tc = 0; tc < 4; ++tc) {
            f32x16 p0, p1; qkt(p0, p1, L + A_KC + tc * SHM_T, qr, r32, hi);
            const int lim = ((s - 31) >> 4) - (tc * 64 + 4 * hi);
#pragma unroll
            for (int r = 0; r < 16; ++r) { const int cc = (r & 3) + 8 * (r >> 2);
                p0[r] = (cc <= lim) ? p0[r] : -INFINITY; p1[r] = (cc + 32 <= lim) ? p1[r] : -INFINITY; }
            float alpha; bf16x8 pa0, pa1, pa2, pa3;
            softmax_tile(p0, p1, m, l, alpha, pa0, pa1, pa2, pa3);
            if (__any(alpha < 1.f)) { if (hi == 0) al_c[r32] = alpha; asm volatile("s_waitcnt lgkmcnt(0)" ::: "memory");
#pragma unroll
                for (int d = 0; d < 4; ++d)
#pragma unroll
                    for (int r = 0; r < 16; ++r) o[d][r] *= al_c[crow(r, hi)]; }
            pv_d0_lean(o, vbc + tc * SHM_T, pa0, pa1, pa2, pa3);
        }
    }
    const float inv_l = l > 0.f ? 1.f / l : 0.f, mC = -m * C2;
    SEC();
#ifndef T_NOPASS2
    {
        f32x16 imp0, imp1;
#pragma unroll
        for (int e = 0; e < 16; ++e) { imp0[e] = 0.f; imp1[e] = 0.f; }
#pragma unroll 1
        for (int tc = 0; tc < 4; ++tc) {
            f32x16 p0, p1; qkt(p0, p1, L + A_KC + tc * SHM_T, qr, r32, hi);
            const int kb = tc * 64 + 4 * hi;
#pragma unroll
            for (int r = 0; r < 16; ++r) { const int c = kb + (r & 3) + 8 * (r >> 2);
                p0[r] = (16 * c + 31 <= s) ? __builtin_amdgcn_exp2f(fmaf(p0[r], C2, mC)) * inv_l : 0.f;
                p1[r] = (16 * (c + 32) + 31 <= s) ? __builtin_amdgcn_exp2f(fmaf(p1[r], C2, mC)) * inv_l : 0.f; }
#pragma unroll
            for (int ks = 0; ks < 4; ++ks) {
                unsigned hh[4], ll[4];
#pragma unroll
                for (int i = 0; i < 4; ++i) { const int r = 8 * (ks & 1) + 2 * i; const float a = (ks < 2) ? p0[r] : p1[r], bq = (ks < 2) ? p0[r + 1] : p1[r + 1];
                    hh[i] = cvtpk(a, bq); ll[i] = cvtpk(a - __uint_as_float(hh[i] << 16), bq - __uint_as_float(hh[i] & 0xffff0000u)); }
                const bf16x8 pah = pks(hh[0], hh[1], hh[2], hh[3]), pal = pks(ll[0], ll[1], ll[2], ll[3]);
                int jv = r32; asm volatile("" : "+v"(jv));
                const int c0 = tc * 64 + ks * 16 + 8 * hi;
                if (tc <= 1) { const bf16x8 hf = hfrag(c0, jv); imp0 = __builtin_amdgcn_mfma_f32_32x32x16_bf16(pah, hf, imp0, 0, 0, 0); imp0 = __builtin_amdgcn_mfma_f32_32x32x16_bf16(pal, hf, imp0, 0, 0, 0); }
                if (tc >= 1) { const bf16x8 hf = hfrag(c0, 32 + jv); imp1 = __builtin_amdgcn_mfma_f32_32x32x16_bf16(pah, hf, imp1, 0, 0, 0); imp1 = __builtin_amdgcn_mfma_f32_32x32x16_bf16(pal, hf, imp1, 0, 0, 0); }
            }
        }
        LAS float* impw0 = (LAS float*)(L + A_IMP) + wave * 512;
#pragma unroll
        for (int e = 0; e < 4; ++e) {
            impw0[(e + 4 * hi) * 64 + r32] = (imp0[e] + imp0[4 + e]) + (imp0[8 + e] + imp0[12 + e]);
            impw0[(e + 4 * hi) * 64 + 32 + r32] = (imp1[e] + imp1[4 + e]) + (imp1[8 + e] + imp1[12 + e]);
        }
    }
#endif
    SEC();
    LAS unsigned* selw = (LAS unsigned*)(L + A_SEL) + wave * 16;
    {
        unsigned key[8], T[8];
#pragma unroll
        for (int qi = 0; qi < 8; ++qi) {
            const int sq = q0 + 8 * wave + qi, j = lane;
            const float iv = impw[qi * 64 + lane];
            const bool forced = (j == 0) || (j == qb) || (j == qb - 1);
            const bool valid = (j * 64 <= sq);
            const float score = forced ? 1e6f : (valid ? iv : -INFINITY);
            key[qi] = (score == -INFINITY) ? 0u : (__float_as_uint(fmaxf(score, 0.f)) + 1u); T[qi] = 0u;
        }
#pragma unroll
        for (int bb = 30; bb >= 0; --bb)
#pragma unroll
            for (int qi = 0; qi < 8; ++qi) { const unsigned cand = T[qi] | (1u << bb); if (__popcll(__ballot(key[qi] >= cand)) >= NSEL) T[qi] = cand; }
#pragma unroll
        for (int qi = 0; qi < 8; ++qi) {
            const unsigned long long gt = __ballot(key[qi] > T[qi]), eq = __ballot(key[qi] == T[qi]);
            const int need = NSEL - (int)__popcll(gt);
            const int below = (int)__builtin_amdgcn_mbcnt_hi((unsigned)(eq >> 32), __builtin_amdgcn_mbcnt_lo((unsigned)eq, 0u));
            const bool sel = (key[qi] > T[qi]) || (key[qi] == T[qi] && T[qi] != 0u && below < need);
            const unsigned long long mk = __ballot(sel);
            if (lane == 0) { selw[2 * qi] = (unsigned)mk; selw[2 * qi + 1] = (unsigned)(mk >> 32); }
        }
    }
    asm volatile("s_waitcnt lgkmcnt(0)" ::: "memory");
    const unsigned mlo = selw[2 * (r32 & 7)], mhi = selw[2 * (r32 & 7) + 1];
    SEC();
    SEC();
    asm volatile("s_waitcnt lgkmcnt(0)" ::: "memory");
    __builtin_amdgcn_s_barrier();
    asm volatile("" ::: "memory");
    float m_reg = -1e30f, l_reg = 0.f;
    const bf16* kvb = proj + (size_t)(b * SEQ) * LDP + g * 128;
    bf16* obaseC = outC + (size_t)(b * SEQ + q0 + 8 * wave) * 2048 + g * 512;
    auto pre = [&]() {
        if (hi == 0) sc_l[r32] = inv_l;
        asm volatile("s_waitcnt lgkmcnt(0)" ::: "memory");
        store_tile_direct(o, sc_l, [&](int row) { return obaseC + (size_t)(row & 7) * 2048 + (row >> 3) * 128; }, lane);
#pragma unroll
        for (int d = 0; d < 4; ++d)
#pragma unroll
            for (int e = 0; e < 16; ++e) o[d][e] = 0.f;
    };
    attn_stream<MaskSel, NeedAll, STD_VMOPS>(L, kvb + OFF_KS, kvb + OFF_VS, (size_t)LDP, 0, qb + 1, qr, MaskSel{mlo, mhi, s, qb}, NeedAll{}, o, m_reg, l_reg, tid, lane, wave, pre SSEC_ARG);
    SEC();
    if (hi == 0) sc_l[r32] = 1.f / l_reg;
    asm volatile("s_waitcnt lgkmcnt(0)" ::: "memory");
    {
        bf16* obase = outS + (size_t)(b * SEQ + q0 + 8 * wave) * 2048 + g * 512;
        store_tile_direct(o, sc_l, [&](int row) { return obase + (size_t)(row & 7) * 2048 + (row >> 3) * 128; }, lane);
    }
    SEC();
}
__device__ __forceinline__ void compress_unit(LAS unsigned char* L, const bf16* proj, int coloff, const bf16* W1T, const float* bias1, const float* w2, bf16* outkc,
                                              int b, int g, int cblk, int tid, int lane, int wave) {
    const int r32 = lane & 31, hi = lane >> 5, n = wave & 3, th = wave >> 2;
    const int tokbase = 16 * (32 * cblk + r32);
    f32x16 acc;
#pragma unroll
    for (int e = 0; e < 16; ++e) acc[e] = 0.f;
    const bf16* arow = proj + (size_t)(b * SEQ) * LDP + coloff + g * 128 + hi * 8;
    const bf16* brow = W1T + (size_t)(32 * n + r32) * 4096 + hi * 8;
#pragma unroll 2
    for (int t = 16 * th; t < 16 * th + 16; ++t) {
        int tok = tokbase + t; tok = tok < SEQ ? tok : SEQ - 1;
        const bf16* ap = arow + (size_t)tok * LDP; const bf16* bp = brow + t * 128;
#pragma unroll
        for (int ks = 0; ks < 8; ++ks) acc = __builtin_amdgcn_mfma_f32_32x32x16_bf16(*(const bf16x8*)(ap + 16 * ks), *(const bf16x8*)(bp + 16 * ks), acc, 0, 0, 0);
    }
    LAS float* part = (LAS float*)L + th * 4096;
#pragma unroll
    for (int r = 0; r < 16; ++r) part[crow(r, hi) * 128 + 32 * n + r32] = acc[r];
    __syncthreads();
    LAS float* hid = (LAS float*)L + 8192;
    for (int e = tid; e < 4096; e += NWAVES * 64) { const float v = ((LAS float*)L)[e] + ((LAS float*)L)[4096 + e] + bias1[e & 127];
        const float uu = 0.7978845608028654f * (v + 0.044715f * v * v * v); hid[e] = 0.5f * v * (1.f + tanhf(uu)); }
    __syncthreads();
    const int j2 = tid & 127, cg = tid >> 7;
    float oacc[8];
#pragma unroll
    for (int k = 0; k < 8; ++k) oacc[k] = 0.f;
#pragma unroll 16
    for (int j = 0; j < 128; ++j) { const float w = w2[j * 128 + j2];
#pragma unroll
        for (int k = 0; k < 8; ++k) oacc[k] += hid[(cg * 8 + k) * 128 + j] * w; }
#pragma unroll
    for (int k = 0; k < 8; ++k) { const int c = 32 * cblk + cg * 8 + k; outkc[((size_t)(b * GB + g) * 256 + c) * 128 + j2] = (c < NC) ? (bf16)f2bf(oacc[k]) : (bf16)0; }
    __syncthreads();
}
__device__ __forceinline__ void gate_unit(LAS unsigned char* L, const bf16* h, const bf16* Wg, const float* rowsq0, float* gates, int row0, int tid, int lane, int wave) {
    const int r32 = lane & 31, hi = lane >> 5, rt = wave & 1, kq = wave >> 1;
    f32x16 acc0, acc1;
#pragma unroll
    for (int e = 0; e < 16; ++e) { acc0[e] = 0.f; acc1[e] = 0.f; }
    const bf16* ap = h + (size_t)(row0 + 32 * rt + r32) * D_MODEL + kq * 1024 + hi * 8;
    const bf16* bp0 = Wg + (size_t)r32 * D_MODEL + kq * 1024 + hi * 8; const bf16* bp1 = bp0 + (size_t)32 * D_MODEL;
#pragma unroll 8
    for (int ks = 0; ks < 64; ++ks) {
        const bf16x8 a = *(const bf16x8*)(ap + 16 * ks), b0 = *(const bf16x8*)(bp0 + 16 * ks), b1 = *(const bf16x8*)(bp1 + 16 * ks);
        acc0 = __builtin_amdgcn_mfma_f32_32x32x16_bf16(a, b0, acc0, 0, 0, 0); acc1 = __builtin_amdgcn_mfma_f32_32x32x16_bf16(a, b1, acc1, 0, 0, 0);
    }
    LAS float* part = (LAS float*)L + wave * 2048;
#pragma unroll
    for (int r = 0; r < 16; ++r) { part[crow(r, hi) * 64 + r32] = acc0[r]; part[crow(r, hi) * 64 + 32 + r32] = acc1[r]; }
    __syncthreads();
    for (int e = tid; e < 64 * 48; e += NWAVES * 64) { const int row = e / 48, col = e % 48, rtt = row >> 5, rr = row & 31;
        const LAS float* p = (const LAS float*)L + rtt * 2048 + rr * 64 + col;
        const float v = (p[0] + p[2 * 2048]) + (p[4 * 2048] + p[6 * 2048]);
        gates[(size_t)(row0 + row) * 48 + col] = sigmoidf_(v / sqrtf(rowsq0[row0 + row] * (1.f / 4096.f) + EPS)); }
    __syncthreads();
}
}
__device__ __forceinline__ float wave_sum(float v) {
#pragma unroll
    for (int o = 1; o < 64; o <<= 1) v += __shfl_xor(v, o);
    return v;
}
__device__ __forceinline__ float wave_max(float v) {
#pragma unroll
    for (int o = 1; o < 64; o <<= 1) v = fmaxf(v, __shfl_xor(v, o));
    return v;
}
__device__ __forceinline__ void p0_transpose_item(const float* W, int N, int nvalid, bf16* WT, size_t ldt, int k0, int n0, int drow0, LAS float* scr, int lane, const float* kgain = nullptr, float fp8scale = 0.f) {
    const int rr = lane >> 3, c4 = lane & 7, nn = n0 + 4 * c4; const bool ok = nn < nvalid;
    const GAS f32x4* src = (const GAS f32x4*)(W + (size_t)(k0 + rr) * N + nn);
    f32x4 v[8];
#pragma unroll
    for (int i = 0; i < 8; ++i) v[i] = ok ? src[(size_t)i * 2 * N] : (f32x4){0.f, 0.f, 0.f, 0.f};
#pragma unroll
    for (int i = 0; i < 8; ++i) { LAS float* d = scr + (8 * i + rr) * 33 + 4 * c4; const float gk = kgain ? kgain[k0 + 8 * i + rr] : 1.f; d[0] = v[i].x * gk; d[1] = v[i].y * gk; d[2] = v[i].z * gk; d[3] = v[i].w * gk; }
    LDS_WAIT(); asm volatile("" ::: "memory");
    const int c = lane & 7;
#pragma unroll
    for (int j = 0; j < 4; ++j) { const int n = (lane >> 3) + 8 * j; const LAS float* s = scr + (8 * c) * 33 + n;
        if (fp8scale != 0.f) {
            int w0 = __builtin_amdgcn_cvt_pk_fp8_f32(s[0 * 33] * fp8scale, s[1 * 33] * fp8scale, 0, false); w0 = __builtin_amdgcn_cvt_pk_fp8_f32(s[2 * 33] * fp8scale, s[3 * 33] * fp8scale, w0, true);
            int w1 = __builtin_amdgcn_cvt_pk_fp8_f32(s[4 * 33] * fp8scale, s[5 * 33] * fp8scale, 0, false); w1 = __builtin_amdgcn_cvt_pk_fp8_f32(s[6 * 33] * fp8scale, s[7 * 33] * fp8scale, w1, true);
            *(GAS v2u*)((GAS unsigned char*)WT + (size_t)(drow0 + n) * ldt + k0 + 8 * c) = (v2u){(unsigned)w0, (unsigned)w1};
        } else {
        v4u o; o.x = pk2(s[0 * 33], s[1 * 33]); o.y = pk2(s[2 * 33], s[3 * 33]); o.z = pk2(s[4 * 33], s[5 * 33]); o.w = pk2(s[6 * 33], s[7 * 33]);
        *(GAS v4u*)(WT + (size_t)(drow0 + n) * ldt + k0 + 8 * c) = o; } }
    LDS_WAIT(); asm volatile("" ::: "memory");
}
__device__ __forceinline__ void row_to_bf16_sumsq(const float* xrow, bf16* orow, float* sumsq, int lane) {
    const GAS f32x4* xr = (const GAS f32x4*)xrow + lane;
    f32x4 v[16]; float s = 0.f;
#pragma unroll
    for (int j = 0; j < 16; ++j) { v[j] = xr[64 * j]; s += (v[j].x * v[j].x + v[j].y * v[j].y) + (v[j].z * v[j].z + v[j].w * v[j].w); }
    s = wave_sum(s);
    if (lane == 0) *sumsq = s;
    GAS v2u* o8 = (GAS v2u*)orow + lane;
#pragma unroll
    for (int j = 0; j < 16; ++j) { v2u w; w.x = pk2(v[j].x, v[j].y); w.y = pk2(v[j].z, v[j].w); o8[64 * j] = w; }
}
__device__ __forceinline__ void rms_row_inplace(float* xrow, const float* g, int lane) {
    GAS f32x4* xr = (GAS f32x4*)xrow + lane; const GAS f32x4* gr = (const GAS f32x4*)g + lane;
    f32x4 v[16]; float s = 0.f;
#pragma unroll
    for (int j = 0; j < 16; ++j) { v[j] = xr[64 * j]; s += (v[j].x * v[j].x + v[j].y * v[j].y) + (v[j].z * v[j].z + v[j].w * v[j].w); }
    const float rs = 1.f / sqrtf(wave_sum(s) * (1.f / 4096.f) + EPS);
#pragma unroll
    for (int j = 0; j < 16; ++j) { const f32x4 gg = gr[64 * j]; xr[64 * j] = v[j] * rs * gg; }
}

struct Args { const float* in[17]; float* out; unsigned char* ws; float inv[16]; int ph_lo, ph_hi, li, pad; };
constexpr int N_PHASES = 10;
__global__ void __launch_bounds__(NWAVES * 64, 2) mega(Args args) {
    extern __shared__ __attribute__((aligned(16))) unsigned char lds[];
    LAS unsigned char* L = (LAS unsigned char*)lds;
    volatile LAS unsigned* MISC = (volatile LAS unsigned*)(L + MISC_OFF);
    const int tid = threadIdx.x, lane = tid & 63, wave = __builtin_amdgcn_readfirstlane(tid >> 6);
    const int G = gridDim.x;
    unsigned char* ws = args.ws;
    gu32* ctl = (gu32*)(ws + WS_CTL);
    const float* x = args.in[0]; const float* norm_attn = args.in[1]; const float* w_in = args.in[2];
    const float* w_out = args.in[11]; const float* norm_ffn = args.in[12]; const float* w_gate = args.in[13]; const float* w_up = args.in[14]; const float* w_down = args.in[15];
    const float* norm_final = args.in[16];
    float* out = args.out;
    bf16* Win_t = (bf16*)(ws + WS_WIN); bf16* Wout_t = (bf16*)(ws + WS_WOUT); bf16* Wgu_t = (bf16*)(ws + WS_WGU); bf16* Wdn_t = (bf16*)(ws + WS_WDN);
    bf16* bufA = (bf16*)(ws + WS_BUFA); bf16* proj = (bf16*)(ws + WS_PROJ); bf16* mixed = proj; bf16* act = proj;
    float* cs = (float*)(ws + WS_CS);
    const float* ck_pe = args.in[3]; const float* ck_w1 = args.in[4]; const float* ck_w2 = args.in[5];
    const float* cv_pe = args.in[6]; const float* cv_w1 = args.in[7]; const float* cv_w2 = args.in[8];
    const float* out_norm_a = args.in[9]; const float* out_norm_b = args.in[10];
    bf16* kcb = (bf16*)(ws + WS_KCB); bf16* vcb = (bf16*)(ws + WS_KCB + 1 * MiB);
    bf16* ckW1T = (bf16*)(ws + WS_W1T); bf16* cvW1T = (bf16*)(ws + WS_W1T + 1 * MiB);
    float* bias1 = (float*)(ws + WS_BIAS1); float* lse = (float*)(ws + WS_LSE);
    bf16* partA = (bf16*)out;
    bf16* partC = (bf16*)out + (size_t)3 * T * 2048;
    bf16* partS = (bf16*)(ws + WS_PART); bf16* partW = partS + (size_t)T * 2048;
    unsigned char* x1f8 = ws + WS_PART;
    float* rowsq = (float*)(ws + WS_ROWSQ);
    float* gates = (float*)(ws + WS_GATES);
    for (int u = tid; u < (LDS_BYTES - LDSCTL_OFF) / 4; u += NWAVES * 64) ((LAS unsigned*)(L + LDSCTL_OFF))[u] = 0u;
    __syncthreads();
    const int lo = args.ph_lo, hi = args.ph_hi;
    const bool one_launch = (hi - lo) > 1;
    XcdBarrier bar; bar.bar = (unsigned*)(ctl + CW_BAR) + args.li * XCD_BAR_WORDS; bar.x = 0; bar.st = nullptr;
    if (one_launch) bar = xcd_barrier_post((unsigned*)(ctl + CW_BAR) + args.li * XCD_BAR_WORDS, MISC + 8);
#ifndef MK_PH
#define MK_PH 0x3ff
#endif
#define IN(k) ((((MK_PH) >> (k)) & 1) && lo <= (k) && (k) < hi)
#ifdef MK_TPROBE
    unsigned long long ts_a = 0, ts_b = 0, sec_acc = 0; int ts_n = 0;
#define TS() do { unsigned long long t_; asm volatile("s_memrealtime %0\n\ts_waitcnt lgkmcnt(0)" : "=s"(t_) :: "memory"); if (ts_n == MK_TPROBE) ts_a = t_; if (ts_n == MK_TPROBE + 1) ts_b = t_; ++ts_n; } while (0)
#else
#define TS() do { } while (0)
#endif
    TS();
#define BOTH(k) (IN(k) && IN((k) + 1))
    const int gw = blockIdx.x * NWAVES + wave, NGW = G * NWAVES;

    if (IN(0)) {
        LAS float* scr = (LAS float*)(L + RING_OFF + wave * 16384);
        constexpr int I_IN = 64 * 360, I_OUT = 64 * 128, I_G = 64 * 344, I_D = 172 * 128, I_W1 = 64 * 4;
        constexpr int NITEMS = I_IN + I_OUT + 2 * I_G + I_D + 2 * I_W1;
        for (int it = gw; it < NITEMS; it += NGW) {
            int r = it;
            if (r < I_IN) { const int kb = r / 360, nb = r % 360; p0_transpose_item(w_in, D_IN, D_IN, Win_t, 4096, 64 * kb, 32 * nb, 32 * nb, scr, lane, norm_attn); continue; } r -= I_IN;
            if (r < I_OUT) { const int kb = r / 128, nb = r % 128; p0_transpose_item(w_out, 4096, 4096, Wout_t, 4096, 64 * kb, 32 * nb, 32 * nb, scr, lane); continue; } r -= I_OUT;
            if (r < I_G) { const int kb = r / 344, nb = r % 344, n0 = 32 * nb; p0_transpose_item(w_gate, D_FF, D_FF, Wgu_t, 4096, 64 * kb, n0, 256 * (n0 >> 7) + (n0 & 127), scr, lane, norm_ffn, WGU_SCALE); continue; } r -= I_G;
            if (r < I_G) { const int kb = r / 344, nb = r % 344, n0 = 32 * nb; p0_transpose_item(w_up, D_FF, D_FF, Wgu_t, 4096, 64 * kb, n0, 256 * (n0 >> 7) + 128 + (n0 & 127), scr, lane, norm_ffn, WGU_SCALE); continue; } r -= I_G;
            if (r < I_D) { const int kb = r / 128, nb = r % 128; p0_transpose_item(w_down, 4096, 4096, Wdn_t, D_FF, 64 * kb, 32 * nb, 32 * nb, scr, lane, nullptr, WDN_SCALE); continue; } r -= I_D;
            if (r < I_W1) { const int kb = r / 4, nb = r % 4; p0_transpose_item(ck_w1, 128, 128, ckW1T, 4096, 64 * kb, 32 * nb, 32 * nb, scr, lane); continue; } r -= I_W1;
            { const int kb = r / 4, nb = r % 4; p0_transpose_item(cv_w1, 128, 128, cvW1T, 4096, 64 * kb, 32 * nb, 32 * nb, scr, lane); }
        }
        for (int o = gw; o < 256; o += NGW) {
            const int which = o >> 7, j = o & 127; const float* pe = which ? cv_pe : ck_pe; const float* w1 = which ? cv_w1 : ck_w1;
            float a = 0.f;
            for (int i = lane; i < 4096; i += 64) a += pe[i] * w1[(size_t)i * 128 + j];
            a = wave_sum(a);
            if (lane == 0) bias1[o] = a;
        }
        for (int idx = blockIdx.x * (NWAVES * 64) + tid; idx < SEQ * 16; idx += G * NWAVES * 64) {
            const int s = idx >> 4, i = idx & 15; const float ang = (float)s * args.inv[i]; const double a = (double)ang;
            cs[2 * idx] = (float)cos(a); cs[2 * idx + 1] = (float)sin(a);
        }
        for (int m = gw; m < T; m += NGW) row_to_bf16_sumsq(x + (size_t)m * D_MODEL, bufA + (size_t)m * D_MODEL, rowsq + 2 * T + m, lane);
        for (int i = blockIdx.x * (NWAVES * 64) + tid; i < 2 * T; i += G * NWAVES * 64) rowsq[i] = 0.f;
        if (BOTH(0)) xcd_barrier(bar);
        TS();
    }
    if (IN(1)) {
        pg8::Gemm g{bufA, Win_t, T, OFF_GL, D_MODEL}; pg8::StaticOrder S; S.init(T, OFF_GL, G, (int)blockIdx.x);
        pg8::EpiProj E{proj, LDP, cs, rowsq + 2 * T, 1.f / 4096.f, EPS};
        pg8::gemm_phase<pg8::EpiProj, pg8::StaticOrder, true, true>(L + RING_OFF, g, S, E);
        if (BOTH(1)) xcd_barrier(bar);
        TS();
    }
    if (IN(2)) {
        for (int cu = blockIdx.x; cu < 256; cu += G) { const int which = cu >> 7, r = cu & 127;
            att::compress_unit(L, proj, which ? OFF_VC : OFF_KC, which ? cvW1T : ckW1T, bias1 + which * 128, which ? cv_w2 : ck_w2, which ? vcb : kcb, r >> 5, (r >> 3) & 3, r & 7, tid, lane, wave); }
        TS();
        for (int u = blockIdx.x; u < T / 64; u += G) att::gate_unit(L, bufA, Win_t + (size_t)OFF_GL * D_MODEL, rowsq + 2 * T, gates, 64 * u, tid, lane, wave);
        TS();
        for (int u = blockIdx.x; u < 1024; u += G) att::window_unit(L, proj, partW, u, tid, lane, wave SECARG);
        TS();
        for (int u = blockIdx.x; u < 3072; u += G) att::dilated_unit(L, proj, partA, lse, u, tid, lane, wave SECARG);
        TS();
        if (BOTH(2)) xcd_barrier(bar);
        TS();
    }
    if (IN(3)) {
        for (int rd = 0; rd * G < 1024; ++rd) {
            const int idx = (rd & 1) ? rd * G + (G - 1 - (int)blockIdx.x) : rd * G + (int)blockIdx.x;
            if (idx < 1024) { const int qb = 63 - (idx >> 4), bg = idx & 15; att::nsa_unit(L, proj, kcb, vcb, partC, partS, bg >> 2, bg & 3, qb, tid, lane, wave SECARG); }
        }
        TS();
        if (BOTH(3)) xcd_barrier(bar);
        TS();
    }
    if (IN(4)) {
        for (int it = gw; it < 2 * T; it += NGW) {
            const int m = it >> 1, grp = it & 1;
            float ov[32]; float ss = 0.f;
            if (grp == 0) {
#pragma unroll
                for (int k = 0; k < 4; ++k) {
                    const int ch = lane + 64 * k, head = ch >> 4;
                    const float l0 = lse[((size_t)0 * T + m) * 16 + head], l1 = lse[((size_t)1 * T + m) * 16 + head], l2 = lse[((size_t)2 * T + m) * 16 + head];
                    const float mx = fmaxf(l0, fmaxf(l1, l2)); const float e0 = __expf(l0 - mx), e1 = __expf(l1 - mx), e2 = __expf(l2 - mx); const float inv = 1.f / (e0 + e1 + e2);
                    const float w0 = e0 * inv, w1 = e1 * inv, w2 = e2 * inv;
                    const size_t off = (size_t)m * 2048 + 8 * ch;
                    const v4u x0 = *(const v4u*)(partA + off), x1 = *(const v4u*)(partA + (size_t)T * 2048 + off), x2 = *(const v4u*)(partA + (size_t)2 * T * 2048 + off);
#pragma unroll
                    for (int e = 0; e < 4; ++e) {
                        const float alo = w0 * __uint_as_float(x0[e] << 16) + w1 * __uint_as_float(x1[e] << 16) + w2 * __uint_as_float(x2[e] << 16);
                        const float ahi = w0 * __uint_as_float(x0[e] & 0xffff0000u) + w1 * __uint_as_float(x1[e] & 0xffff0000u) + w2 * __uint_as_float(x2[e] & 0xffff0000u);
                        ov[8 * k + 2 * e] = alo; ov[8 * k + 2 * e + 1] = ahi; ss += alo * alo + ahi * ahi;
                    }
                }
            } else {
#pragma unroll
                for (int k = 0; k < 4; ++k) {
                    const int ch = lane + 64 * k, head = ch >> 4;
                    const size_t off = (size_t)m * 2048 + 8 * ch;
                    const float gc = gates[(size_t)m * 48 + head * 3], gs = gates[(size_t)m * 48 + head * 3 + 1], gw_ = gates[(size_t)m * 48 + head * 3 + 2];
                    const v4u y0 = *(const v4u*)(partC + off), y1 = *(const v4u*)(partS + off), y2 = *(const v4u*)(partW + off);
#pragma unroll
                    for (int e = 0; e < 4; ++e) {
                        const float blo = gc * __uint_as_float(y0[e] << 16) + gs * __uint_as_float(y1[e] << 16) + gw_ * __uint_as_float(y2[e] << 16);
                        const float bhi = gc * __uint_as_float(y0[e] & 0xffff0000u) + gs * __uint_as_float(y1[e] & 0xffff0000u) + gw_ * __uint_as_float(y2[e] & 0xffff0000u);
                        ov[8 * k + 2 * e] = blo; ov[8 * k + 2 * e + 1] = bhi; ss += blo * blo + bhi * bhi;
                    }
                }
            }
            const float rs = 1.f / sqrtf(wave_sum(ss) * (1.f / 2048.f) + EPS);
            const float* gn = grp ? out_norm_b : out_norm_a;
#pragma unroll
            for (int k = 0; k < 4; ++k) {
                const int ch = lane + 64 * k;
                const f32x4 g0 = *(const f32x4*)(gn + 8 * ch), g1 = *(const f32x4*)(gn + 8 * ch + 4);
                v4u w;
                w.x = pk2(ov[8 * k + 0] * rs * g0.x, ov[8 * k + 1] * rs * g0.y); w.y = pk2(ov[8 * k + 2] * rs * g0.z, ov[8 * k + 3] * rs * g0.w);
                w.z = pk2(ov[8 * k + 4] * rs * g1.x, ov[8 * k + 5] * rs * g1.y); w.w = pk2(ov[8 * k + 6] * rs * g1.z, ov[8 * k + 7] * rs * g1.w);
                *(v4u*)(mixed + (size_t)m * D_MODEL + grp * 2048 + 8 * ch) = w;
            }
        }
        if (BOTH(4)) xcd_barrier(bar);
        TS();
    }

    if (IN(5)) {
        pg8::Gemm g{mixed, Wout_t, T, D_MODEL, D_MODEL}; pg8::StaticOrder S; S.init(T, D_MODEL, G, (int)blockIdx.x);
        pg8::EpiResid<true> E{bufA, bufA, rowsq, x1f8, D_MODEL, 1.f};
        pg8::gemm_phase<pg8::EpiResid<true>, pg8::StaticOrder, true, true>(L + RING_OFF, g, S, E);
        if (IN(7)) xcd_barrier(bar);
        TS();
    }
    if (IN(7)) {
        pg8::Gemm g{(const bf16*)x1f8, Wgu_t, T, NGU, D_MODEL / 2}; pg8::StaticOrder S; S.init(T, NGU, G, (int)blockIdx.x);
        pg8::EpiSwiglu<true> E{act, D_FF, rowsq, 1.f / 4096.f, EPS, 1.f / WGU_SCALE};
        pg8::gemm_phase<pg8::EpiSwiglu<true>, pg8::StaticOrder, true, true, true>(L + RING_OFF, g, S, E);
        if (BOTH(7)) xcd_barrier(bar);
        TS();
    }
    if (IN(8)) {
        pg8::Gemm g{act, Wdn_t, T, D_MODEL, D_FF / 2}; pg8::StaticOrder S; S.init(T, D_MODEL, G, (int)blockIdx.x);
        pg8::EpiResid<true> E{bufA, bufA, rowsq + T, nullptr, D_MODEL, 1.f / WDN_SCALE};
        pg8::gemm_phase<pg8::EpiResid<true>, pg8::StaticOrder, true, P8_SP2, true>(L + RING_OFF, g, S, E);
        if (BOTH(8)) xcd_barrier(bar);
        TS();
    }
    if (IN(9)) {
        for (int m = gw; m < T; m += NGW) {
            const float rs = 1.f / sqrtf(rowsq[T + m] * (1.f / 4096.f) + EPS);
            const GAS v2u* xr = (const GAS v2u*)(bufA + (size_t)m * D_MODEL) + lane; const GAS f32x4* gr = (const GAS f32x4*)norm_final + lane; GAS f32x4* orow = (GAS f32x4*)(out + (size_t)m * D_MODEL) + lane;
            v2u v[16];
#pragma unroll
            for (int j = 0; j < 16; ++j) v[j] = xr[64 * j];
#pragma unroll
            for (int j = 0; j < 16; ++j) { const f32x4 gg = gr[64 * j];
                orow[64 * j] = (f32x4){__uint_as_float(v[j].x << 16) * rs * gg.x, __uint_as_float(v[j].x & 0xffff0000u) * rs * gg.y, __uint_as_float(v[j].y << 16) * rs * gg.z, __uint_as_float(v[j].y & 0xffff0000u) * rs * gg.w}; }
        }
    }
    TS();
#ifdef MK_TPROBE
    if (blockIdx.x == 0) {
        unsigned long long d = 4ull * (MK_TSEC >= 0 ? sec_acc : (ts_b - ts_a)); if (d > 2000000ull) d = 2000000ull;
        unsigned long long t0_; asm volatile("s_memrealtime %0\n\ts_waitcnt lgkmcnt(0)" : "=s"(t0_) :: "memory");
        for (;;) { unsigned long long t1_; asm volatile("s_memrealtime %0\n\ts_waitcnt lgkmcnt(0)" : "=s"(t1_) :: "memory"); if (t1_ - t0_ >= d) break; __builtin_amdgcn_s_sleep(8); }
    }
#endif
#undef IN
#undef BOTH
}

extern "C" void kernel_launch(void* const* d_in, const int* in_sizes, int n_in, void* d_out, int out_size, void* d_ws, size_t ws_size, hipStream_t stream) {
    static int grid = 0;
    if (grid == 0) {
        if (n_in != 17 || out_size != T * D_MODEL || ws_size < WS_END) { fprintf(stderr, "kernel_launch: unexpected shapes (n_in %d out %d ws %zu); nothing launched\n", n_in, out_size, ws_size); grid = -1; return; }
        int dev = 0, cus = 0, per_cu = 0;
        if (hipGetDevice(&dev) != hipSuccess || hipDeviceGetAttribute(&cus, hipDeviceAttributeMultiprocessorCount, dev) != hipSuccess) { grid = -1; return; }
        if (hipFuncSetAttribute((const void*)mega, hipFuncAttributeMaxDynamicSharedMemorySize, LDS_BYTES) != hipSuccess) { fprintf(stderr, "kernel_launch: hipFuncSetAttribute failed\n"); grid = -1; return; }
        if (hipOccupancyMaxActiveBlocksPerMultiprocessor(&per_cu, (const void*)mega, NWAVES * 64, LDS_BYTES) != hipSuccess || per_cu < 1)
            fprintf(stderr, "kernel_launch: note: occupancy query reports %d workgroups per CU\n", per_cu);
        (void)hipGetLastError();
        grid = cus;
    }
    if (grid < 0) return;
    if (hipMemsetAsync((char*)d_ws + WS_CTL, 0, CTL_ZERO_BYTES, stream) != hipSuccess) return;
    Args a{};
    for (int i = 0; i < 17; ++i) a.in[i] = (const float*)d_in[i];
    a.out = (float*)d_out; a.ws = (unsigned char*)d_ws;
    for (int i = 0; i < 16; ++i) a.inv[i] = (float)pow(500000.0, -(double)(2 * i) / 32.0);
    unsigned char* ws = (unsigned char*)d_ws;
    int n_launch = 0;
    auto launch = [&](int lo, int hi) { a.ph_lo = lo; a.ph_hi = hi; a.li = n_launch++; hipLaunchKernelGGL(mega, dim3(grid), dim3(NWAVES * 64), LDS_BYTES, stream, a); };
#if MK_BUILD == 2
    for (int ph = 0; ph < N_PHASES; ++ph) launch(ph, ph + 1);
#elif MK_BUILD == 3
    launch(0, N_PHASES);
#else
#if MK_PROBE == 0
    launch(0, N_PHASES); launch(0, 1);
#elif MK_PROBE == 7
    launch(0, N_PHASES); launch(7, 8);
#else
    launch(0, MK_PROBE + 1); launch(MK_PROBE, MK_PROBE + 1); launch(MK_PROBE + 1, N_PHASES);
#endif
#endif
    const hipError_t le = hipPeekAtLastError();
    if (le != hipSuccess) fprintf(stderr, "kernel_launch: launch failed: %s\n", hipGetErrorName(le));
}
```

```cpp
#include <hip/hip_runtime.h>
#include <cstdio>
#include <cstdint>
#include <math.h>

#ifndef MK_TSEC
#define MK_TSEC -1
#endif
#ifndef MK_TWAVE
#define MK_TWAVE 0
#endif
#ifndef MK_TUNIT
#define MK_TUNIT 2
#endif
#ifndef MK_BUILD
#define MK_BUILD 3
#endif
namespace pg8 {
#define PG8_LAS __attribute__((address_space(3)))
typedef unsigned short bf16_t;
typedef short bf16x8 __attribute__((ext_vector_type(8)));
typedef float f32x4 __attribute__((ext_vector_type(4)));
typedef unsigned u32x4 __attribute__((ext_vector_type(4)));
constexpr int BM = 256, BK = 64, HALF = 128, HTB = HALF * BK * 2  , STAGE_BYTES = 8 * HTB, NXCD = 8, WGM = 8;

__host__ __device__ __forceinline__ int lds_byte(int r, int c) { const int st = (r >> 4) * 2 + (c >> 5), rr = r & 15, cc = c & 31, ob = rr * 64 + cc * 2; return st * 1024 + (ob ^ (((ob >> 9) & 1) << 5)); }
__host__ __device__ __forceinline__ void stage_rc(int b, int& R, int& C) { const int st = b / 1024, sb = b % 1024, swz = sb ^ (((sb >> 9) & 1) << 5); R = (st >> 1) * 16 + swz / 64; C = (st & 1) * 32 + (swz % 64) / 2; }
__host__ __device__ __forceinline__ int perm32(int rho) { const int n = rho >> 4, i = rho & 15; return 8 * (i >> 2) + 4 * n + (i & 3); }

struct Unit { int pm, pn; };
struct Gemm { const bf16_t* A; const bf16_t* Bt; int M, N, K; };

struct StaticOrder {
    int nM, nN, nwg, G, c;
    __host__ __device__ void init(int M, int N, int G_, int c_) { nM = M / BM; nN = N / BM; nwg = nM * nN; G = G_; c = c_; }
    __host__ __device__ bool next(int i, Unit& u) const {
        const long L = (long)i * G + c; if (L >= nwg) return false;
        int wgid = (int)L; { const int q = nwg / NXCD, r = nwg % NXCD, xcd = wgid % NXCD, off = wgid / NXCD; wgid = (xcd < r ? xcd * (q + 1) : r * (q + 1) + (xcd - r) * q) + off; }
        const int nig = WGM * nN, gid = wgid / nig, fm = gid * WGM, gsz = (nM - fm) < WGM ? (nM - fm) : WGM;
        u.pm = fm + ((wgid % nig) % gsz); u.pn = (wgid % nig) / gsz; return true;
    }
    __device__ __forceinline__ void a_ready(const Unit&) const {}
    __device__ __forceinline__ void done(const Unit&) const {}
};
__device__ __forceinline__ unsigned cvt_pk_bf16(float lo, float hi) { unsigned r; asm volatile("v_cvt_pk_bf16_f32 %0, %1, %2" : "=v"(r) : "v"(lo), "v"(hi)); return r; }
typedef unsigned u32x4 __attribute__((ext_vector_type(4)));
typedef unsigned u32x2 __attribute__((ext_vector_type(2)));
struct EpiProj {
    static constexpr bool PERM = true, AFTER_DRAIN = false;
    bf16_t* O; int ldc; const float* cs; const float* rowsq; float inv_k, eps;
    __device__ __forceinline__ void operator()(const f32x4 (&acc)[2][2][4][2], const Unit& u, int wr, int wc, int fr, int fq) const {
        const int row0 = u.pm * BM + wr * 64 + fr;
        const int col0 = u.pn * BM + wc * 32 + 8 * fq;
#pragma unroll
        for (int bj = 0; bj < 2; ++bj) {
            const int hd = u.pn * 2 + bj;
            const bool rope = (wc == 0) && (hd < 32 || (hd >= 48 && hd < 68) || (hd >= 72 && hd < 76) || (hd >= 80 && hd < 84));
#pragma unroll
            for (int ai = 0; ai < 2; ++ai)
#pragma unroll
                for (int m = 0; m < 4; ++m) {
                    const int row = row0 + ai * HALF + m * 16;
                    const float rs = 1.f / sqrtf(rowsq[row] * inv_k + eps);
                    f32x4 v0 = acc[ai][bj][m][0] * rs, v1 = acc[ai][bj][m][1] * rs;
                    if (rope) {
                        f32x4 w0, w1;
#pragma unroll
                        for (int e = 0; e < 4; ++e) { w0[e] = __shfl_xor(v0[e], 32); w1[e] = __shfl_xor(v1[e], 32); }
                        const float* c = cs + ((size_t)(row & 4095) * 16 + 8 * (fq & 1)) * 2;
                        const f32x4 c0 = *(const f32x4*)c, c1 = *(const f32x4*)(c + 4), c2 = *(const f32x4*)(c + 8), c3 = *(const f32x4*)(c + 12);
                        const float cosv[8] = {c0[0], c0[2], c1[0], c1[2], c2[0], c2[2], c3[0], c3[2]};
                        const float sinv[8] = {c0[1], c0[3], c1[1], c1[3], c2[1], c2[3], c3[1], c3[3]};
                        if (fq < 2) {
#pragma unroll
                            for (int e = 0; e < 4; ++e) { v0[e] = v0[e] * cosv[e] - w0[e] * sinv[e]; v1[e] = v1[e] * cosv[4 + e] - w1[e] * sinv[4 + e]; }
                        } else {
#pragma unroll
                            for (int e = 0; e < 4; ++e) { v0[e] = w0[e] * sinv[e] + v0[e] * cosv[e]; v1[e] = w1[e] * sinv[4 + e] + v1[e] * cosv[4 + e]; }
                        }
                    }
                    u32x4 w; w.x = cvt_pk_bf16(v0[0], v0[1]); w.y = cvt_pk_bf16(v0[2], v0[3]); w.z = cvt_pk_bf16(v1[0], v1[1]); w.w = cvt_pk_bf16(v1[2], v1[3]);
                    *(u32x4*)(O + (size_t)row * ldc + col0 + bj * HALF) = w;
                }
        }
    }
};
template <bool R_BF16> struct EpiResid {
    static constexpr bool PERM = true, AFTER_DRAIN = false;
    const void* R; bf16_t* Ob; float* rowsq; unsigned char* O8; int ldc; float ascale;
    __device__ __forceinline__ void operator()(const f32x4 (&acc)[2][2][4][2], const Unit& u, int wr, int wc, int fr, int fq) const {
        const int row0 = u.pm * BM + wr * 64 + fr;
        const int col0 = u.pn * BM + wc * 32 + 8 * fq;
#pragma unroll
        for (int ai = 0; ai < 2; ++ai)
#pragma unroll
            for (int m = 0; m < 4; ++m) {
                const size_t ro = (size_t)(row0 + ai * HALF + m * 16) * ldc + col0;
                float ss = 0.f;
#pragma unroll
                for (int bj = 0; bj < 2; ++bj) {
                    f32x4 r0, r1;
                    if constexpr (R_BF16) { const u32x4 rb = *(const u32x4*)((const bf16_t*)R + ro + bj * HALF);
                        r0 = (f32x4){__builtin_bit_cast(float, rb.x << 16), __builtin_bit_cast(float, rb.x & 0xffff0000u), __builtin_bit_cast(float, rb.y << 16), __builtin_bit_cast(float, rb.y & 0xffff0000u)};
                        r1 = (f32x4){__builtin_bit_cast(float, rb.z << 16), __builtin_bit_cast(float, rb.z & 0xffff0000u), __builtin_bit_cast(float, rb.w << 16), __builtin_bit_cast(float, rb.w & 0xffff0000u)}; }
                    else { r0 = *(const f32x4*)((const float*)R + ro + bj * HALF); r1 = *(const f32x4*)((const float*)R + ro + bj * HALF + 4); }
                    const f32x4 o0 = r0 + acc[ai][bj][m][0] * ascale, o1 = r1 + acc[ai][bj][m][1] * ascale;
                    u32x4 w; w.x = cvt_pk_bf16(o0[0], o0[1]); w.y = cvt_pk_bf16(o0[2], o0[3]); w.z = cvt_pk_bf16(o1[0], o1[1]); w.w = cvt_pk_bf16(o1[2], o1[3]);
                    *(u32x4*)(Ob + ro + bj * HALF) = w;
                    if (O8) { int w0 = __builtin_amdgcn_cvt_pk_fp8_f32(o0[0], o0[1], 0, false); w0 = __builtin_amdgcn_cvt_pk_fp8_f32(o0[2], o0[3], w0, true);
                        int w1 = __builtin_amdgcn_cvt_pk_fp8_f32(o1[0], o1[1], 0, false); w1 = __builtin_amdgcn_cvt_pk_fp8_f32(o1[2], o1[3], w1, true);
                        *(u32x2*)(O8 + ro + bj * HALF) = (u32x2){(unsigned)w0, (unsigned)w1}; }
                    ss += (o0[0] * o0[0] + o0[1] * o0[1]) + (o0[2] * o0[2] + o0[3] * o0[3]) + (o1[0] * o1[0] + o1[1] * o1[1]) + (o1[2] * o1[2] + o1[3] * o1[3]);
                }
                ss += __shfl_xor(ss, 16); ss += __shfl_xor(ss, 32); if (fq == 0) atomicAdd(rowsq + (row0 + ai * HALF + m * 16), ss);
            }
    }
};
template <bool FP8OUT> struct EpiSwiglu {
    static constexpr bool PERM = true, AFTER_DRAIN = false;
    bf16_t* O; int ldc; const float* rowsq; float inv_k, eps, ascale;
    __device__ __forceinline__ static float silu_mul(float g, float uu) { return g * __builtin_amdgcn_rcpf(1.f + __builtin_amdgcn_exp2f(-1.4426950408889634f * g)) * uu; }
    __device__ __forceinline__ void operator()(const f32x4 (&acc)[2][2][4][2], const Unit& u, int wr, int wc, int fr, int fq) const {
        const int row0 = u.pm * BM + wr * 64 + fr;
        const int col0 = u.pn * HALF + wc * 32 + 8 * fq;
#pragma unroll
        for (int ai = 0; ai < 2; ++ai)
#pragma unroll
            for (int m = 0; m < 4; ++m) {
                const float rs = ascale / sqrtf(rowsq[row0 + ai * HALF + m * 16] * inv_k + eps);
                const f32x4 g0 = acc[ai][0][m][0] * rs, g1 = acc[ai][0][m][1] * rs, u0 = acc[ai][1][m][0] * rs, u1 = acc[ai][1][m][1] * rs;
                if constexpr (FP8OUT) {
                    int w0 = __builtin_amdgcn_cvt_pk_fp8_f32(silu_mul(g0[0], u0[0]), silu_mul(g0[1], u0[1]), 0, false); w0 = __builtin_amdgcn_cvt_pk_fp8_f32(silu_mul(g0[2], u0[2]), silu_mul(g0[3], u0[3]), w0, true);
                    int w1 = __builtin_amdgcn_cvt_pk_fp8_f32(silu_mul(g1[0], u1[0]), silu_mul(g1[1], u1[1]), 0, false); w1 = __builtin_amdgcn_cvt_pk_fp8_f32(silu_mul(g1[2], u1[2]), silu_mul(g1[3], u1[3]), w1, true);
                    *(u32x2*)((unsigned char*)O + (size_t)(row0 + ai * HALF + m * 16) * ldc + col0) = (u32x2){(unsigned)w0, (unsigned)w1};
                } else {
                u32x4 w;
                w.x = cvt_pk_bf16(silu_mul(g0[0], u0[0]), silu_mul(g0[1], u0[1])); w.y = cvt_pk_bf16(silu_mul(g0[2], u0[2]), silu_mul(g0[3], u0[3]));
                w.z = cvt_pk_bf16(silu_mul(g1[0], u1[0]), silu_mul(g1[1], u1[1])); w.w = cvt_pk_bf16(silu_mul(g1[2], u1[2]), silu_mul(g1[3], u1[3]));
                *(u32x4*)(O + (size_t)(row0 + ai * HALF + m * 16) * ldc + col0) = w; }
            }
    }
};
typedef int v8i_t __attribute__((ext_vector_type(8)));
typedef int v4i_t __attribute__((ext_vector_type(4)));
__device__ __forceinline__ v8i_t cat8(bf16x8 lo, bf16x8 hi) { const v4i_t a = __builtin_bit_cast(v4i_t, lo), b = __builtin_bit_cast(v4i_t, hi); return __builtin_shufflevector(a, b, 0, 1, 2, 3, 4, 5, 6, 7); }
template <class Epi, class Sched, bool ALIGN_EPI = false, bool SP2 = false, bool FP8 = false>
__device__ __forceinline__ void gemm_phase(PG8_LAS unsigned char* lds, const Gemm g, const Sched& S, const Epi& E) {
    const int tid = threadIdx.x, wid = __builtin_amdgcn_readfirstlane(tid >> 6), lane = tid & 63, wr = wid >> 2, wc = wid & 3, fr = lane & 15, fq = lane >> 4;
    const int K = g.K, nt = K / BK;
    unsigned voffA[2], voffB[2];
#pragma unroll
    for (int i = 0; i < 2; ++i) { int R, C; stage_rc(tid * 16 + i * 8192, R, C); const int Rb = Epi::PERM ? ((R & ~31) + perm32(R & 31)) : R;
        voffA[i] = (unsigned)(R * K + C) * 2u; voffB[i] = (unsigned)(Rb * K + C) * 2u; }
    const size_t kstep = (size_t)(BK * 2);
    const size_t hstep = (size_t)HALF * K * 2;
    const size_t tstep = 2 * hstep;
    const unsigned ldsw = (unsigned)wid * 1024u;
    const int aoff = lds_byte(wr * 64 + fr, fq * 8), boff = lds_byte(wc * 32 + fr, fq * 8);
#define PG8_SA(b, h) (((b) * 2 + (h)) * HTB)
#define PG8_SB(b, h) ((4 + (b) * 2 + (h)) * HTB)
#define PG8_STAGE(bufoff, gbase, voff) do { _Pragma("unroll") for (int _i = 0; _i < 2; ++_i) \
        __builtin_amdgcn_global_load_lds((const unsigned*)((const char*)(gbase) + (voff)[_i]), (PG8_LAS unsigned*)(lds + (bufoff) + ldsw + _i * 8192), 16, 0, 0); } while (0)
#define PG8_LDA(dst, b, h) do { if constexpr (FP8) { _Pragma("unroll") for (int m = 0; m < 4; ++m) dst##8[m] = cat8(*(const PG8_LAS bf16x8*)(lds + PG8_SA(b, h) + aoff + m * 2048), *(const PG8_LAS bf16x8*)(lds + PG8_SA(b, h) + aoff + m * 2048 + 1024)); } else { \
        _Pragma("unroll") for (int m = 0; m < 4; ++m) _Pragma("unroll") for (int k = 0; k < 2; ++k) dst[m][k] = *(const PG8_LAS bf16x8*)(lds + PG8_SA(b, h) + aoff + m * 2048 + k * 1024); } } while (0)
#define PG8_LDB(dst, b, h) do { if constexpr (FP8) { _Pragma("unroll") for (int n = 0; n < 2; ++n) dst##8[n] = cat8(*(const PG8_LAS bf16x8*)(lds + PG8_SB(b, h) + boff + n * 2048), *(const PG8_LAS bf16x8*)(lds + PG8_SB(b, h) + boff + n * 2048 + 1024)); } else { \
        _Pragma("unroll") for (int n = 0; n < 2; ++n) _Pragma("unroll") for (int k = 0; k < 2; ++k) dst[n][k] = *(const PG8_LAS bf16x8*)(lds + PG8_SB(b, h) + boff + n * 2048 + k * 1024); } } while (0)
#define PG8_MMA(ai, bj, At, Bt) do { __builtin_amdgcn_s_setprio(1); if constexpr (FP8) { _Pragma("unroll") for (int m = 0; m < 4; ++m) _Pragma("unroll") for (int n = 0; n < 2; ++n) \
        asm volatile("v_mfma_scale_f32_16x16x128_f8f6f4 %0, %1, %2, %0, %3, %3 op_sel_hi:[0,0,0]" : "+v"(acc[ai][bj][m][n]) : "v"(Bt##8[n]), "v"(At##8[m]), "v"(fp8_unit_scale)); } else { \
        _Pragma("unroll") for (int m = 0; m < 4; ++m) _Pragma("unroll") for (int n = 0; n < 2; ++n) _Pragma("unroll") for (int k = 0; k < 2; ++k) \
        acc[ai][bj][m][n] = __builtin_amdgcn_mfma_f32_16x16x32_bf16(Bt[n][k], At[m][k], acc[ai][bj][m][n], 0, 0, 0); } __builtin_amdgcn_s_setprio(0); } while (0)
#define PG8_WAIT_V(n) asm volatile("s_waitcnt vmcnt(" #n ")" ::: "memory")
#define PG8_WAIT_L(n) asm volatile("s_waitcnt lgkmcnt(" #n ")" ::: "memory")
#define PG8_BAR __builtin_amdgcn_s_barrier()
#define PG8_SCHED __builtin_amdgcn_sched_barrier(0)
    Unit cur, nxt; int ui = 0;
    if (!S.next(0, cur)) return;
    f32x4 acc[2][2][4][2];
#pragma unroll
    for (int a = 0; a < 2; ++a)
#pragma unroll
        for (int b = 0; b < 2; ++b)
#pragma unroll
            for (int m = 0; m < 4; ++m)
#pragma unroll
                for (int n = 0; n < 2; ++n) acc[a][b][m][n] = (f32x4){0.f, 0.f, 0.f, 0.f};
    const int fp8_unit_scale = 0x7F7F7F7F;
    bf16x8 At[4][2], B0[2][2], B1[2][2]; v8i_t At8[4], B08[2], B18[2];
    const char* cA = (const char*)g.A + (size_t)cur.pm * tstep; const char* cB = (const char*)g.Bt + (size_t)cur.pn * tstep;
    S.a_ready(cur);
    if constexpr (SP2) {
        PG8_STAGE(PG8_SB(0, 0), cB, voffB); PG8_STAGE(PG8_SB(0, 1), cB + hstep, voffB); PG8_STAGE(PG8_SA(0, 0), cA, voffA); PG8_STAGE(PG8_SA(0, 1), cA + hstep, voffA);
        if (wr == 1) PG8_BAR;
        PG8_WAIT_V(2); PG8_BAR;
        PG8_STAGE(PG8_SB(1, 0), cB + kstep, voffB); PG8_STAGE(PG8_SA(1, 0), cA + kstep, voffA); PG8_STAGE(PG8_SB(1, 1), cB + hstep + kstep, voffB);
        PG8_WAIT_V(6); PG8_BAR;
    } else {
        PG8_STAGE(PG8_SB(0, 0), cB, voffB); PG8_STAGE(PG8_SA(0, 0), cA, voffA); PG8_STAGE(PG8_SB(0, 1), cB + hstep, voffB); PG8_STAGE(PG8_SA(0, 1), cA + hstep, voffA);
        if (wr == 1) PG8_BAR;
        PG8_WAIT_V(4); PG8_BAR;
        PG8_STAGE(PG8_SB(1, 0), cB + kstep, voffB); PG8_STAGE(PG8_SA(1, 0), cA + kstep, voffA); PG8_STAGE(PG8_SB(1, 1), cB + hstep + kstep, voffB);
        PG8_WAIT_V(6); PG8_BAR;
    }
    for (;;) {
        const bool has_next = S.next(ui + 1, nxt);
        const char* nA = has_next ? (const char*)g.A + (size_t)nxt.pm * tstep : cA; const char* nB = has_next ? (const char*)g.Bt + (size_t)nxt.pn * tstep : cB;
        for (int t = 0; t < nt; t += 2) {
            const bool last = (t == nt - 2);
            const char* a1 = cA + (size_t)(t + 1) * kstep;
            const char* a2 = last ? nA : cA + (size_t)(t + 2) * kstep; const char* b2 = last ? nB : cB + (size_t)(t + 2) * kstep;
            const char* a3 = a2 + kstep; const char* b3 = b2 + kstep;
            if (last && has_next) S.a_ready(nxt);
            if constexpr (SP2) {
            PG8_LDB(B0, 0, 0); PG8_LDB(B1, 0, 1); PG8_SCHED; PG8_LDA(At, 0, 0); PG8_STAGE(PG8_SA(1, 1), a1 + hstep, voffA);
            PG8_WAIT_V(8); PG8_WAIT_L(0); PG8_BAR; PG8_MMA(0, 0, At, B0); PG8_MMA(0, 1, At, B1); PG8_BAR; PG8_SCHED;
            PG8_LDA(At, 0, 1); PG8_STAGE(PG8_SB(0, 0), b2, voffB); PG8_STAGE(PG8_SB(0, 1), b2 + hstep, voffB); PG8_STAGE(PG8_SA(0, 0), a2, voffA);
            PG8_WAIT_V(8); PG8_WAIT_L(0); PG8_BAR; PG8_MMA(1, 0, At, B0); PG8_MMA(1, 1, At, B1); PG8_BAR; PG8_SCHED;
            PG8_LDB(B0, 1, 0); PG8_LDB(B1, 1, 1); PG8_SCHED; PG8_LDA(At, 1, 0); PG8_STAGE(PG8_SA(0, 1), a2 + hstep, voffA);
            PG8_WAIT_V(8); PG8_WAIT_L(0); PG8_BAR; PG8_MMA(0, 0, At, B0); PG8_MMA(0, 1, At, B1); PG8_BAR; PG8_SCHED;
            PG8_LDA(At, 1, 1); PG8_STAGE(PG8_SB(1, 0), b3, voffB); PG8_STAGE(PG8_SB(1, 1), b3 + hstep, voffB); PG8_STAGE(PG8_SA(1, 0), a3, voffA);
            PG8_WAIT_V(8); PG8_WAIT_L(0); PG8_BAR; PG8_MMA(1, 0, At, B0); PG8_MMA(1, 1, At, B1); PG8_BAR; PG8_SCHED;
            } else {
            PG8_LDB(B0, 0, 0); PG8_SCHED; PG8_LDA(At, 0, 0); PG8_STAGE(PG8_SA(1, 1), a1 + hstep, voffA);
            PG8_WAIT_L(8); PG8_BAR; PG8_WAIT_L(0); PG8_MMA(0, 0, At, B0); PG8_BAR; PG8_SCHED;
            PG8_LDB(B1, 0, 1); PG8_STAGE(PG8_SB(0, 0), b2, voffB);
            PG8_BAR; PG8_WAIT_L(0); PG8_MMA(0, 1, At, B1); PG8_BAR;
            PG8_LDA(At, 0, 1); PG8_STAGE(PG8_SA(0, 0), a2, voffA);
            PG8_BAR; PG8_WAIT_L(0); PG8_MMA(1, 0, At, B0); PG8_BAR; PG8_SCHED;
            PG8_STAGE(PG8_SB(0, 1), b2 + hstep, voffB);
            PG8_WAIT_V(6); PG8_BAR; PG8_MMA(1, 1, At, B1); PG8_BAR;
            PG8_LDB(B0, 1, 0); PG8_SCHED; PG8_LDA(At, 1, 0); PG8_STAGE(PG8_SA(0, 1), a2 + hstep, voffA);
            PG8_WAIT_L(8); PG8_BAR; PG8_WAIT_L(0); PG8_MMA(0, 0, At, B0); PG8_BAR; PG8_SCHED;
            PG8_LDB(B1, 1, 1); PG8_STAGE(PG8_SB(1, 0), b3, voffB);
            PG8_BAR; PG8_WAIT_L(0); PG8_MMA(0, 1, At, B1); PG8_BAR;
            PG8_LDA(At, 1, 1); PG8_STAGE(PG8_SA(1, 0), a3, voffA);
            PG8_BAR; PG8_WAIT_L(0); PG8_MMA(1, 0, At, B0); PG8_BAR; PG8_SCHED;
            PG8_STAGE(PG8_SB(1, 1), b3 + hstep, voffB);
            PG8_WAIT_V(6); PG8_BAR; PG8_MMA(1, 1, At, B1); PG8_BAR;
            }
        }
        if constexpr (ALIGN_EPI) { if (wr == 0) PG8_BAR; }
        if constexpr (FP8) asm volatile("s_nop 15\n\ts_nop 15\n\ts_nop 15" ::: "memory");
        if constexpr (!Epi::AFTER_DRAIN) { E(acc, cur, wr, wc, fr, fq); S.done(cur); }
        if (!has_next) break;
#pragma unroll
        for (int a = 0; a < 2; ++a)
#pragma unroll
            for (int b = 0; b < 2; ++b)
#pragma unroll
                for (int m = 0; m < 4; ++m)
#pragma unroll
                    for (int n = 0; n < 2; ++n) acc[a][b][m][n] = (f32x4){0.f, 0.f, 0.f, 0.f};
        if constexpr (FP8) asm volatile("s_nop 7" ::: "memory");
        cur = nxt; cA = nA; cB = nB; ++ui;
        if constexpr (ALIGN_EPI) { if (wr == 1) PG8_BAR; }
    }
    PG8_WAIT_V(0);
    if constexpr (!ALIGN_EPI) { if (wr == 0) PG8_BAR; }
    PG8_BAR;
    if constexpr (Epi::AFTER_DRAIN) { E.fused(acc, cur, wr, wc, fr, fq, lds, wid, lane); S.done(cur); }
#undef PG8_SA
#undef PG8_SB
#undef PG8_STAGE
#undef PG8_LDA
#undef PG8_LDB
#undef PG8_MMA
#undef PG8_WAIT_V
#undef PG8_WAIT_L
#undef PG8_BAR
#undef PG8_SCHED
}
}
constexpr int D_MODEL = 4096, BATCH = 4, SEQ = 4096, T = BATCH * SEQ;
constexpr int HA = 16, HB = 16, GB = 4, RB = 4;
constexpr int D_IN = 11312, LDP = 11520, D_FF = 11008, NGU = 2 * D_FF;
constexpr int OFF_QA = 0, OFF_KA = 2048, OFF_VA = 4096, OFF_QB = 6144, OFF_KC = 8192, OFF_VC = 8704,
              OFF_KS = 9216, OFF_VS = 9728, OFF_KW = 10240, OFF_VW = 10752, OFF_GL = 11264;
constexpr int NC = 255, NS = 64, CMP_LEN = 32, CMP_STRIDE = 16, NSEL = 16, WIN = 512;
constexpr float EPS = 1e-5f;
constexpr float QSCALE = 0.08838834764831845f;
constexpr int NWAVES = 8;
#ifndef PG8_FP8_SCALE
#define PG8_FP8_SCALE 0x7F7F7F7F
#endif
#ifndef P8_SP2
#define P8_SP2 true
#endif
constexpr float WGU_SCALE = 64.f;
constexpr float WDN_SCALE = 64.f;

constexpr size_t MiB = 1u << 20;
constexpr size_t WS_CTL = 0, CTL_ZERO_BYTES = 1 * MiB;
constexpr size_t WS_WIN = 1 * MiB;
constexpr size_t WS_WOUT = 91 * MiB;
constexpr size_t WS_WGU = 123 * MiB;
constexpr size_t WS_WDN = 295 * MiB;
constexpr size_t WS_BUFA = 381 * MiB;
constexpr size_t WS_PROJ = 509 * MiB;
constexpr size_t WS_SMALL = 869 * MiB;
constexpr size_t WS_CS = WS_SMALL;
constexpr size_t WS_KCF = WS_SMALL + 1 * MiB;
constexpr size_t WS_KCB = WS_SMALL + 5 * MiB;
constexpr size_t WS_W1T = WS_SMALL + 7 * MiB;
constexpr size_t WS_BIAS1 = WS_SMALL + 9 * MiB;
constexpr size_t WS_LSE = WS_SMALL + 10 * MiB;
constexpr size_t WS_GATES = WS_SMALL + 13 * MiB;
constexpr size_t WS_ROWSQ = WS_SMALL + 16 * MiB;
constexpr size_t WS_PART = 888 * MiB;
constexpr size_t WS_END = 1016 * MiB;
static_assert(WS_WIN + (size_t)LDP * 4096 * 2 <= WS_WOUT && WS_WOUT + (size_t)4096 * 4096 * 2 <= WS_WGU && WS_WGU + (size_t)NGU * 4096 * 2 <= WS_WDN &&
              WS_WDN + (size_t)4096 * D_FF * 2 <= WS_BUFA && WS_BUFA + (size_t)T * 4096 * 2 <= WS_PROJ && WS_PROJ + (size_t)T * LDP * 2 <= WS_SMALL, "d_ws map");
constexpr int CW_TMO = 0, CW_CODE = 1;
constexpr int CW_BAR = 4096;

constexpr int RING_OFF = 0, RING_BYTES = 131072;
constexpr int LDSCTL_OFF = RING_BYTES, MISC_OFF = LDSCTL_OFF + 320;
constexpr int LDS_BYTES = 155648;

#define GAS __attribute__((address_space(1)))
#define LAS __attribute__((address_space(3)))
typedef unsigned short bf16;
typedef unsigned v4u __attribute__((ext_vector_type(4)));
typedef unsigned v2u __attribute__((ext_vector_type(2)));
typedef float f32x4 __attribute__((ext_vector_type(4)));
typedef short bf16x8 __attribute__((ext_vector_type(8)));
typedef GAS unsigned gu32;
#define RLX_AGENT __ATOMIC_RELAXED, __HIP_MEMORY_SCOPE_AGENT
#define LDS_WAIT() asm volatile("s_waitcnt lgkmcnt(0)" ::: "memory")
#define VM_WAIT() asm volatile("s_waitcnt vmcnt(0)" ::: "memory")
__device__ __forceinline__ unsigned f2bf(float f) { unsigned u = __builtin_bit_cast(unsigned, f); return (u + 0x7fffu + ((u >> 16) & 1u)) >> 16; }
__device__ __forceinline__ unsigned pk2(float lo, float hi) { return f2bf(lo) | (f2bf(hi) << 16); }
__device__ __forceinline__ float bf2f(bf16 v) { return __builtin_bit_cast(float, (unsigned)v << 16); }
#define XB_TMO      128
#define XB_XCNT(j)  (256  + 64 * (j))
#define XB_XSUB(j)  (1280 + 64 * (j))
#define XB_XGEN(j)  (2304 + 64 * (j))
#define XB_TOP      3328
#define XB_TOPGEN   3392
#define XCD_BAR_WORDS 3456
#define XB_SPIN_CAP (1u << 18)

__device__ __forceinline__ unsigned xb_ld(unsigned* p)              { return __hip_atomic_load(p, __ATOMIC_RELAXED, __HIP_MEMORY_SCOPE_AGENT); }
__device__ __forceinline__ unsigned xb_add(unsigned* p, unsigned v) { return __hip_atomic_fetch_add(p, v, __ATOMIC_RELAXED, __HIP_MEMORY_SCOPE_AGENT); }
__device__ __forceinline__ unsigned xb_xcc_id() { return (unsigned)__builtin_amdgcn_s_getreg((3 << 11) | 20) & 0xFu; }
#define XB_SPIN(cond, bar) do { unsigned _sp = 0; while (cond) { __builtin_amdgcn_s_sleep(1); \
    if ((++_sp & 255u) == 0u) { if (xb_ld(&(bar)[XB_TMO])) break; if (_sp > XB_SPIN_CAP) { atomicAdd(&(bar)[XB_TMO], 1u); break; } } } } while (0)

struct XcdBarrier {
    unsigned* bar; unsigned x;
    volatile LAS unsigned* st;
};

__device__ __forceinline__ XcdBarrier xcd_barrier_post(unsigned* bar, volatile LAS unsigned* st) {
    XcdBarrier b; b.bar = bar; b.x = xb_xcc_id(); b.st = st;
    if (threadIdx.x == 0) (void)xb_add(&bar[XB_XCNT(b.x)], 1u);
    return b;
}
__device__ __forceinline__ void xcd_barrier_complete(unsigned* bar, unsigned x, unsigned& nloc, unsigned& nx) {
    const unsigned G = gridDim.x * gridDim.y * gridDim.z;
    unsigned sum, cnt, mine, sp = 0u;
    for (;;) {
        sum = 0u; cnt = 0u; mine = 0u;
#pragma unroll
        for (unsigned j = 0; j < 16; ++j) { const unsigned c = xb_ld(&bar[XB_XCNT(j)]); sum += c; cnt += (c > 0u) ? 1u : 0u; mine = (j == x) ? c : mine; }
        if (sum == G) break;
        __builtin_amdgcn_s_sleep(1);
        if ((++sp & 255u) == 0u) { if (xb_ld(&bar[XB_TMO])) break; if (sp > XB_SPIN_CAP) { atomicAdd(&bar[XB_TMO], 1u); break; } }
    }
    nloc = mine > 0u ? mine : 1u; nx = cnt > 0u ? cnt : 1u;
}

__device__ __forceinline__ void xcd_barrier(const XcdBarrier& b) {
    asm volatile("s_waitcnt vmcnt(0)" ::: "memory");
    __syncthreads();
    if (threadIdx.x == 0) {
        unsigned* bar = b.bar;
        __builtin_amdgcn_s_waitcnt(0);
        unsigned nloc = b.st[0], nx = b.st[1];
        if (nloc == 0u) { xcd_barrier_complete(bar, b.x, nloc, nx); b.st[0] = nloc; b.st[1] = nx; }
        const unsigned old = xb_add(&bar[XB_XSUB(b.x)], 1u);
        const unsigned gen = old / nloc;
        if (old + 1u == (gen + 1u) * nloc) {
            __builtin_amdgcn_fence(__ATOMIC_RELEASE, "agent");
            asm volatile("s_waitcnt vmcnt(0)" ::: "memory");
            const unsigned og = xb_add(&bar[XB_TOP], 1u);
            const unsigned tg = og / nx;
            if (og + 1u == (tg + 1u) * nx) xb_add(&bar[XB_TOPGEN], 1u);
            else XB_SPIN(xb_ld(&bar[XB_TOPGEN]) == tg, bar);
            __builtin_amdgcn_fence(__ATOMIC_ACQUIRE, "agent");
            xb_add(&bar[XB_XGEN(b.x)], 1u);
            asm volatile("s_waitcnt vmcnt(0)" ::: "memory");
        } else {
            XB_SPIN(xb_ld(&bar[XB_XGEN(b.x)]) == gen, bar);
            __builtin_amdgcn_fence(__ATOMIC_ACQUIRE, "agent");
            asm volatile("s_waitcnt vmcnt(0)" ::: "memory");
        }
    }
    __syncthreads();
}
namespace att {
#ifdef MK_TPROBE
#define SECARG , sec_acc
#define SECPARM , unsigned long long& sec_acc
#define SEC_BEGIN(kind) unsigned long long sec_t; asm volatile("s_memrealtime %0\n\ts_waitcnt lgkmcnt(0)" : "=s"(sec_t) :: "memory"); int sec_n = 0; const bool sec_on = (kind) == MK_TUNIT
#define SSEC(k) do { unsigned long long t_; asm volatile("s_memrealtime %0\n\ts_waitcnt lgkmcnt(0)" : "=s"(t_) :: "memory"); if (ssec_on && MK_TSEC == (k) && wave == MK_TWAVE) *ssec_acc += t_ - ssec_t; ssec_t = t_; } while (0)
#define SSEC_PARM , unsigned long long* ssec_acc = nullptr, bool ssec_on = false
#define SSEC_ARG , &sec_acc, sec_on
#define SSEC_INIT unsigned long long ssec_t; asm volatile("s_memrealtime %0\n\ts_waitcnt lgkmcnt(0)" : "=s"(ssec_t) :: "memory")
#define SEC() do { unsigned long long t_; asm volatile("s_memrealtime %0\n\ts_waitcnt lgkmcnt(0)" : "=s"(t_) :: "memory"); if (sec_on && sec_n == MK_TSEC) sec_acc += t_ - sec_t; sec_t = t_; ++sec_n; } while (0)
#else
#define SECARG
#define SECPARM
#define SEC_BEGIN(kind) do { } while (0)
#define SEC() do { } while (0)
#define SSEC(k) do { } while (0)
#define SSEC_PARM
#define SSEC_ARG
#define SSEC_INIT do { } while (0)
#endif
typedef float f32x16 __attribute__((ext_vector_type(16)));
typedef short s16x4 __attribute__((ext_vector_type(4)));
constexpr int SHM_T = 16384;
constexpr int A_V = 0, A_K = 4 * SHM_T;
constexpr int A_KC = 0, A_VC = 4 * SHM_T;
constexpr int A_WS = 131072 + 1024;
constexpr int A_IMP = A_WS + 2048;
constexpr int A_SEL = A_IMP + 16384;
constexpr int A_END = A_SEL + 512;
constexpr float C2 = QSCALE * 1.4426950408889634f;
constexpr float THR_RAW = 8.f / QSCALE;
#define KSWZ(row, colB) ((row) * 256 + ((colB) ^ (((row) & 7) << 4)))
__device__ __forceinline__ int crow(int r, int hi) { return (r & 3) + 8 * (r >> 2) + 4 * hi; }
__device__ __forceinline__ unsigned cvtpk(float lo, float hi) { unsigned r; asm volatile("v_cvt_pk_bf16_f32 %0, %1, %2" : "=v"(r) : "v"(lo), "v"(hi)); return r; }
__device__ __forceinline__ int v_st(int k, int c) { const int kk = (k & ~0xC) | ((k & 4) << 1) | ((k & 8) >> 1); return ((kk >> 3) * 4 + (c >> 5)) * 512 + ((kk & 7) * 32 + (c & 31)) * 2; }
__device__ __forceinline__ int v_rd_base(int lane) { return ((lane & 3) << 3) | (((lane >> 2) & 3) << 6) | (((lane >> 4) & 1) << 5) | (((lane >> 5) & 1) << 8); }
constexpr int v_rd_off(int d0, int ks, int half) { return d0 * 512 + ks * 4096 + half * 2048; }
template <int OFF> __device__ __forceinline__ s16x4 tr_read(int vb) {
    s16x4 r; asm volatile("ds_read_b64_tr_b16 %0, %1 offset:%2" : "=&v"(r) : "v"(vb), "i"(OFF) : "memory"); return r;
}
struct VFrag { s16x4 l0, h0, l1, h1, l2, h2, l3, h3; };
template <int D0> __device__ __forceinline__ void v_reads(VFrag& f, int vb) {
    f.l0 = tr_read<v_rd_off(D0, 0, 0)>(vb); f.h0 = tr_read<v_rd_off(D0, 0, 1)>(vb); f.l1 = tr_read<v_rd_off(D0, 1, 0)>(vb); f.h1 = tr_read<v_rd_off(D0, 1, 1)>(vb);
    f.l2 = tr_read<v_rd_off(D0, 2, 0)>(vb); f.h2 = tr_read<v_rd_off(D0, 2, 1)>(vb); f.l3 = tr_read<v_rd_off(D0, 3, 0)>(vb); f.h3 = tr_read<v_rd_off(D0, 3, 1)>(vb);
}
#define ATT_PK(Lx, Hx) (bf16x8){Lx[0], Lx[1], Lx[2], Lx[3], Hx[0], Hx[1], Hx[2], Hx[3]}
__device__ __forceinline__ void pv_mma(f32x16& od, const VFrag& f, bf16x8 pa0, bf16x8 pa1, bf16x8 pa2, bf16x8 pa3) {
    od = __builtin_amdgcn_mfma_f32_32x32x16_bf16(pa0, ATT_PK(f.l0, f.h0), od, 0, 0, 0);
    od = __builtin_amdgcn_mfma_f32_32x32x16_bf16(pa1, ATT_PK(f.l1, f.h1), od, 0, 0, 0);
    od = __builtin_amdgcn_mfma_f32_32x32x16_bf16(pa2, ATT_PK(f.l2, f.h2), od, 0, 0, 0);
    od = __builtin_amdgcn_mfma_f32_32x32x16_bf16(pa3, ATT_PK(f.l3, f.h3), od, 0, 0, 0);
}
__device__ __forceinline__ void pv_d0(f32x16 (&o)[4], int vb, bf16x8 pa0, bf16x8 pa1, bf16x8 pa2, bf16x8 pa3) {
    VFrag fa, fb;
    v_reads<0>(fa, vb); v_reads<1>(fb, vb);
    asm volatile("s_waitcnt lgkmcnt(8)" ::: "memory"); __builtin_amdgcn_sched_barrier(0);
    pv_mma(o[0], fa, pa0, pa1, pa2, pa3); __builtin_amdgcn_sched_barrier(0);
    v_reads<2>(fa, vb);
    asm volatile("s_waitcnt lgkmcnt(8)" ::: "memory"); __builtin_amdgcn_sched_barrier(0);
    pv_mma(o[1], fb, pa0, pa1, pa2, pa3); __builtin_amdgcn_sched_barrier(0);
    v_reads<3>(fb, vb);
    asm volatile("s_waitcnt lgkmcnt(8)" ::: "memory"); __builtin_amdgcn_sched_barrier(0);
    pv_mma(o[2], fa, pa0, pa1, pa2, pa3); __builtin_amdgcn_sched_barrier(0);
    asm volatile("s_waitcnt lgkmcnt(0)" ::: "memory"); __builtin_amdgcn_sched_barrier(0);
    pv_mma(o[3], fb, pa0, pa1, pa2, pa3);
}
#undef ATT_PK
__device__ __forceinline__ void pv_d0_lean(f32x16 (&o)[4], int vb, bf16x8 pa0, bf16x8 pa1, bf16x8 pa2, bf16x8 pa3) {
    VFrag f;
    v_reads<0>(f, vb); asm volatile("s_waitcnt lgkmcnt(0)" ::: "memory"); __builtin_amdgcn_sched_barrier(0); pv_mma(o[0], f, pa0, pa1, pa2, pa3); __builtin_amdgcn_sched_barrier(0);
    v_reads<1>(f, vb); asm volatile("s_waitcnt lgkmcnt(0)" ::: "memory"); __builtin_amdgcn_sched_barrier(0); pv_mma(o[1], f, pa0, pa1, pa2, pa3); __builtin_amdgcn_sched_barrier(0);
    v_reads<2>(f, vb); asm volatile("s_waitcnt lgkmcnt(0)" ::: "memory"); __builtin_amdgcn_sched_barrier(0); pv_mma(o[2], f, pa0, pa1, pa2, pa3); __builtin_amdgcn_sched_barrier(0);
    v_reads<3>(f, vb); asm volatile("s_waitcnt lgkmcnt(0)" ::: "memory"); __builtin_amdgcn_sched_barrier(0); pv_mma(o[3], f, pa0, pa1, pa2, pa3);
}
#define ATT_KRD(B, d0) do { const int cb_ = ((d0) * 16 + hi * 8) * 2; B##0 = *(const LAS bf16x8*)(Ks + KSWZ(r32, cb_)); B##1 = *(const LAS bf16x8*)(Ks + KSWZ(32 + r32, cb_)); } while (0)
#define ATT_KMM(B, d0) do { p0 = __builtin_amdgcn_mfma_f32_32x32x16_bf16(B##0, qr[d0], p0, 0, 0, 0); p1 = __builtin_amdgcn_mfma_f32_32x32x16_bf16(B##1, qr[d0], p1, 0, 0, 0); } while (0)
__device__ __forceinline__ void qkt(f32x16& p0, f32x16& p1, const LAS unsigned char* Ks, const bf16x8 (&qr)[8], int r32, int hi) {
    bf16x8 a0, a1, b0, b1, c0, c1, e0, e1;
    ATT_KRD(a, 0); ATT_KRD(b, 1); ATT_KRD(c, 2); ATT_KRD(e, 3);
#pragma unroll
    for (int r = 0; r < 16; ++r) { p0[r] = 0.f; p1[r] = 0.f; }
    __builtin_amdgcn_sched_barrier(0);
    ATT_KMM(a, 0); ATT_KMM(b, 1); __builtin_amdgcn_sched_barrier(0);
    ATT_KRD(a, 4); ATT_KRD(b, 5); __builtin_amdgcn_sched_barrier(0);
    ATT_KMM(c, 2); ATT_KMM(e, 3); __builtin_amdgcn_sched_barrier(0);
    ATT_KRD(c, 6); ATT_KRD(e, 7); __builtin_amdgcn_sched_barrier(0);
    ATT_KMM(a, 4); ATT_KMM(b, 5); __builtin_amdgcn_sched_barrier(0);
    ATT_KMM(c, 6); ATT_KMM(e, 7);
}
#undef ATT_KRD
#undef ATT_KMM
__device__ __forceinline__ float xhalf_max(float v) { auto rr = __builtin_amdgcn_permlane32_swap(__float_as_uint(v), __float_as_uint(v), false, false); return fmaxf(__uint_as_float(rr[0]), __uint_as_float(rr[1])); }
__device__ __forceinline__ float xhalf_sum(float v) { auto rr = __builtin_amdgcn_permlane32_swap(__float_as_uint(v), __float_as_uint(v), false, false); return __uint_as_float(rr[0]) + __uint_as_float(rr[1]); }
__device__ __forceinline__ bf16x8 pks(unsigned a0, unsigned a1, unsigned b0, unsigned b1) {
    auto r0 = __builtin_amdgcn_permlane32_swap(a0, b0, false, false); auto r1 = __builtin_amdgcn_permlane32_swap(a1, b1, false, false);
    v4u w = {r0[0], r1[0], r0[1], r1[1]}; return __builtin_bit_cast(bf16x8, w);
}
__device__ __forceinline__ void softmax_tile(f32x16& p0, f32x16& p1, float& m_reg, float& l_reg, float& alpha, bf16x8& pa0, bf16x8& pa1, bf16x8& pa2, bf16x8& pa3) {
    float pmax = fmaxf(p0[0], p1[0]);
#pragma unroll
    for (int r = 1; r < 16; ++r) pmax = fmaxf(fmaxf(pmax, p0[r]), p1[r]);
    pmax = xhalf_max(pmax);
    float mn;
    if (__all(pmax - m_reg <= THR_RAW)) { mn = m_reg; alpha = 1.f; }
    else { mn = fmaxf(m_reg, pmax); alpha = __builtin_amdgcn_exp2f((m_reg - mn) * C2); m_reg = mn; }
    const float mnC = -mn * C2;
    float ps = 0.f;
#pragma unroll
    for (int r = 0; r < 16; ++r) { p0[r] = __builtin_amdgcn_exp2f(fmaf(p0[r], C2, mnC)); p1[r] = __builtin_amdgcn_exp2f(fmaf(p1[r], C2, mnC)); ps += p0[r] + p1[r]; }
    ps = xhalf_sum(ps);
    l_reg = l_reg * alpha + ps;
    pa0 = pks(cvtpk(p0[0], p0[1]), cvtpk(p0[2], p0[3]), cvtpk(p0[4], p0[5]), cvtpk(p0[6], p0[7]));
    pa1 = pks(cvtpk(p0[8], p0[9]), cvtpk(p0[10], p0[11]), cvtpk(p0[12], p0[13]), cvtpk(p0[14], p0[15]));
    pa2 = pks(cvtpk(p1[0], p1[1]), cvtpk(p1[2], p1[3]), cvtpk(p1[4], p1[5]), cvtpk(p1[6], p1[7]));
    pa3 = pks(cvtpk(p1[8], p1[9]), cvtpk(p1[10], p1[11]), cvtpk(p1[12], p1[13]), cvtpk(p1[14], p1[15]));
}
struct MaskBand { int qi, W, amin, amax;
    __device__ __forceinline__ bool interior(int t) const { return (t * 64 + 63 <= amin) && (t * 64 >= amax - W); }
    __device__ __forceinline__ void operator()(f32x16& p0, f32x16& p1, int t, int hi) const {
        const int kb = t * 64 + 4 * hi;
#pragma unroll
        for (int r = 0; r < 16; ++r) { const int k = kb + (r & 3) + 8 * (r >> 2);
            p0[r] = ((unsigned)(qi - k) <= (unsigned)W) ? p0[r] : -INFINITY; p1[r] = ((unsigned)(qi - k - 32) <= (unsigned)W) ? p1[r] : -INFINITY; }
    } };
struct NeedBand { int a, W;
    __device__ __forceinline__ bool operator()(int t) const { return (t * 64 + 63 >= a - W) && (t * 64 <= a + 31); } };
struct NeedAll { __device__ __forceinline__ bool operator()(int) const { return true; } };
struct MaskSel { unsigned mlo, mhi; int s, qb;
    __device__ __forceinline__ bool interior(int) const { return false; }
    __device__ __forceinline__ void operator()(f32x16& p0, f32x16& p1, int t, int hi) const {
        const bool bit = ((t < 32 ? (mlo >> t) : (mhi >> (t - 32))) & 1u) != 0u;
        const int lim = (bit ? s : -1) - (t * 64 + 4 * hi);
#pragma unroll
        for (int r = 0; r < 16; ++r) { const int c = (r & 3) + 8 * (r >> 2);
            p0[r] = (c <= lim) ? p0[r] : -INFINITY; p1[r] = (c + 32 <= lim) ? p1[r] : -INFINITY; }
    } };
struct NeedSel { unsigned mlo, mhi;
    __device__ __forceinline__ bool operator()(int t) const { const bool bit = ((t < 32 ? (mlo >> t) : (mhi >> (t - 32))) & 1u) != 0u; return __any(bit) != 0; } };

struct NoPre { __device__ __forceinline__ void operator()() const {} };
template <class Mask, class Need, int PRE = 0, class Pre = NoPre>
__device__ __forceinline__ void attn_stream(LAS unsigned char* L, const bf16* Kg, const bf16* Vg, size_t stride, int t_lo, int t_hi, const bf16x8 (&qr)[8],
                                            const Mask& mask, const Need& need, f32x16 (&o)[4], float& m_reg, float& l_reg, int tid, int lane, int wave, const Pre& pre = Pre() SSEC_PARM) {
    SSEC_INIT;
    asm volatile("" : "+v"(tid), "+v"(lane));
    const bool late = wave >= 4;
    const bf16* kp; const bf16* vp;
    { const int krow = 4 * wave + (lane >> 4), kch = (lane & 15) ^ (krow & 7);
      const int vsub = 2 * wave + (lane >> 5), vkk = 8 * (vsub >> 2) + ((lane & 31) >> 2), vk = (vkk & ~0xC) | ((vkk & 4) << 1) | ((vkk & 8) >> 1);
      kp = Kg + ((size_t)t_lo * 64 + krow) * stride + kch * 8;
      vp = Vg + ((size_t)t_lo * 64 + vk) * stride + (vsub & 3) * 32 + (lane & 3) * 8; }
    const size_t s32 = 32 * stride, s64 = 64 * stride;
#define ATT_DMA(kslot, vslot) do { \
        __builtin_amdgcn_global_load_lds((const unsigned*)kp, (LAS unsigned*)(L + A_K + (kslot) * SHM_T + wave * 1024), 16, 0, 0); \
        __builtin_amdgcn_global_load_lds((const unsigned*)(kp + s32), (LAS unsigned*)(L + A_K + (kslot) * SHM_T + 8192 + wave * 1024), 16, 0, 0); \
        __builtin_amdgcn_global_load_lds((const unsigned*)vp, (LAS unsigned*)(L + A_V + (vslot) * SHM_T + wave * 1024), 16, 0, 0); \
        __builtin_amdgcn_global_load_lds((const unsigned*)(vp + s32), (LAS unsigned*)(L + A_V + (vslot) * SHM_T + 8192 + wave * 1024), 16, 0, 0); \
        kp += s64; vp += s64; } while (0)
#define ATT_RESC() do { if (__any(alpha < 1.f)) { if (hi == 0) al_l[r32] = alpha; asm volatile("s_waitcnt lgkmcnt(0)" ::: "memory"); \
        _Pragma("unroll") for (int d = 0; d < 4; ++d) _Pragma("unroll") for (int r = 0; r < 16; ++r) o[d][r] *= al_l[crow(r, hi)]; } } while (0)
    ATT_DMA(0, 0);
    if (t_lo + 1 < t_hi) ATT_DMA(1, 1);
    pre();
    asm volatile("" : "+v"(lane));
    const int r32 = lane & 31, hi = lane >> 5;
    LAS float* al_l = (LAS float*)(L + A_WS + wave * 256) + 32;
    const int vb0 = (int)(unsigned)(uintptr_t)(L + A_V) + v_rd_base(lane);
    int ks = 0, vs = 0, vsp = 0; bool pend = false;
    bf16x8 pa0, pa1, pa2, pa3;
    for (int t = t_lo; t < t_hi; ++t) {
        if (PRE > 0 && t - t_lo < 2 && t + 1 < t_hi) asm volatile("s_waitcnt vmcnt(%0)" :: "n"(4 + PRE) : "memory");
        else if (t + 1 < t_hi) asm volatile("s_waitcnt vmcnt(4)" ::: "memory"); else asm volatile("s_waitcnt vmcnt(0)" ::: "memory");
        __builtin_amdgcn_s_barrier();
        asm volatile("" ::: "memory");
        SSEC(10);
        if (t + 2 < t_hi) { const int k2 = ks >= 1 ? ks - 1 : 2, v2 = vs >= 2 ? vs - 2 : vs + 2; ATT_DMA(k2, v2); }
        SSEC(11);
        if (pend) { pv_d0(o, vb0 + vsp * SHM_T, pa0, pa1, pa2, pa3); pend = false; }
        SSEC(12);
        if (need(t)) {
            f32x16 p0, p1; qkt(p0, p1, L + A_K + ks * SHM_T, qr, r32, hi);
            SSEC(13);
            if (!mask.interior(t)) mask(p0, p1, t, hi);
            float alpha;
            softmax_tile(p0, p1, m_reg, l_reg, alpha, pa0, pa1, pa2, pa3);
            ATT_RESC();
            SSEC(14);
            if (late) { pend = true; vsp = vs; }
            else pv_d0(o, vb0 + vs * SHM_T, pa0, pa1, pa2, pa3);
        }
        SSEC(15);
        ks = ks == 2 ? 0 : ks + 1; vs = (vs + 1) & 3;
    }
    if (pend) pv_d0(o, vb0 + vsp * SHM_T, pa0, pa1, pa2, pa3);
#undef ATT_DMA
#undef ATT_RESC
    asm volatile("s_waitcnt lgkmcnt(0)" ::: "memory");
    __builtin_amdgcn_s_barrier();
}
__device__ __forceinline__ int st_img(int wave) { return wave < 4 ? 2 * SHM_T + wave * 8192 : A_K + 2 * SHM_T + (wave - 4) * 8192; }
constexpr int ST_VMOPS = 8;
template <class RowPtr>
__device__ __forceinline__ void store_tile(LAS unsigned char* L, const f32x16 (&o)[4], const LAS float* sc_l, const RowPtr& rowptr, int lane, int wave) {
    const int r32 = lane & 31, hi = lane >> 5, odd = lane & 1;
    LAS unsigned char* img = L + st_img(wave);
#pragma unroll
    for (int rp = 0; rp < 8; ++rp) {
        const int r = 2 * rp;
        const float s0 = sc_l[crow(r, hi)], s1 = sc_l[crow(r + 1, hi)];
        const int row = crow(r + odd, hi);
#pragma unroll
        for (int d0 = 0; d0 < 4; ++d0) {
            const float a = o[d0][r] * s0, b = o[d0][r + 1] * s1;
            const float send = odd ? a : b;
            const float recv = __shfl_xor(send, 1);
            const unsigned w = cvtpk(odd ? recv : a, odd ? b : recv);
            *(LAS unsigned*)(img + row * 256 + (((32 * d0 + (r32 & ~1)) * 2) ^ ((row & 7) << 4))) = w;
        }
    }
    asm volatile("s_waitcnt lgkmcnt(0)" ::: "memory");
#pragma unroll
    for (int i = 0; i < 8; ++i) {
        const int row = 4 * i + (lane >> 4), ch = lane & 15;
        const v4u v = *(const LAS v4u*)(img + row * 256 + ((ch * 16) ^ ((row & 7) << 4)));
        *(v4u*)(rowptr(row) + ch * 8) = v;
    }
}
constexpr int STD_VMOPS = 32;
template <class RowPtr>
__device__ __forceinline__ void store_tile_direct(const f32x16 (&o)[4], const LAS float* sc_l, const RowPtr& rowptr, int lane) {
    const int r32 = lane & 31, hi = lane >> 5, odd = lane & 1;
#pragma unroll
    for (int rp = 0; rp < 8; ++rp) {
        const int r = 2 * rp;
        const float s0 = sc_l[crow(r, hi)], s1 = sc_l[crow(r + 1, hi)];
        bf16* prow = rowptr(crow(r + odd, hi)) + (r32 & ~1);
#pragma unroll
        for (int d0 = 0; d0 < 4; ++d0) {
            const float a = o[d0][r] * s0, b = o[d0][r + 1] * s1;
            const float send = odd ? a : b;
            const float recv = __shfl_xor(send, 1);
            *(unsigned*)(prow + 32 * d0) = cvtpk(odd ? recv : a, odd ? b : recv);
        }
    }
}
__device__ __forceinline__ float sigmoidf_(float v) { return 1.f / (1.f + __expf(-v)); }

__device__ __forceinline__ void dilated_unit(LAS unsigned char* L, const bf16* proj, bf16* outA, float* lse, int u, int tid, int lane, int wave SECPARM) {
    SEC_BEGIN(0);
    const int r32 = lane & 31, hi = lane >> 5;
    const int cfg = u >> 10, r = u & 1023, sh = 2 * cfg, dil = 1 << sh;
    const int b = r >> 8, h = (r >> 4) & 15, rb = r & 15, res = rb & (dil - 1), blk = rb >> sh;
    const int i0 = blk * 256, a = i0 + 32 * wave, qi = a + r32;
    const bf16* base = proj + (size_t)(b * SEQ + res) * LDP + h * 128;
    const size_t stride = (size_t)dil * LDP;
    const bf16* qrow = base + OFF_QA + (size_t)qi * stride + hi * 8;
    bf16x8 qr[8];
#pragma unroll
    for (int d0 = 0; d0 < 8; ++d0) qr[d0] = *(const bf16x8*)(qrow + d0 * 16);
    f32x16 o[4];
#pragma unroll
    for (int d = 0; d < 4; ++d)
#pragma unroll
        for (int e = 0; e < 16; ++e) o[d][e] = 0.f;
    float m_reg = -1e30f, l_reg = 0.f;
    const int t_lo = (i0 >= 128) ? (i0 - 128) >> 6 : 0, t_hi = (i0 >> 6) + 4;
    SEC();
    attn_stream(L, base + OFF_KA, base + OFF_VA, stride, t_lo, t_hi, qr, MaskBand{qi, 128, a, a + 31}, NeedBand{a, 128}, o, m_reg, l_reg, tid, lane, wave, NoPre() SSEC_ARG);
    SEC();
    LAS float* sc_l = (LAS float*)(L + A_WS + wave * 256);
    const int tok = qi * dil + res;
    if (hi == 0) { sc_l[r32] = 1.f / l_reg; lse[((size_t)cfg * T + (size_t)b * SEQ + tok) * 16 + h] = m_reg * QSCALE + __logf(l_reg); }
    asm volatile("s_waitcnt lgkmcnt(0)" ::: "memory");
    bf16* obase = outA + (size_t)cfg * T * 2048 + (size_t)(b * SEQ + res) * 2048 + h * 128;
    const size_t ostride = (size_t)dil * 2048;
    store_tile(L, o, sc_l, [&](int row) { return obase + (size_t)(a + row) * ostride; }, lane, wave);
    SEC();
}
__device__ __forceinline__ void window_unit(LAS unsigned char* L, const bf16* proj, bf16* outB, int u, int tid, int lane, int wave SECPARM) {
    SEC_BEGIN(1);
    const int r32 = lane & 31, hi = lane >> 5;
    const int b = u >> 8, g = (u >> 6) & 3, qb = u & 63, q0 = qb * 64;
    const int head = r32 >> 3, s = q0 + 8 * wave + (r32 & 7);
    const bf16* prow = proj + (size_t)(b * SEQ + s) * LDP;
    const bf16* qrow = prow + OFF_QB + (g * 4 + head) * 128 + hi * 8;
    bf16x8 qr[8];
#pragma unroll
    for (int d0 = 0; d0 < 8; ++d0) qr[d0] = *(const bf16x8*)(qrow + d0 * 16);
    f32x16 o[4];
#pragma unroll
    for (int d = 0; d < 4; ++d)
#pragma unroll
        for (int e = 0; e < 16; ++e) o[d][e] = 0.f;
    float m_reg = -1e30f, l_reg = 0.f;
    const bf16* kvb = proj + (size_t)(b * SEQ) * LDP + g * 128;
    attn_stream(L, kvb + OFF_KW, kvb + OFF_VW, (size_t)LDP, qb >= 8 ? qb - 8 : 0, qb + 1, qr, MaskBand{s, WIN - 1, q0 + 8 * wave, q0 + 8 * wave + 7}, NeedAll{}, o, m_reg, l_reg, tid, lane, wave);
    LAS float* sc_l = (LAS float*)(L + A_WS + wave * 256);
    if (hi == 0) sc_l[r32] = 1.f / l_reg;
    asm volatile("s_waitcnt lgkmcnt(0)" ::: "memory");
    bf16* obase = outB + (size_t)(b * SEQ + q0 + 8 * wave) * 2048 + g * 512;
    store_tile(L, o, sc_l, [&](int row) { return obase + (size_t)(row & 7) * 2048 + (row >> 3) * 128; }, lane, wave);
}
__device__ __forceinline__ bf16x8 hfrag(int c0, int j) {
    bf16x8 f; const int d = c0 - 4 * j;
#pragma unroll
    for (int jj = 0; jj < 8; ++jj) f[jj] = ((unsigned)(d + jj + 1) <= 4u) ? (short)0x3F80 : (short)0;
    return f;
}
__device__ __forceinline__ void nsa_unit(LAS unsigned char* L, const bf16* proj, const bf16* kc, const bf16* vc, bf16* outC, bf16* outS, int b, int g, int qb, int tid, int lane, int wave SECPARM) {
    SEC_BEGIN(2);
    asm volatile("" : "+v"(tid), "+v"(lane));
    const int r32 = lane & 31, hi = lane >> 5;
    const int q0 = qb * 64, head = r32 >> 3, s = q0 + 8 * wave + (r32 & 7);
    const bf16* prow = proj + (size_t)(b * SEQ + s) * LDP;
    const bf16* qrow = prow + OFF_QB + (g * 4 + head) * 128 + hi * 8;
    bf16x8 qr[8];
#pragma unroll
    for (int d0 = 0; d0 < 8; ++d0) qr[d0] = *(const bf16x8*)(qrow + d0 * 16);
    {
        int tid_ = tid; asm volatile("" : "+v"(tid_));
        const int sr = tid_ >> 4, sc = (tid_ & 15) * 8;
        const bf16* kcb = kc + (size_t)(b * GB + g) * 256 * 128 + (size_t)sr * 128 + sc; const bf16* vcb = vc + (size_t)(b * GB + g) * 256 * 128 + (size_t)sr * 128 + sc;
#pragma unroll
        for (int tc = 0; tc < 4; ++tc) {
            const bf16x8 k0 = *(const bf16x8*)(kcb + tc * 8192), k1 = *(const bf16x8*)(kcb + tc * 8192 + 4096), v0 = *(const bf16x8*)(vcb + tc * 8192), v1 = *(const bf16x8*)(vcb + tc * 8192 + 4096);
            *(LAS bf16x8*)(L + A_KC + tc * SHM_T + KSWZ(sr, sc * 2)) = k0; *(LAS bf16x8*)(L + A_KC + tc * SHM_T + KSWZ(32 + sr, sc * 2)) = k1;
            *(LAS bf16x8*)(L + A_VC + tc * SHM_T + v_st(sr, sc)) = v0; *(LAS bf16x8*)(L + A_VC + tc * SHM_T + v_st(32 + sr, sc)) = v1;
        }
    }
    __syncthreads();
    LAS float* impw = (LAS float*)(L + A_IMP) + wave * 512;
    LAS float* sc_l = (LAS float*)(L + A_WS + wave * 256);
    f32x16 o[4];
#pragma unroll
    for (int e = 0; e < 16; ++e) { o[0][e] = 0.f; o[1][e] = 0.f; o[2][e] = 0.f; o[3][e] = 0.f; }
    float m = -1e30f, l = 0.f;
    {
        const int vbc = (int)(unsigned)(uintptr_t)(L + A_VC) + v_rd_base(lane);
        LAS float* al_c = (LAS float*)(L + A_WS + wave * 256) + 32;
#pragma unroll 1
        for (int tc = 0; tc < 4; ++tc) {
            f32x16 p0, p1; qkt(p0, p1, L + A_KC + tc * SHM_T, qr, r32, hi);
            const int lim = ((s - 31) >> 4) - (tc * 64 + 4 * hi);
#pragma unroll
            for (int r = 0; r < 16; ++r) { const int cc = (r & 3) + 8 * (r >> 2);
                p0[r] = (cc <= lim) ? p0[r] : -INFINITY; p1[r] = (cc + 32 <= lim) ? p1[r] : -INFINITY; }
            float alpha; bf16x8 pa0, pa1, pa2, pa3;
            softmax_tile(p0, p1, m, l, alpha, pa0, pa1, pa2, pa3);
            if (__any(alpha < 1.f)) { if (hi == 0) al_c[r32] = alpha; asm volatile("s_waitcnt lgkmcnt(0)" ::: "memory");
#pragma unroll
                for (int d = 0; d < 4; ++d)
#pragma unroll
                    for (int r = 0; r < 16; ++r) o[d][r] *= al_c[crow(r, hi)]; }
            pv_d0_lean(o, vbc + tc * SHM_T, pa0, pa1, pa2, pa3);
        }
    }
    const float inv_l = l > 0.f ? 1.f / l : 0.f, mC = -m * C2;
    SEC();
#ifndef T_NOPASS2
    {
        f32x16 imp0, imp1;
#pragma unroll
        for (int e = 0; e < 16; ++e) { imp0[e] = 0.f; imp1[e] = 0.f; }
#pragma unroll 1
        for (int tc = 0; tc < 4; ++tc) {
            f32x16 p0, p1; qkt(p0, p1, L + A_KC + tc * SHM_T, qr, r32, hi);
            const int kb = tc * 64 + 4 * hi;
#pragma unroll
            for (int r = 0; r < 16; ++r) { const int c = kb + (r & 3) + 8 * (r >> 2);
                p0[r] = (16 * c + 31 <= s) ? __builtin_amdgcn_exp2f(fmaf(p0[r], C2, mC)) * inv_l : 0.f;
                p1[r] = (16 * (c + 32) + 31 <= s) ? __builtin_amdgcn_exp2f(fmaf(p1[r], C2, mC)) * inv_l : 0.f; }
#pragma unroll
            for (int ks = 0; ks < 4; ++ks) {
                unsigned hh[4], ll[4];
#pragma unroll
                for (int i = 0; i < 4; ++i) { const int r = 8 * (ks & 1) + 2 * i; const float a = (ks < 2) ? p0[r] : p1[r], bq = (ks < 2) ? p0[r + 1] : p1[r + 1];
                    hh[i] = cvtpk(a, bq); ll[i] = cvtpk(a - __uint_as_float(hh[i] << 16), bq - __uint_as_float(hh[i] & 0xffff0000u)); }
                const bf16x8 pah = pks(hh[0], hh[1], hh[2], hh[3]), pal = pks(ll[0], ll[1], ll[2], ll[3]);
                int jv = r32; asm volatile("" : "+v"(jv));
                const int c0 = tc * 64 + ks * 16 + 8 * hi;
                if (tc <= 1) { const bf16x8 hf = hfrag(c0, jv); imp0 = __builtin_amdgcn_mfma_f32_32x32x16_bf16(pah, hf, imp0, 0, 0, 0); imp0 = __builtin_amdgcn_mfma_f32_32x32x16_bf16(pal, hf, imp0, 0, 0, 0); }
                if (tc >= 1) { const bf16x8 hf = hfrag(c0, 32 + jv); imp1 = __builtin_amdgcn_mfma_f32_32x32x16_bf16(pah, hf, imp1, 0, 0, 0); imp1 = __builtin_amdgcn_mfma_f32_32x32x16_bf16(pal, hf, imp1, 0, 0, 0); }
            }
        }
        LAS float* impw0 = (LAS float*)(L + A_IMP) + wave * 512;
#pragma unroll
        for (int e = 0; e < 4; ++e) {
            impw0[(e + 4 * hi) * 64 + r32] = (imp0[e] + imp0[4 + e]) + (imp0[8 + e] + imp0[12 + e]);
            impw0[(e + 4 * hi) * 64 + 32 + r32] = (imp1[e] + imp1[4 + e]) + (imp1[8 + e] + imp1[12 + e]);
        }
    }
#endif
    SEC();
    LAS unsigned* selw = (LAS unsigned*)(L + A_SEL) + wave * 16;
    {
        unsigned key[8], T[8];
#pragma unroll
        for (int qi = 0; qi < 8; ++qi) {
            const int sq = q0 + 8 * wave + qi, j = lane;
            const float iv = impw[qi * 64 + lane];
            const bool forced = (j == 0) || (j == qb) || (j == qb - 1);
            const bool valid = (j * 64 <= sq);
            const float score = forced ? 1e6f : (valid ? iv : -INFINITY);
            key[qi] = (score == -INFINITY) ? 0u : (__float_as_uint(fmaxf(score, 0.f)) + 1u); T[qi] = 0u;
        }
#pragma unroll
        for (int bb = 30; bb >= 0; --bb)
#pragma unroll
            for (int qi = 0; qi < 8; ++qi) { const unsigned cand = T[qi] | (1u << bb); if (__popcll(__ballot(key[qi] >= cand)) >= NSEL) T[qi] = cand; }
#pragma unroll
        for (int qi = 0; qi < 8; ++qi) {
            const unsigned long long gt = __ballot(key[qi] > T[qi]), eq = __ballot(key[qi] == T[qi]);
            const int need = NSEL - (int)__popcll(gt);
            const int below = (int)__builtin_amdgcn_mbcnt_hi((unsigned)(eq >> 32), __builtin_amdgcn_mbcnt_lo((unsigned)eq, 0u));
            const bool sel = (key[qi] > T[qi]) || (key[qi] == T[qi] && T[qi] != 0u && below < need);
            const unsigned long long mk = __ballot(sel);
            if (lane == 0) { selw[2 * qi] = (unsigned)mk; selw[2 * qi + 1] = (unsigned)(mk >> 32); }
        }
    }
    asm volatile("s_waitcnt lgkmcnt(0)" ::: "memory");
    const unsigned mlo = selw[2 * (r32 & 7)], mhi = selw[2 * (r32 & 7) + 1];
    SEC();
    SEC();
    asm volatile("s_waitcnt lgkmcnt(0)" ::: "memory");
    __builtin_amdgcn_s_barrier();
    asm volatile("" ::: "memory");
    float m_reg = -1e30f, l_reg = 0.f;
    const bf16* kvb = proj + (size_t)(b * SEQ) * LDP + g * 128;
    bf16* obaseC = outC + (size_t)(b * SEQ + q0 + 8 * wave) * 2048 + g * 512;
    auto pre = [&]() {
        if (hi == 0) sc_l[r32] = inv_l;
        asm volatile("s_waitcnt lgkmcnt(0)" ::: "memory");
        store_tile_direct(o, sc_l, [&](int row) { return obaseC + (size_t)(row & 7) * 2048 + (row >> 3) * 128; }, lane);
#pragma unroll
        for (int d = 0; d < 4; ++d)
#pragma unroll
            for (int e = 0; e < 16; ++e) o[d][e] = 0.f;
    };
    attn_stream<MaskSel, NeedAll, STD_VMOPS>(L, kvb + OFF_KS, kvb + OFF_VS, (size_t)LDP, 0, qb + 1, qr, MaskSel{mlo, mhi, s, qb}, NeedAll{}, o, m_reg, l_reg, tid, lane, wave, pre SSEC_ARG);
    SEC();
    if (hi == 0) sc_l[r32] = 1.f / l_reg;
    asm volatile("s_waitcnt lgkmcnt(0)" ::: "memory");
    {
        bf16* obase = outS + (size_t)(b * SEQ + q0 + 8 * wave) * 2048 + g * 512;
        store_tile_direct(o, sc_l, [&](int row) { return obase + (size_t)(row & 7) * 2048 + (row >> 3) * 128; }, lane);
    }
    SEC();
}
__device__ __forceinline__ void compress_unit(LAS unsigned char* L, const bf16* proj, int coloff, const bf16* W1T, const float* bias1, const float* w2, bf16* outkc,
                                              int b, int g, int cblk, int tid, int lane, int wave) {
    const int r32 = lane & 31, hi = lane >> 5, n = wave & 3, th = wave >> 2;
    const int tokbase = 16 * (32 * cblk + r32);
    f32x16 acc;
#pragma unroll
    for (int e = 0; e < 16; ++e) acc[e] = 0.f;
    const bf16* arow = proj + (size_t)(b * SEQ) * LDP + coloff + g * 128 + hi * 8;
    const bf16* brow = W1T + (size_t)(32 * n + r32) * 4096 + hi * 8;
#pragma unroll 2
    for (int t = 16 * th; t < 16 * th + 16; ++t) {
        int tok = tokbase + t; tok = tok < SEQ ? tok : SEQ - 1;
        const bf16* ap = arow + (size_t)tok * LDP; const bf16* bp = brow + t * 128;
#pragma unroll
        for (int ks = 0; ks < 8; ++ks) acc = __builtin_amdgcn_mfma_f32_32x32x16_bf16(*(const bf16x8*)(ap + 16 * ks), *(const bf16x8*)(bp + 16 * ks), acc, 0, 0, 0);
    }
    LAS float* part = (LAS float*)L + th * 4096;
#pragma unroll
    for (int r = 0; r < 16; ++r) part[crow(r, hi) * 128 + 32 * n + r32] = acc[r];
    __syncthreads();
    LAS float* hid = (LAS float*)L + 8192;
    for (int e = tid; e < 4096; e += NWAVES * 64) { const float v = ((LAS float*)L)[e] + ((LAS float*)L)[4096 + e] + bias1[e & 127];
        const float uu = 0.7978845608028654f * (v + 0.044715f * v * v * v); hid[e] = 0.5f * v * (1.f + tanhf(uu)); }
    __syncthreads();
    const int j2 = tid & 127, cg = tid >> 7;
    float oacc[8];
#pragma unroll
    for (int k = 0; k < 8; ++k) oacc[k] = 0.f;
#pragma unroll 16
    for (int j = 0; j < 128; ++j) { const float w = w2[j * 128 + j2];
#pragma unroll
        for (int k = 0; k < 8; ++k) oacc[k] += hid[(cg * 8 + k) * 128 + j] * w; }
#pragma unroll
    for (int k = 0; k < 8; ++k) { const int c = 32 * cblk + cg * 8 + k; outkc[((size_t)(b * GB + g) * 256 + c) * 128 + j2] = (c < NC) ? (bf16)f2bf(oacc[k]) : (bf16)0; }
    __syncthreads();
}
__device__ __forceinline__ void gate_unit(LAS unsigned char* L, const bf16* h, const bf16* Wg, const float* rowsq0, float* gates, int row0, int tid, int lane, int wave) {
    const int r32 = lane & 31, hi = lane >> 5, rt = wave & 1, kq = wave >> 1;
    f32x16 acc0, acc1;
#pragma unroll
    for (int e = 0; e < 16; ++e) { acc0[e] = 0.f; acc1[e] = 0.f; }
    const bf16* ap = h + (size_t)(row0 + 32 * rt + r32) * D_MODEL + kq * 1024 + hi * 8;
    const bf16* bp0 = Wg + (size_t)r32 * D_MODEL + kq * 1024 + hi * 8; const bf16* bp1 = bp0 + (size_t)32 * D_MODEL;
#pragma unroll 8
    for (int ks = 0; ks < 64; ++ks) {
        const bf16x8 a = *(const bf16x8*)(ap + 16 * ks), b0 = *(const bf16x8*)(bp0 + 16 * ks), b1 = *(const bf16x8*)(bp1 + 16 * ks);
        acc0 = __builtin_amdgcn_mfma_f32_32x32x16_bf16(a, b0, acc0, 0, 0, 0); acc1 = __builtin_amdgcn_mfma_f32_32x32x16_bf16(a, b1, acc1, 0, 0, 0);
    }
    LAS float* part = (LAS float*)L + wave * 2048;
#pragma unroll
    for (int r = 0; r < 16; ++r) { part[crow(r, hi) * 64 + r32] = acc0[r]; part[crow(r, hi) * 64 + 32 + r32] = acc1[r]; }
    __syncthreads();
    for (int e = tid; e < 64 * 48; e += NWAVES * 64) { const int row = e / 48, col = e % 48, rtt = row >> 5, rr = row & 31;
        const LAS float* p = (const LAS float*)L + rtt * 2048 + rr * 64 + col;
        const float v = (p[0] + p[2 * 2048]) + (p[4 * 2048] + p[6 * 2048]);
        gates[(size_t)(row0 + row) * 48 + col] = sigmoidf_(v / sqrtf(rowsq0[row0 + row] * (1.f / 4096.f) + EPS)); }
    __syncthreads();
}
}
__device__ __forceinline__ float wave_sum(float v) {
#pragma unroll
    for (int o = 1; o < 64; o <<= 1) v += __shfl_xor(v, o);
    return v;
}
__device__ __forceinline__ float wave_max(float v) {
#pragma unroll
    for (int o = 1; o < 64; o <<= 1) v = fmaxf(v, __shfl_xor(v, o));
    return v;
}
__device__ __forceinline__ void p0_transpose_item(const float* W, int N, int nvalid, bf16* WT, size_t ldt, int k0, int n0, int drow0, LAS float* scr, int lane, const float* kgain = nullptr, float fp8scale = 0.f) {
    const int rr = lane >> 3, c4 = lane & 7, nn = n0 + 4 * c4; const bool ok = nn < nvalid;
    const GAS f32x4* src = (const GAS f32x4*)(W + (size_t)(k0 + rr) * N + nn);
    f32x4 v[8];
#pragma unroll
    for (int i = 0; i < 8; ++i) v[i] = ok ? __builtin_nontemporal_load(src + (size_t)i * 2 * N) : (f32x4){0.f, 0.f, 0.f, 0.f};
#pragma unroll
    for (int i = 0; i < 8; ++i) { LAS float* d = scr + (8 * i + rr) * 33 + 4 * c4; const float gk = kgain ? kgain[k0 + 8 * i + rr] : 1.f; d[0] = v[i].x * gk; d[1] = v[i].y * gk; d[2] = v[i].z * gk; d[3] = v[i].w * gk; }
    LDS_WAIT(); asm volatile("" ::: "memory");
    const int c = lane & 7;
#pragma unroll
    for (int j = 0; j < 4; ++j) { const int n = (lane >> 3) + 8 * j; const LAS float* s = scr + (8 * c) * 33 + n;
        if (fp8scale != 0.f) {
            int w0 = __builtin_amdgcn_cvt_pk_fp8_f32(s[0 * 33] * fp8scale, s[1 * 33] * fp8scale, 0, false); w0 = __builtin_amdgcn_cvt_pk_fp8_f32(s[2 * 33] * fp8scale, s[3 * 33] * fp8scale, w0, true);
            int w1 = __builtin_amdgcn_cvt_pk_fp8_f32(s[4 * 33] * fp8scale, s[5 * 33] * fp8scale, 0, false); w1 = __builtin_amdgcn_cvt_pk_fp8_f32(s[6 * 33] * fp8scale, s[7 * 33] * fp8scale, w1, true);
            *(GAS v2u*)((GAS unsigned char*)WT + (size_t)(drow0 + n) * ldt + k0 + 8 * c) = (v2u){(unsigned)w0, (unsigned)w1};
        } else {
        v4u o; o.x = pk2(s[0 * 33], s[1 * 33]); o.y = pk2(s[2 * 33], s[3 * 33]); o.z = pk2(s[4 * 33], s[5 * 33]); o.w = pk2(s[6 * 33], s[7 * 33]);
        *(GAS v4u*)(WT + (size_t)(drow0 + n) * ldt + k0 + 8 * c) = o; } }
    LDS_WAIT(); asm volatile("" ::: "memory");
}
__device__ __forceinline__ void row_to_bf16_sumsq(const float* xrow, bf16* orow, float* sumsq, int lane) {
    const GAS f32x4* xr = (const GAS f32x4*)xrow + lane;
    f32x4 v[16]; float s = 0.f;
#pragma unroll
    for (int j = 0; j < 16; ++j) { v[j] = __builtin_nontemporal_load(xr + 64 * j); s += (v[j].x * v[j].x + v[j].y * v[j].y) + (v[j].z * v[j].z + v[j].w * v[j].w); }
    s = wave_sum(s);
    if (lane == 0) *sumsq = s;
    GAS v2u* o8 = (GAS v2u*)orow + lane;
#pragma unroll
    for (int j = 0; j < 16; ++j) { v2u w; w.x = pk2(v[j].x, v[j].y); w.y = pk2(v[j].z, v[j].w); o8[64 * j] = w; }
}
__device__ __forceinline__ void rms_row_inplace(float* xrow, const float* g, int lane) {
    GAS f32x4* xr = (GAS f32x4*)xrow + lane; const GAS f32x4* gr = (const GAS f32x4*)g + lane;
    f32x4 v[16]; float s = 0.f;
#pragma unroll
    for (int j = 0; j < 16; ++j) { v[j] = xr[64 * j]; s += (v[j].x * v[j].x + v[j].y * v[j].y) + (v[j].z * v[j].z + v[j].w * v[j].w); }
    const float rs = 1.f / sqrtf(wave_sum(s) * (1.f / 4096.f) + EPS);
#pragma unroll
    for (int j = 0; j < 16; ++j) { const f32x4 gg = gr[64 * j]; xr[64 * j] = v[j] * rs * gg; }
}

struct Args { const float* in[17]; float* out; unsigned char* ws; float inv[16]; int ph_lo, ph_hi, li, pad; };
constexpr int N_PHASES = 10;
__global__ void __launch_bounds__(NWAVES * 64, 2) mega(Args args) {
    extern __shared__ __attribute__((aligned(16))) unsigned char lds[];
    LAS unsigned char* L = (LAS unsigned char*)lds;
    volatile LAS unsigned* MISC = (volatile LAS unsigned*)(L + MISC_OFF);
    const int tid = threadIdx.x, lane = tid & 63, wave = __builtin_amdgcn_readfirstlane(tid >> 6);
    const int G = gridDim.x;
    unsigned char* ws = args.ws;
    gu32* ctl = (gu32*)(ws + WS_CTL);
    const float* x = args.in[0]; const float* norm_attn = args.in[1]; const float* w_in = args.in[2];
    const float* w_out = args.in[11]; const float* norm_ffn = args.in[12]; const float* w_gate = args.in[13]; const float* w_up = args.in[14]; const float* w_down = args.in[15];
    const float* norm_final = args.in[16];
    float* out = args.out;
    bf16* Win_t = (bf16*)(ws + WS_WIN); bf16* Wout_t = (bf16*)(ws + WS_WOUT); bf16* Wgu_t = (bf16*)(ws + WS_WGU); bf16* Wdn_t = (bf16*)(ws + WS_WDN);
    bf16* bufA = (bf16*)(ws + WS_BUFA); bf16* proj = (bf16*)(ws + WS_PROJ); bf16* mixed = proj; bf16* act = proj;
    float* cs = (float*)(ws + WS_CS);
    const float* ck_pe = args.in[3]; const float* ck_w1 = args.in[4]; const float* ck_w2 = args.in[5];
    const float* cv_pe = args.in[6]; const float* cv_w1 = args.in[7]; const float* cv_w2 = args.in[8];
    const float* out_norm_a = args.in[9]; const float* out_norm_b = args.in[10];
    bf16* kcb = (bf16*)(ws + WS_KCB); bf16* vcb = (bf16*)(ws + WS_KCB + 1 * MiB);
    bf16* ckW1T = (bf16*)(ws + WS_W1T); bf16* cvW1T = (bf16*)(ws + WS_W1T + 1 * MiB);
    float* bias1 = (float*)(ws + WS_BIAS1); float* lse = (float*)(ws + WS_LSE);
    bf16* partA = (bf16*)out;
    bf16* partC = (bf16*)out + (size_t)3 * T * 2048;
    bf16* partS = (bf16*)(ws + WS_PART); bf16* partW = partS + (size_t)T * 2048;
    unsigned char* x1f8 = ws + WS_PART;
    float* rowsq = (float*)(ws + WS_ROWSQ);
    float* gates = (float*)(ws + WS_GATES);
    for (int u = tid; u < (LDS_BYTES - LDSCTL_OFF) / 4; u += NWAVES * 64) ((LAS unsigned*)(L + LDSCTL_OFF))[u] = 0u;
    __syncthreads();
    const int lo = args.ph_lo, hi = args.ph_hi;
    const bool one_launch = (hi - lo) > 1;
    XcdBarrier bar; bar.bar = (unsigned*)(ctl + CW_BAR) + args.li * XCD_BAR_WORDS; bar.x = 0; bar.st = nullptr;
    if (one_launch) bar = xcd_barrier_post((unsigned*)(ctl + CW_BAR) + args.li * XCD_BAR_WORDS, MISC + 8);
#ifndef MK_PH
#define MK_PH 0x3ff
#endif
#define IN(k) ((((MK_PH) >> (k)) & 1) && lo <= (k) && (k) < hi)
#ifdef MK_TPROBE
    unsigned long long ts_a = 0, ts_b = 0, sec_acc = 0; int ts_n = 0;
#define TS() do { unsigned long long t_; asm volatile("s_memrealtime %0\n\ts_waitcnt lgkmcnt(0)" : "=s"(t_) :: "memory"); if (ts_n == MK_TPROBE) ts_a = t_; if (ts_n == MK_TPROBE + 1) ts_b = t_; ++ts_n; } while (0)
#else
#define TS() do { } while (0)
#endif
    TS();
#define BOTH(k) (IN(k) && IN((k) + 1))
    const int gw = blockIdx.x * NWAVES + wave, NGW = G * NWAVES;

    if (IN(0)) {
        LAS float* scr = (LAS float*)(L + RING_OFF + wave * 16384);
        constexpr int I_IN = 64 * 360, I_OUT = 64 * 128, I_G = 64 * 344, I_D = 172 * 128, I_W1 = 64 * 4;
        constexpr int NITEMS = I_IN + I_OUT + 2 * I_G + I_D + 2 * I_W1;
        for (int it = gw; it < NITEMS; it += NGW) {
            int r = it;
            if (r < I_IN) { const int kb = r / 360, nb = r % 360; p0_transpose_item(w_in, D_IN, D_IN, Win_t, 4096, 64 * kb, 32 * nb, 32 * nb, scr, lane, norm_attn); continue; } r -= I_IN;
            if (r < I_OUT) { const int kb = r / 128, nb = r % 128; p0_transpose_item(w_out, 4096, 4096, Wout_t, 4096, 64 * kb, 32 * nb, 32 * nb, scr, lane); continue; } r -= I_OUT;
            if (r < I_G) { const int kb = r / 344, nb = r % 344, n0 = 32 * nb; p0_transpose_item(w_gate, D_FF, D_FF, Wgu_t, 4096, 64 * kb, n0, 256 * (n0 >> 7) + (n0 & 127), scr, lane, norm_ffn, WGU_SCALE); continue; } r -= I_G;
            if (r < I_G) { const int kb = r / 344, nb = r % 344, n0 = 32 * nb; p0_transpose_item(w_up, D_FF, D_FF, Wgu_t, 4096, 64 * kb, n0, 256 * (n0 >> 7) + 128 + (n0 & 127), scr, lane, norm_ffn, WGU_SCALE); continue; } r -= I_G;
            if (r < I_D) { const int kb = r / 128, nb = r % 128; p0_transpose_item(w_down, 4096, 4096, Wdn_t, D_FF, 64 * kb, 32 * nb, 32 * nb, scr, lane, nullptr, WDN_SCALE); continue; } r -= I_D;
            if (r < I_W1) { const int kb = r / 4, nb = r % 4; p0_transpose_item(ck_w1, 128, 128, ckW1T, 4096, 64 * kb, 32 * nb, 32 * nb, scr, lane); continue; } r -= I_W1;
            { const int kb = r / 4, nb = r % 4; p0_transpose_item(cv_w1, 128, 128, cvW1T, 4096, 64 * kb, 32 * nb, 32 * nb, scr, lane); }
        }
        for (int o = gw; o < 256; o += NGW) {
            const int which = o >> 7, j = o & 127; const float* pe = which ? cv_pe : ck_pe; const float* w1 = which ? cv_w1 : ck_w1;
            float a = 0.f;
            for (int i = lane; i < 4096; i += 64) a += pe[i] * w1[(size_t)i * 128 + j];
            a = wave_sum(a);
            if (lane == 0) bias1[o] = a;
        }
        for (int idx = blockIdx.x * (NWAVES * 64) + tid; idx < SEQ * 16; idx += G * NWAVES * 64) {
            const int s = idx >> 4, i = idx & 15; const float ang = (float)s * args.inv[i]; const double a = (double)ang;
            cs[2 * idx] = (float)cos(a); cs[2 * idx + 1] = (float)sin(a);
        }
        for (int m = gw; m < T; m += NGW) row_to_bf16_sumsq(x + (size_t)m * D_MODEL, bufA + (size_t)m * D_MODEL, rowsq + 2 * T + m, lane);
        for (int i = blockIdx.x * (NWAVES * 64) + tid; i < 2 * T; i += G * NWAVES * 64) rowsq[i] = 0.f;
        if (BOTH(0)) xcd_barrier(bar);
        TS();
    }
    if (IN(1)) {
        pg8::Gemm g{bufA, Win_t, T, OFF_GL, D_MODEL}; pg8::StaticOrder S; S.init(T, OFF_GL, G, (int)blockIdx.x);
        pg8::EpiProj E{proj, LDP, cs, rowsq + 2 * T, 1.f / 4096.f, EPS};
        pg8::gemm_phase<pg8::EpiProj, pg8::StaticOrder, true, true>(L + RING_OFF, g, S, E);
        if (BOTH(1)) xcd_barrier(bar);
        TS();
    }
    if (IN(2)) {
        for (int cu = blockIdx.x; cu < 256; cu += G) { const int which = cu >> 7, r = cu & 127;
            att::compress_unit(L, proj, which ? OFF_VC : OFF_KC, which ? cvW1T : ckW1T, bias1 + which * 128, which ? cv_w2 : ck_w2, which ? vcb : kcb, r >> 5, (r >> 3) & 3, r & 7, tid, lane, wave); }
        TS();
        for (int u = blockIdx.x; u < T / 64; u += G) att::gate_unit(L, bufA, Win_t + (size_t)OFF_GL * D_MODEL, rowsq + 2 * T, gates, 64 * u, tid, lane, wave);
        TS();
        for (int u = blockIdx.x; u < 1024; u += G) att::window_unit(L, proj, partW, u, tid, lane, wave SECARG);
        TS();
        for (int u = blockIdx.x; u < 3072; u += G) att::dilated_unit(L, proj, partA, lse, u, tid, lane, wave SECARG);
        TS();
        if (BOTH(2)) xcd_barrier(bar);
        TS();
    }
    if (IN(3)) {
        for (int rd = 0; rd * G < 1024; ++rd) {
            const int idx = (rd & 1) ? rd * G + (G - 1 - (int)blockIdx.x) : rd * G + (int)blockIdx.x;
            if (idx < 1024) { const int qb = 63 - (idx >> 4), bg = idx & 15; att::nsa_unit(L, proj, kcb, vcb, partC, partS, bg >> 2, bg & 3, qb, tid, lane, wave SECARG); }
        }
        TS();
        if (BOTH(3)) xcd_barrier(bar);
        TS();
    }
    if (IN(4)) {
        for (int it = gw; it < 2 * T; it += NGW) {
            const int m = it >> 1, grp = it & 1;
            float ov[32]; float ss = 0.f;
            if (grp == 0) {
#pragma unroll
                for (int k = 0; k < 4; ++k) {
                    const int ch = lane + 64 * k, head = ch >> 4;
                    const float l0 = lse[((size_t)0 * T + m) * 16 + head], l1 = lse[((size_t)1 * T + m) * 16 + head], l2 = lse[((size_t)2 * T + m) * 16 + head];
                    const float mx = fmaxf(l0, fmaxf(l1, l2)); const float e0 = __expf(l0 - mx), e1 = __expf(l1 - mx), e2 = __expf(l2 - mx); const float inv = 1.f / (e0 + e1 + e2);
                    const float w0 = e0 * inv, w1 = e1 * inv, w2 = e2 * inv;
                    const size_t off = (size_t)m * 2048 + 8 * ch;
                    const v4u x0 = *(const v4u*)(partA + off), x1 = *(const v4u*)(partA + (size_t)T * 2048 + off), x2 = *(const v4u*)(partA + (size_t)2 * T * 2048 + off);
#pragma unroll
                    for (int e = 0; e < 4; ++e) {
                        const float alo = w0 * __uint_as_float(x0[e] << 16) + w1 * __uint_as_float(x1[e] << 16) + w2 * __uint_as_float(x2[e] << 16);
                        const float ahi = w0 * __uint_as_float(x0[e] & 0xffff0000u) + w1 * __uint_as_float(x1[e] & 0xffff0000u) + w2 * __uint_as_float(x2[e] & 0xffff0000u);
                        ov[8 * k + 2 * e] = alo; ov[8 * k + 2 * e + 1] = ahi; ss += alo * alo + ahi * ahi;
                    }
                }
            } else {
#pragma unroll
                for (int k = 0; k < 4; ++k) {
                    const int ch = lane + 64 * k, head = ch >> 4;
                    const size_t off = (size_t)m * 2048 + 8 * ch;
                    const float gc = gates[(size_t)m * 48 + head * 3], gs = gates[(size_t)m * 48 + head * 3 + 1], gw_ = gates[(size_t)m * 48 + head * 3 + 2];
                    const v4u y0 = *(const v4u*)(partC + off), y1 = *(const v4u*)(partS + off), y2 = *(const v4u*)(partW + off);
#pragma unroll
                    for (int e = 0; e < 4; ++e) {
                        const float blo = gc * __uint_as_float(y0[e] << 16) + gs * __uint_as_float(y1[e] << 16) + gw_ * __uint_as_float(y2[e] << 16);
                        const float bhi = gc * __uint_as_float(y0[e] & 0xffff0000u) + gs * __uint_as_float(y1[e] & 0xffff0000u) + gw_ * __uint_as_float(y2[e] & 0xffff0000u);
                        ov[8 * k + 2 * e] = blo; ov[8 * k + 2 * e + 1] = bhi; ss += blo * blo + bhi * bhi;
                    }
                }
            }
            const float rs = 1.f / sqrtf(wave_sum(ss) * (1.f / 2048.f) + EPS);
            const float* gn = grp ? out_norm_b : out_norm_a;
#pragma unroll
            for (int k = 0; k < 4; ++k) {
                const int ch = lane + 64 * k;
                const f32x4 g0 = *(const f32x4*)(gn + 8 * ch), g1 = *(const f32x4*)(gn + 8 * ch + 4);
                v4u w;
                w.x = pk2(ov[8 * k + 0] * rs * g0.x, ov[8 * k + 1] * rs * g0.y); w.y = pk2(ov[8 * k + 2] * rs * g0.z, ov[8 * k + 3] * rs * g0.w);
                w.z = pk2(ov[8 * k + 4] * rs * g1.x, ov[8 * k + 5] * rs * g1.y); w.w = pk2(ov[8 * k + 6] * rs * g1.z, ov[8 * k + 7] * rs * g1.w);
                *(v4u*)(mixed + (size_t)m * D_MODEL + grp * 2048 + 8 * ch) = w;
            }
        }
        if (BOTH(4)) xcd_barrier(bar);
        TS();
    }

    if (IN(5)) {
        pg8::Gemm g{mixed, Wout_t, T, D_MODEL, D_MODEL}; pg8::StaticOrder S; S.init(T, D_MODEL, G, (int)blockIdx.x);
        pg8::EpiResid<true> E{bufA, bufA, rowsq, x1f8, D_MODEL, 1.f};
        pg8::gemm_phase<pg8::EpiResid<true>, pg8::StaticOrder, true, true>(L + RING_OFF, g, S, E);
        if (IN(7)) xcd_barrier(bar);
        TS();
    }
    if (IN(7)) {
        pg8::Gemm g{(const bf16*)x1f8, Wgu_t, T, NGU, D_MODEL / 2}; pg8::StaticOrder S; S.init(T, NGU, G, (int)blockIdx.x);
        pg8::EpiSwiglu<true> E{act, D_FF, rowsq, 1.f / 4096.f, EPS, 1.f / WGU_SCALE};
        pg8::gemm_phase<pg8::EpiSwiglu<true>, pg8::StaticOrder, true, true, true>(L + RING_OFF, g, S, E);
        if (BOTH(7)) xcd_barrier(bar);
        TS();
    }
    if (IN(8)) {
        pg8::Gemm g{act, Wdn_t, T, D_MODEL, D_FF / 2}; pg8::StaticOrder S; S.init(T, D_MODEL, G, (int)blockIdx.x);
        pg8::EpiResid<true> E{bufA, bufA, rowsq + T, nullptr, D_MODEL, 1.f / WDN_SCALE};
        pg8::gemm_phase<pg8::EpiResid<true>, pg8::StaticOrder, true, P8_SP2, true>(L + RING_OFF, g, S, E);
        if (BOTH(8)) xcd_barrier(bar);
        TS();
    }
    if (IN(9)) {
        for (int m = gw; m < T; m += NGW) {
            const float rs = 1.f / sqrtf(rowsq[T + m] * (1.f / 4096.f) + EPS);
            const GAS v2u* xr = (const GAS v2u*)(bufA + (size_t)m * D_MODEL) + lane; const GAS f32x4* gr = (const GAS f32x4*)norm_final + lane; GAS f32x4* orow = (GAS f32x4*)(out + (size_t)m * D_MODEL) + lane;
            v2u v[16];
#pragma unroll
            for (int j = 0; j < 16; ++j) v[j] = xr[64 * j];
#pragma unroll
            for (int j = 0; j < 16; ++j) { const f32x4 gg = gr[64 * j];
                orow[64 * j] = (f32x4){__uint_as_float(v[j].x << 16) * rs * gg.x, __uint_as_float(v[j].x & 0xffff0000u) * rs * gg.y, __uint_as_float(v[j].y << 16) * rs * gg.z, __uint_as_float(v[j].y & 0xffff0000u) * rs * gg.w}; }
        }
    }
    TS();
#ifdef MK_TPROBE
    if (blockIdx.x == 0) {
        unsigned long long d = 4ull * (MK_TSEC >= 0 ? sec_acc : (ts_b - ts_a)); if (d > 2000000ull) d = 2000000ull;
        unsigned long long t0_; asm volatile("s_memrealtime %0\n\ts_waitcnt lgkmcnt(0)" : "=s"(t0_) :: "memory");
        for (;;) { unsigned long long t1_; asm volatile("s_memrealtime %0\n\ts_waitcnt lgkmcnt(0)" : "=s"(t1_) :: "memory"); if (t1_ - t0_ >= d) break; __builtin_amdgcn_s_sleep(8); }
    }
#endif
#undef IN
#undef BOTH
}

extern "C" void kernel_launch(void* const* d_in, const int* in_sizes, int n_in, void* d_out, int out_size, void* d_ws, size_t ws_size, hipStream_t stream) {
    static int grid = 0;
    if (grid == 0) {
        if (n_in != 17 || out_size != T * D_MODEL || ws_size < WS_END) { fprintf(stderr, "kernel_launch: unexpected shapes (n_in %d out %d ws %zu); nothing launched\n", n_in, out_size, ws_size); grid = -1; return; }
        int dev = 0, cus = 0, per_cu = 0;
        if (hipGetDevice(&dev) != hipSuccess || hipDeviceGetAttribute(&cus, hipDeviceAttributeMultiprocessorCount, dev) != hipSuccess) { grid = -1; return; }
        if (hipFuncSetAttribute((const void*)mega, hipFuncAttributeMaxDynamicSharedMemorySize, LDS_BYTES) != hipSuccess) { fprintf(stderr, "kernel_launch: hipFuncSetAttribute failed\n"); grid = -1; return; }
        if (hipOccupancyMaxActiveBlocksPerMultiprocessor(&per_cu, (const void*)mega, NWAVES * 64, LDS_BYTES) != hipSuccess || per_cu < 1)
            fprintf(stderr, "kernel_launch: note: occupancy query reports %d workgroups per CU\n", per_cu);
        (void)hipGetLastError();
        grid = cus;
    }
    if (grid < 0) return;
    if (hipMemsetAsync((char*)d_ws + WS_CTL, 0, CTL_ZERO_BYTES, stream) != hipSuccess) return;
    Args a{};
    for (int i = 0; i < 17; ++i) a.in[i] = (const float*)d_in[i];
    a.out = (float*)d_out; a.ws = (unsigned char*)d_ws;
    for (int i = 0; i < 16; ++i) a.inv[i] = (float)pow(500000.0, -(double)(2 * i) / 32.0);
    unsigned char* ws = (unsigned char*)d_ws;
    int n_launch = 0;
    auto launch = [&](int lo, int hi) { a.ph_lo = lo; a.ph_hi = hi; a.li = n_launch++; hipLaunchKernelGGL(mega, dim3(grid), dim3(NWAVES * 64), LDS_BYTES, stream, a); };
#if MK_BUILD == 2
    for (int ph = 0; ph < N_PHASES; ++ph) launch(ph, ph + 1);
#elif MK_BUILD == 3
    launch(0, N_PHASES);
#else
#if MK_PROBE == 0
    launch(0, N_PHASES); launch(0, 1);
#elif MK_PROBE == 7
    launch(0, N_PHASES); launch(7, 8);
#else
    launch(0, MK_PROBE + 1); launch(MK_PROBE, MK_PROBE + 1); launch(MK_PROBE + 1, N_PHASES);
#endif
#endif
    const hipError_t le = hipPeekAtLastError();
    if (le != hipSuccess) fprintf(stderr, "kernel_launch: launch failed: %s\n", hipGetErrorName(le));
}
```

```cpp
#include <hip/hip_runtime.h>
#include <cstdio>
#include <cstdint>
#include <math.h>

#ifndef MK_TSEC
#define MK_TSEC -1
#endif
#ifndef MK_TBLOCK
#define MK_TBLOCK 0
#endif
#ifndef MK_TWAVE
#define MK_TWAVE 0
#endif
#ifndef MK_TUNIT
#define MK_TUNIT 2
#endif
#ifndef MK_DYN
#define MK_DYN 1
#endif
#if defined(MK_TPROBE) && !defined(MK_TPROBE_END)
#define MK_TPROBE_END (MK_TPROBE + 1)
#endif
#ifndef MK_BUILD
#define MK_BUILD 3
#endif
namespace pg8 {
#define PG8_LAS __attribute__((address_space(3)))
typedef unsigned short bf16_t;
typedef short bf16x8 __attribute__((ext_vector_type(8)));
typedef float f32x4 __attribute__((ext_vector_type(4)));
typedef unsigned u32x4 __attribute__((ext_vector_type(4)));
constexpr int BM = 256, BK = 64, HALF = 128, HTB = HALF * BK * 2  , STAGE_BYTES = 8 * HTB, NXCD = 8, WGM = 8;

__host__ __device__ __forceinline__ int lds_byte(int r, int c) { const int st = (r >> 4) * 2 + (c >> 5), rr = r & 15, cc = c & 31, ob = rr * 64 + cc * 2; return st * 1024 + (ob ^ (((ob >> 9) & 1) << 5)); }
__host__ __device__ __forceinline__ void stage_rc(int b, int& R, int& C) { const int st = b / 1024, sb = b % 1024, swz = sb ^ (((sb >> 9) & 1) << 5); R = (st >> 1) * 16 + swz / 64; C = (st & 1) * 32 + (swz % 64) / 2; }
__host__ __device__ __forceinline__ int perm32(int rho) { const int n = rho >> 4, i = rho & 15; return 8 * (i >> 2) + 4 * n + (i & 3); }

struct Unit { int pm, pn; };
struct Gemm { const bf16_t* A; const bf16_t* Bt; int M, N, K; };

struct StaticOrder {
    int nM, nN, nwg, G, c, wgm;
    __host__ __device__ void init(int M, int N, int G_, int c_, int wgm_ = WGM) { nM = M / BM; nN = N / BM; nwg = nM * nN; G = G_; c = c_; wgm = wgm_; }
    __host__ __device__ bool next(int i, Unit& u) const {
        const long L = (long)i * G + c; if (L >= nwg) return false;
        int wgid = (int)L; { const int q = nwg / NXCD, r = nwg % NXCD, xcd = wgid % NXCD, off = wgid / NXCD; wgid = (xcd < r ? xcd * (q + 1) : r * (q + 1) + (xcd - r) * q) + off; }
        const int nig = wgm * nN, gid = wgid / nig, fm = gid * wgm, gsz = (nM - fm) < wgm ? (nM - fm) : wgm;
        u.pm = fm + ((wgid % nig) % gsz); u.pn = (wgid % nig) / gsz; return true;
    }
    __device__ __forceinline__ void a_ready(const Unit&) const {}
    __device__ __forceinline__ void done(const Unit&) const {}
};
__device__ __forceinline__ unsigned cvt_pk_bf16(float lo, float hi) { unsigned r; asm volatile("v_cvt_pk_bf16_f32 %0, %1, %2" : "=v"(r) : "v"(lo), "v"(hi)); return r; }
typedef unsigned u32x4 __attribute__((ext_vector_type(4)));
typedef unsigned u32x2 __attribute__((ext_vector_type(2)));
struct EpiProj {
    static constexpr bool PERM = true, AFTER_DRAIN = false;
    bf16_t* O; int ldc; const float* cs; const float* rowsq; float inv_k, eps;
    __device__ __forceinline__ void operator()(const f32x4 (&acc)[2][2][4][2], const Unit& u, int wr, int wc, int fr, int fq) const {
        const int row0 = u.pm * BM + wr * 64 + fr;
        const int col0 = u.pn * BM + wc * 32 + 8 * fq;
        float rsv[2][4];
#pragma unroll
        for (int ai = 0; ai < 2; ++ai)
#pragma unroll
            for (int m = 0; m < 4; ++m) rsv[ai][m] = rowsq[row0 + ai * HALF + m * 16];
        bool ropeb[2];
#pragma unroll
        for (int bj = 0; bj < 2; ++bj) { const int hd = u.pn * 2 + bj;
            ropeb[bj] = (wc == 0) && (hd < 32 || (hd >= 48 && hd < 68) || (hd >= 72 && hd < 76) || (hd >= 80 && hd < 84)); }
        const bool anyrope = ropeb[0] || ropeb[1];
        f32x4 cn0 = {0.f, 0.f, 0.f, 0.f}, cn1 = cn0, cn2 = cn0, cn3 = cn0;
        if (anyrope) { const float* c = cs + ((size_t)(row0 & 4095) * 16 + 8 * (fq & 1)) * 2; cn0 = *(const f32x4*)c; cn1 = *(const f32x4*)(c + 4); cn2 = *(const f32x4*)(c + 8); cn3 = *(const f32x4*)(c + 12); }
#pragma unroll
        for (int idx = 0; idx < 8; ++idx) {
            const int ai = idx >> 2, m = idx & 3;
            const int row = row0 + ai * HALF + m * 16;
            const float rs = 1.f / sqrtf(rsv[ai][m] * inv_k + eps);
            const f32x4 c0 = cn0, c1 = cn1, c2 = cn2, c3 = cn3;
            if (anyrope && idx < 7) { const int rown = row0 + ((idx + 1) >> 2) * HALF + ((idx + 1) & 3) * 16; const float* c = cs + ((size_t)(rown & 4095) * 16 + 8 * (fq & 1)) * 2;
                cn0 = *(const f32x4*)c; cn1 = *(const f32x4*)(c + 4); cn2 = *(const f32x4*)(c + 8); cn3 = *(const f32x4*)(c + 12); }
#pragma unroll
            for (int bj = 0; bj < 2; ++bj) {
                f32x4 v0 = acc[ai][bj][m][0] * rs, v1 = acc[ai][bj][m][1] * rs;
                if (ropeb[bj]) {
                    f32x4 w0, w1;
#pragma unroll
                    for (int e = 0; e < 4; ++e) { w0[e] = __shfl_xor(v0[e], 32); w1[e] = __shfl_xor(v1[e], 32); }
                    const float cosv[8] = {c0[0], c0[2], c1[0], c1[2], c2[0], c2[2], c3[0], c3[2]};
                    const float sinv[8] = {c0[1], c0[3], c1[1], c1[3], c2[1], c2[3], c3[1], c3[3]};
                    if (fq < 2) {
#pragma unroll
                        for (int e = 0; e < 4; ++e) { v0[e] = v0[e] * cosv[e] - w0[e] * sinv[e]; v1[e] = v1[e] * cosv[4 + e] - w1[e] * sinv[4 + e]; }
                    } else {
#pragma unroll
                        for (int e = 0; e < 4; ++e) { v0[e] = w0[e] * sinv[e] + v0[e] * cosv[e]; v1[e] = w1[e] * sinv[4 + e] + v1[e] * cosv[4 + e]; }
                    }
                }
                u32x4 w; w.x = cvt_pk_bf16(v0[0], v0[1]); w.y = cvt_pk_bf16(v0[2], v0[3]); w.z = cvt_pk_bf16(v1[0], v1[1]); w.w = cvt_pk_bf16(v1[2], v1[3]);
                *(u32x4*)(O + (size_t)row * ldc + col0 + bj * HALF) = w;
            }
        }
    }
};
template <bool R_BF16> struct EpiResid {
    static constexpr bool PERM = true, AFTER_DRAIN = false;
    const void* R; bf16_t* Ob; float* rowsq; unsigned char* O8; int ldc; float ascale;
    __device__ __forceinline__ void operator()(const f32x4 (&acc)[2][2][4][2], const Unit& u, int wr, int wc, int fr, int fq) const {
        const int row0 = u.pm * BM + wr * 64 + fr;
        const int col0 = u.pn * BM + wc * 32 + 8 * fq;
        u32x4 rbv[2][4][2];
        if constexpr (R_BF16) {
#pragma unroll
            for (int ai = 0; ai < 2; ++ai)
#pragma unroll
                for (int m = 0; m < 4; ++m)
#pragma unroll
                    for (int bj = 0; bj < 2; ++bj) rbv[ai][m][bj] = *(const u32x4*)((const bf16_t*)R + (size_t)(row0 + ai * HALF + m * 16) * ldc + col0 + bj * HALF);
        }
#pragma unroll
        for (int ai = 0; ai < 2; ++ai)
#pragma unroll
            for (int m = 0; m < 4; ++m) {
                const size_t ro = (size_t)(row0 + ai * HALF + m * 16) * ldc + col0;
                float ss = 0.f;
#pragma unroll
                for (int bj = 0; bj < 2; ++bj) {
                    f32x4 r0, r1;
                    if constexpr (R_BF16) { const u32x4 rb = rbv[ai][m][bj];
                        r0 = (f32x4){__builtin_bit_cast(float, rb.x << 16), __builtin_bit_cast(float, rb.x & 0xffff0000u), __builtin_bit_cast(float, rb.y << 16), __builtin_bit_cast(float, rb.y & 0xffff0000u)};
                        r1 = (f32x4){__builtin_bit_cast(float, rb.z << 16), __builtin_bit_cast(float, rb.z & 0xffff0000u), __builtin_bit_cast(float, rb.w << 16), __builtin_bit_cast(float, rb.w & 0xffff0000u)}; }
                    else { r0 = *(const f32x4*)((const float*)R + ro + bj * HALF); r1 = *(const f32x4*)((const float*)R + ro + bj * HALF + 4); }
                    const f32x4 o0 = r0 + acc[ai][bj][m][0] * ascale, o1 = r1 + acc[ai][bj][m][1] * ascale;
                    u32x4 w; w.x = cvt_pk_bf16(o0[0], o0[1]); w.y = cvt_pk_bf16(o0[2], o0[3]); w.z = cvt_pk_bf16(o1[0], o1[1]); w.w = cvt_pk_bf16(o1[2], o1[3]);
                    *(u32x4*)(Ob + ro + bj * HALF) = w;
                    if (O8) { int w0 = __builtin_amdgcn_cvt_pk_fp8_f32(o0[0], o0[1], 0, false); w0 = __builtin_amdgcn_cvt_pk_fp8_f32(o0[2], o0[3], w0, true);
                        int w1 = __builtin_amdgcn_cvt_pk_fp8_f32(o1[0], o1[1], 0, false); w1 = __builtin_amdgcn_cvt_pk_fp8_f32(o1[2], o1[3], w1, true);
                        *(u32x2*)(O8 + ro + bj * HALF) = (u32x2){(unsigned)w0, (unsigned)w1}; }
                    ss += (o0[0] * o0[0] + o0[1] * o0[1]) + (o0[2] * o0[2] + o0[3] * o0[3]) + (o1[0] * o1[0] + o1[1] * o1[1]) + (o1[2] * o1[2] + o1[3] * o1[3]);
                }
                ss += __shfl_xor(ss, 16); ss += __shfl_xor(ss, 32); if (fq == 0) atomicAdd(rowsq + (row0 + ai * HALF + m * 16), ss);
            }
    }
};
template <bool FP8OUT> struct EpiSwiglu {
    static constexpr bool PERM = true, AFTER_DRAIN = false;
    bf16_t* O; int ldc; const float* rowsq; float inv_k, eps, ascale;
    __device__ __forceinline__ static float silu_mul(float g, float uu) { return g * __builtin_amdgcn_rcpf(1.f + __builtin_amdgcn_exp2f(-1.4426950408889634f * g)) * uu; }
    __device__ __forceinline__ void operator()(const f32x4 (&acc)[2][2][4][2], const Unit& u, int wr, int wc, int fr, int fq) const {
        const int row0 = u.pm * BM + wr * 64 + fr;
        const int col0 = u.pn * HALF + wc * 32 + 8 * fq;
        float rsv[2][4];
#pragma unroll
        for (int ai = 0; ai < 2; ++ai)
#pragma unroll
            for (int m = 0; m < 4; ++m) rsv[ai][m] = rowsq[row0 + ai * HALF + m * 16];
#pragma unroll
        for (int ai = 0; ai < 2; ++ai)
#pragma unroll
            for (int m = 0; m < 4; ++m) {
                const float rs = ascale / sqrtf(rsv[ai][m] * inv_k + eps);
                const f32x4 g0 = acc[ai][0][m][0] * rs, g1 = acc[ai][0][m][1] * rs, u0 = acc[ai][1][m][0] * rs, u1 = acc[ai][1][m][1] * rs;
                if constexpr (FP8OUT) {
                    int w0 = __builtin_amdgcn_cvt_pk_fp8_f32(silu_mul(g0[0], u0[0]), silu_mul(g0[1], u0[1]), 0, false); w0 = __builtin_amdgcn_cvt_pk_fp8_f32(silu_mul(g0[2], u0[2]), silu_mul(g0[3], u0[3]), w0, true);
                    int w1 = __builtin_amdgcn_cvt_pk_fp8_f32(silu_mul(g1[0], u1[0]), silu_mul(g1[1], u1[1]), 0, false); w1 = __builtin_amdgcn_cvt_pk_fp8_f32(silu_mul(g1[2], u1[2]), silu_mul(g1[3], u1[3]), w1, true);
                    *(u32x2*)((unsigned char*)O + (size_t)(row0 + ai * HALF + m * 16) * ldc + col0) = (u32x2){(unsigned)w0, (unsigned)w1};
                } else {
                u32x4 w;
                w.x = cvt_pk_bf16(silu_mul(g0[0], u0[0]), silu_mul(g0[1], u0[1])); w.y = cvt_pk_bf16(silu_mul(g0[2], u0[2]), silu_mul(g0[3], u0[3]));
                w.z = cvt_pk_bf16(silu_mul(g1[0], u1[0]), silu_mul(g1[1], u1[1])); w.w = cvt_pk_bf16(silu_mul(g1[2], u1[2]), silu_mul(g1[3], u1[3]));
                *(u32x4*)(O + (size_t)(row0 + ai * HALF + m * 16) * ldc + col0) = w; }
            }
    }
};
typedef int v8i_t __attribute__((ext_vector_type(8)));
typedef int v4i_t __attribute__((ext_vector_type(4)));
__device__ __forceinline__ v8i_t cat8(bf16x8 lo, bf16x8 hi) { const v4i_t a = __builtin_bit_cast(v4i_t, lo), b = __builtin_bit_cast(v4i_t, hi); return __builtin_shufflevector(a, b, 0, 1, 2, 3, 4, 5, 6, 7); }
template <class Epi, class Sched, bool ALIGN_EPI = false, bool SP2 = false, bool FP8 = false>
__device__ __forceinline__ void gemm_phase(PG8_LAS unsigned char* lds, const Gemm g, const Sched& S, const Epi& E) {
    const int tid = threadIdx.x, wid = __builtin_amdgcn_readfirstlane(tid >> 6), lane = tid & 63, wr = wid >> 2, wc = wid & 3, fr = lane & 15, fq = lane >> 4;
    const int K = g.K, nt = K / BK;
    unsigned voffA[2], voffB[2];
#pragma unroll
    for (int i = 0; i < 2; ++i) { int R, C; stage_rc(tid * 16 + i * 8192, R, C); const int Rb = Epi::PERM ? ((R & ~31) + perm32(R & 31)) : R;
        voffA[i] = (unsigned)(R * K + C) * 2u; voffB[i] = (unsigned)(Rb * K + C) * 2u; }
    const size_t kstep = (size_t)(BK * 2);
    const size_t hstep = (size_t)HALF * K * 2;
    const size_t tstep = 2 * hstep;
    const unsigned ldsw = (unsigned)wid * 1024u;
    const int aoff = lds_byte(wr * 64 + fr, fq * 8), boff = lds_byte(wc * 32 + fr, fq * 8);
#define PG8_SA(b, h) (((b) * 2 + (h)) * HTB)
#define PG8_SB(b, h) ((4 + (b) * 2 + (h)) * HTB)
#define PG8_STAGE(bufoff, gbase, voff) do { _Pragma("unroll") for (int _i = 0; _i < 2; ++_i) \
        __builtin_amdgcn_global_load_lds((const unsigned*)((const char*)(gbase) + (voff)[_i]), (PG8_LAS unsigned*)(lds + (bufoff) + ldsw + _i * 8192), 16, 0, 0); } while (0)
#define PG8_LDA(dst, b, h) do { if constexpr (FP8) { _Pragma("unroll") for (int m = 0; m < 4; ++m) dst##8[m] = cat8(*(const PG8_LAS bf16x8*)(lds + PG8_SA(b, h) + aoff + m * 2048), *(const PG8_LAS bf16x8*)(lds + PG8_SA(b, h) + aoff + m * 2048 + 1024)); } else { \
        _Pragma("unroll") for (int m = 0; m < 4; ++m) _Pragma("unroll") for (int k = 0; k < 2; ++k) dst[m][k] = *(const PG8_LAS bf16x8*)(lds + PG8_SA(b, h) + aoff + m * 2048 + k * 1024); } } while (0)
#define PG8_LDB(dst, b, h) do { if constexpr (FP8) { _Pragma("unroll") for (int n = 0; n < 2; ++n) dst##8[n] = cat8(*(const PG8_LAS bf16x8*)(lds + PG8_SB(b, h) + boff + n * 2048), *(const PG8_LAS bf16x8*)(lds + PG8_SB(b, h) + boff + n * 2048 + 1024)); } else { \
        _Pragma("unroll") for (int n = 0; n < 2; ++n) _Pragma("unroll") for (int k = 0; k < 2; ++k) dst[n][k] = *(const PG8_LAS bf16x8*)(lds + PG8_SB(b, h) + boff + n * 2048 + k * 1024); } } while (0)
#define PG8_MMA(ai, bj, At, Bt) do { __builtin_amdgcn_s_setprio(1); if constexpr (FP8) { _Pragma("unroll") for (int m = 0; m < 4; ++m) _Pragma("unroll") for (int n = 0; n < 2; ++n) \
        asm volatile("v_mfma_scale_f32_16x16x128_f8f6f4 %0, %1, %2, %0, %3, %3 op_sel_hi:[0,0,0]" : "+v"(acc[ai][bj][m][n]) : "v"(Bt##8[n]), "v"(At##8[m]), "v"(fp8_unit_scale)); } else { \
        _Pragma("unroll") for (int m = 0; m < 4; ++m) _Pragma("unroll") for (int n = 0; n < 2; ++n) _Pragma("unroll") for (int k = 0; k < 2; ++k) \
        acc[ai][bj][m][n] = __builtin_amdgcn_mfma_f32_16x16x32_bf16(Bt[n][k], At[m][k], acc[ai][bj][m][n], 0, 0, 0); } __builtin_amdgcn_s_setprio(0); } while (0)
#define PG8_WAIT_V(n) asm volatile("s_waitcnt vmcnt(" #n ")" ::: "memory")
#define PG8_WAIT_L(n) asm volatile("s_waitcnt lgkmcnt(" #n ")" ::: "memory")
#define PG8_BAR __builtin_amdgcn_s_barrier()
#define PG8_SCHED __builtin_amdgcn_sched_barrier(0)
    Unit cur, nxt; int ui = 0;
    if (!S.next(0, cur)) return;
    f32x4 acc[2][2][4][2];
#pragma unroll
    for (int a = 0; a < 2; ++a)
#pragma unroll
        for (int b = 0; b < 2; ++b)
#pragma unroll
            for (int m = 0; m < 4; ++m)
#pragma unroll
                for (int n = 0; n < 2; ++n) acc[a][b][m][n] = (f32x4){0.f, 0.f, 0.f, 0.f};
    const int fp8_unit_scale = 0x7F7F7F7F;
    bf16x8 At[4][2], B0[2][2], B1[2][2]; v8i_t At8[4], B08[2], B18[2];
    const char* cA = (const char*)g.A + (size_t)cur.pm * tstep; const char* cB = (const char*)g.Bt + (size_t)cur.pn * tstep;
    S.a_ready(cur);
    if constexpr (SP2) {
        PG8_STAGE(PG8_SB(0, 0), cB, voffB); PG8_STAGE(PG8_SB(0, 1), cB + hstep, voffB); PG8_STAGE(PG8_SA(0, 0), cA, voffA); PG8_STAGE(PG8_SA(0, 1), cA + hstep, voffA);
        if (wr == 1) PG8_BAR;
        PG8_WAIT_V(2); PG8_BAR;
        PG8_STAGE(PG8_SB(1, 0), cB + kstep, voffB); PG8_STAGE(PG8_SA(1, 0), cA + kstep, voffA); PG8_STAGE(PG8_SB(1, 1), cB + hstep + kstep, voffB);
        PG8_WAIT_V(6); PG8_BAR;
    } else {
        PG8_STAGE(PG8_SB(0, 0), cB, voffB); PG8_STAGE(PG8_SA(0, 0), cA, voffA); PG8_STAGE(PG8_SB(0, 1), cB + hstep, voffB); PG8_STAGE(PG8_SA(0, 1), cA + hstep, voffA);
        if (wr == 1) PG8_BAR;
        PG8_WAIT_V(4); PG8_BAR;
        PG8_STAGE(PG8_SB(1, 0), cB + kstep, voffB); PG8_STAGE(PG8_SA(1, 0), cA + kstep, voffA); PG8_STAGE(PG8_SB(1, 1), cB + hstep + kstep, voffB);
        PG8_WAIT_V(6); PG8_BAR;
    }
    for (;;) {
        const bool has_next = S.next(ui + 1, nxt);
        const char* nA = has_next ? (const char*)g.A + (size_t)nxt.pm * tstep : cA; const char* nB = has_next ? (const char*)g.Bt + (size_t)nxt.pn * tstep : cB;
        for (int t = 0; t < nt; t += 2) {
            const bool last = (t == nt - 2);
            const char* a1 = cA + (size_t)(t + 1) * kstep;
            const char* a2 = last ? nA : cA + (size_t)(t + 2) * kstep; const char* b2 = last ? nB : cB + (size_t)(t + 2) * kstep;
            const char* a3 = a2 + kstep; const char* b3 = b2 + kstep;
            if (last && has_next) S.a_ready(nxt);
            if constexpr (SP2) {
            PG8_LDB(B0, 0, 0); PG8_LDB(B1, 0, 1); PG8_SCHED; PG8_LDA(At, 0, 0); PG8_STAGE(PG8_SA(1, 1), a1 + hstep, voffA);
            PG8_WAIT_V(8); PG8_WAIT_L(0); PG8_BAR; PG8_MMA(0, 0, At, B0); PG8_MMA(0, 1, At, B1); PG8_BAR; PG8_SCHED;
            PG8_LDA(At, 0, 1); PG8_STAGE(PG8_SB(0, 0), b2, voffB); PG8_STAGE(PG8_SB(0, 1), b2 + hstep, voffB); PG8_STAGE(PG8_SA(0, 0), a2, voffA);
            PG8_WAIT_V(8); PG8_WAIT_L(0); PG8_BAR; PG8_MMA(1, 0, At, B0); PG8_MMA(1, 1, At, B1); PG8_BAR; PG8_SCHED;
            PG8_LDB(B0, 1, 0); PG8_LDB(B1, 1, 1); PG8_SCHED; PG8_LDA(At, 1, 0); PG8_STAGE(PG8_SA(0, 1), a2 + hstep, voffA);
            PG8_WAIT_V(8); PG8_WAIT_L(0); PG8_BAR; PG8_MMA(0, 0, At, B0); PG8_MMA(0, 1, At, B1); PG8_BAR; PG8_SCHED;
            PG8_LDA(At, 1, 1); PG8_STAGE(PG8_SB(1, 0), b3, voffB); PG8_STAGE(PG8_SB(1, 1), b3 + hstep, voffB); PG8_STAGE(PG8_SA(1, 0), a3, voffA);
            PG8_WAIT_V(8); PG8_WAIT_L(0); PG8_BAR; PG8_MMA(1, 0, At, B0); PG8_MMA(1, 1, At, B1); PG8_BAR; PG8_SCHED;
            } else {
            PG8_LDB(B0, 0, 0); PG8_SCHED; PG8_LDA(At, 0, 0); PG8_STAGE(PG8_SA(1, 1), a1 + hstep, voffA);
            PG8_WAIT_L(8); PG8_BAR; PG8_WAIT_L(0); PG8_MMA(0, 0, At, B0); PG8_BAR; PG8_SCHED;
            PG8_LDB(B1, 0, 1); PG8_STAGE(PG8_SB(0, 0), b2, voffB);
            PG8_BAR; PG8_WAIT_L(0); PG8_MMA(0, 1, At, B1); PG8_BAR;
            PG8_LDA(At, 0, 1); PG8_STAGE(PG8_SA(0, 0), a2, voffA);
            PG8_BAR; PG8_WAIT_L(0); PG8_MMA(1, 0, At, B0); PG8_BAR; PG8_SCHED;
            PG8_STAGE(PG8_SB(0, 1), b2 + hstep, voffB);
            PG8_WAIT_V(6); PG8_BAR; PG8_MMA(1, 1, At, B1); PG8_BAR;
            PG8_LDB(B0, 1, 0); PG8_SCHED; PG8_LDA(At, 1, 0); PG8_STAGE(PG8_SA(0, 1), a2 + hstep, voffA);
            PG8_WAIT_L(8); PG8_BAR; PG8_WAIT_L(0); PG8_MMA(0, 0, At, B0); PG8_BAR; PG8_SCHED;
            PG8_LDB(B1, 1, 1); PG8_STAGE(PG8_SB(1, 0), b3, voffB);
            PG8_BAR; PG8_WAIT_L(0); PG8_MMA(0, 1, At, B1); PG8_BAR;
            PG8_LDA(At, 1, 1); PG8_STAGE(PG8_SA(1, 0), a3, voffA);
            PG8_BAR; PG8_WAIT_L(0); PG8_MMA(1, 0, At, B0); PG8_BAR; PG8_SCHED;
            PG8_STAGE(PG8_SB(1, 1), b3 + hstep, voffB);
            PG8_WAIT_V(6); PG8_BAR; PG8_MMA(1, 1, At, B1); PG8_BAR;
            }
        }
        if constexpr (ALIGN_EPI) { if (wr == 0) PG8_BAR; }
        if constexpr (FP8) asm volatile("s_nop 15\n\ts_nop 15\n\ts_nop 15" ::: "memory");
        if constexpr (!Epi::AFTER_DRAIN) { E(acc, cur, wr, wc, fr, fq); S.done(cur); }
        if (!has_next) break;
#pragma unroll
        for (int a = 0; a < 2; ++a)
#pragma unroll
            for (int b = 0; b < 2; ++b)
#pragma unroll
                for (int m = 0; m < 4; ++m)
#pragma unroll
                    for (int n = 0; n < 2; ++n) acc[a][b][m][n] = (f32x4){0.f, 0.f, 0.f, 0.f};
        if constexpr (FP8) asm volatile("s_nop 7" ::: "memory");
        cur = nxt; cA = nA; cB = nB; ++ui;
        if constexpr (ALIGN_EPI) { if (wr == 1) PG8_BAR; }
    }
    PG8_WAIT_V(0);
    if constexpr (!ALIGN_EPI) { if (wr == 0) PG8_BAR; }
    PG8_BAR;
    if constexpr (Epi::AFTER_DRAIN) { E.fused(acc, cur, wr, wc, fr, fq, lds, wid, lane); S.done(cur); }
#undef PG8_SA
#undef PG8_SB
#undef PG8_STAGE
#undef PG8_LDA
#undef PG8_LDB
#undef PG8_MMA
#undef PG8_WAIT_V
#undef PG8_WAIT_L
#undef PG8_BAR
#undef PG8_SCHED
}
}
constexpr int D_MODEL = 4096, BATCH = 4, SEQ = 4096, T = BATCH * SEQ;
constexpr int HA = 16, HB = 16, GB = 4, RB = 4;
constexpr int D_IN = 11312, LDP = 11520, D_FF = 11008, NGU = 2 * D_FF;
constexpr int OFF_QA = 0, OFF_KA = 2048, OFF_VA = 4096, OFF_QB = 6144, OFF_KC = 8192, OFF_VC = 8704,
              OFF_KS = 9216, OFF_VS = 9728, OFF_KW = 10240, OFF_VW = 10752, OFF_GL = 11264;
constexpr int NC = 255, NS = 64, CMP_LEN = 32, CMP_STRIDE = 16, NSEL = 16, WIN = 512;
constexpr float EPS = 1e-5f;
constexpr float QSCALE = 0.08838834764831845f;
constexpr int NWAVES = 8;
#ifndef PG8_FP8_SCALE
#define PG8_FP8_SCALE 0x7F7F7F7F
#endif
#ifndef P1_WGM
#define P1_WGM 8
#endif
#ifndef P5_WGM
#define P5_WGM 4
#endif
#ifndef P7_WGM
#define P7_WGM 8
#endif
#ifndef P8_WGM
#define P8_WGM 2
#endif
#ifndef P8_SP2
#define P8_SP2 true
#endif
constexpr float WGU_SCALE = 64.f;
constexpr float WDN_SCALE = 64.f;

constexpr size_t MiB = 1u << 20;
constexpr size_t WS_CTL = 0, CTL_ZERO_BYTES = (MK_BUILD == 3) ? 64 * 1024 : 1 * MiB;
constexpr size_t WS_WIN = 1 * MiB;
constexpr size_t WS_WOUT = 91 * MiB;
constexpr size_t WS_WGU = 123 * MiB;
constexpr size_t WS_WDN = 295 * MiB;
constexpr size_t WS_BUFA = 381 * MiB;
constexpr size_t WS_PROJ = 509 * MiB;
constexpr size_t WS_SMALL = 869 * MiB;
constexpr size_t WS_CS = WS_SMALL;
constexpr size_t WS_KCF = WS_SMALL + 1 * MiB;
constexpr size_t WS_KCB = WS_SMALL + 5 * MiB;
constexpr size_t WS_W1T = WS_SMALL + 7 * MiB;
constexpr size_t WS_BIAS1 = WS_SMALL + 9 * MiB;
constexpr size_t WS_LSE = WS_SMALL + 10 * MiB;
constexpr size_t WS_GATES = WS_SMALL + 13 * MiB;
constexpr size_t WS_ROWSQ = WS_SMALL + 16 * MiB;
constexpr size_t WS_PART = 888 * MiB;
constexpr size_t WS_END = 1016 * MiB;
static_assert(WS_WIN + (size_t)LDP * 4096 * 2 <= WS_WOUT && WS_WOUT + (size_t)4096 * 4096 * 2 <= WS_WGU && WS_WGU + (size_t)NGU * 4096 * 2 <= WS_WDN &&
              WS_WDN + (size_t)4096 * D_FF * 2 <= WS_BUFA && WS_BUFA + (size_t)T * 4096 * 2 <= WS_PROJ && WS_PROJ + (size_t)T * LDP * 2 <= WS_SMALL, "d_ws map");
constexpr int CW_TMO = 0, CW_CODE = 1, CW_Q2 = 64, CW_Q3 = 128;
constexpr int CW_BAR = 4096;

constexpr int RING_OFF = 0, RING_BYTES = 131072;
constexpr int LDSCTL_OFF = RING_BYTES, MISC_OFF = LDSCTL_OFF + 320;
constexpr int LDS_BYTES = 155648;

#define GAS __attribute__((address_space(1)))
#define LAS __attribute__((address_space(3)))
typedef unsigned short bf16;
typedef unsigned v4u __attribute__((ext_vector_type(4)));
typedef unsigned v2u __attribute__((ext_vector_type(2)));
typedef float f32x4 __attribute__((ext_vector_type(4)));
typedef short bf16x8 __attribute__((ext_vector_type(8)));
typedef GAS unsigned gu32;
#define RLX_AGENT __ATOMIC_RELAXED, __HIP_MEMORY_SCOPE_AGENT
#define LDS_WAIT() asm volatile("s_waitcnt lgkmcnt(0)" ::: "memory")
#define VM_WAIT() asm volatile("s_waitcnt vmcnt(0)" ::: "memory")
__device__ __forceinline__ unsigned f2bf(float f) { unsigned u = __builtin_bit_cast(unsigned, f); return (u + 0x7fffu + ((u >> 16) & 1u)) >> 16; }
__device__ __forceinline__ unsigned pk2(float lo, float hi) { return f2bf(lo) | (f2bf(hi) << 16); }
__device__ __forceinline__ float bf2f(bf16 v) { return __builtin_bit_cast(float, (unsigned)v << 16); }
#define XB_TMO      128
#define XB_XCNT(j)  (256  + 64 * (j))
#define XB_XSUB(j)  (1280 + 64 * (j))
#define XB_XGEN(j)  (2304 + 64 * (j))
#define XB_TOP      3328
#define XB_TOPGEN   3392
#define XCD_BAR_WORDS 3456
#define XB_SPIN_CAP (1u << 18)

__device__ __forceinline__ unsigned xb_ld(unsigned* p)              { return __hip_atomic_load(p, __ATOMIC_RELAXED, __HIP_MEMORY_SCOPE_AGENT); }
__device__ __forceinline__ unsigned xb_add(unsigned* p, unsigned v) { return __hip_atomic_fetch_add(p, v, __ATOMIC_RELAXED, __HIP_MEMORY_SCOPE_AGENT); }
__device__ __forceinline__ unsigned xb_xcc_id() { return (unsigned)__builtin_amdgcn_s_getreg((3 << 11) | 20) & 0xFu; }
#define XB_SPIN(cond, bar) do { unsigned _sp = 0; while (cond) { __builtin_amdgcn_s_sleep(1); \
    if ((++_sp & 255u) == 0u) { if (xb_ld(&(bar)[XB_TMO])) break; if (_sp > XB_SPIN_CAP) { atomicAdd(&(bar)[XB_TMO], 1u); break; } } } } while (0)

struct XcdBarrier {
    unsigned* bar; unsigned x;
    volatile LAS unsigned* st;
};

__device__ __forceinline__ XcdBarrier xcd_barrier_post(unsigned* bar, volatile LAS unsigned* st) {
    XcdBarrier b; b.bar = bar; b.x = xb_xcc_id(); b.st = st;
    if (threadIdx.x == 0) (void)xb_add(&bar[XB_XCNT(b.x)], 1u);
    return b;
}
__device__ __forceinline__ void xcd_barrier_complete(unsigned* bar, unsigned x, unsigned& nloc, unsigned& nx) {
    const unsigned G = gridDim.x * gridDim.y * gridDim.z;
    unsigned sum, cnt, mine, sp = 0u;
    for (;;) {
        sum = 0u; cnt = 0u; mine = 0u;
#pragma unroll
        for (unsigned j = 0; j < 16; ++j) { const unsigned c = xb_ld(&bar[XB_XCNT(j)]); sum += c; cnt += (c > 0u) ? 1u : 0u; mine = (j == x) ? c : mine; }
        if (sum == G) break;
        __builtin_amdgcn_s_sleep(1);
        if ((++sp & 255u) == 0u) { if (xb_ld(&bar[XB_TMO])) break; if (sp > XB_SPIN_CAP) { atomicAdd(&bar[XB_TMO], 1u); break; } }
    }
    nloc = mine > 0u ? mine : 1u; nx = cnt > 0u ? cnt : 1u;
}

__device__ __forceinline__ void xcd_barrier(const XcdBarrier& b) {
    asm volatile("s_waitcnt vmcnt(0)" ::: "memory");
    __syncthreads();
    if (threadIdx.x == 0) {
        unsigned* bar = b.bar;
        __builtin_amdgcn_s_waitcnt(0);
        unsigned nloc = b.st[0], nx = b.st[1];
        if (nloc == 0u) { xcd_barrier_complete(bar, b.x, nloc, nx); b.st[0] = nloc; b.st[1] = nx; }
        const unsigned old = xb_add(&bar[XB_XSUB(b.x)], 1u);
        const unsigned gen = old / nloc;
        if (old + 1u == (gen + 1u) * nloc) {
            __builtin_amdgcn_fence(__ATOMIC_RELEASE, "agent");
            asm volatile("s_waitcnt vmcnt(0)" ::: "memory");
            const unsigned og = xb_add(&bar[XB_TOP], 1u);
            const unsigned tg = og / nx;
            if (og + 1u == (tg + 1u) * nx) xb_add(&bar[XB_TOPGEN], 1u);
            else XB_SPIN(xb_ld(&bar[XB_TOPGEN]) == tg, bar);
            __builtin_amdgcn_fence(__ATOMIC_ACQUIRE, "agent");
            xb_add(&bar[XB_XGEN(b.x)], 1u);
            asm volatile("s_waitcnt vmcnt(0)" ::: "memory");
        } else {
            XB_SPIN(xb_ld(&bar[XB_XGEN(b.x)]) == gen, bar);
            __builtin_amdgcn_fence(__ATOMIC_ACQUIRE, "agent");
            asm volatile("s_waitcnt vmcnt(0)" ::: "memory");
        }
    }
    __syncthreads();
}
namespace att {
#ifdef MK_TPROBE
#define SECARG , sec_acc
#define SECPARM , unsigned long long& sec_acc
#define SEC_BEGIN(kind) unsigned long long sec_t; asm volatile("s_memrealtime %0\n\ts_waitcnt lgkmcnt(0)" : "=s"(sec_t) :: "memory"); int sec_n = 0; const bool sec_on = (kind) == MK_TUNIT
#define SSEC(k) do { unsigned long long t_; asm volatile("s_memrealtime %0\n\ts_waitcnt lgkmcnt(0)" : "=s"(t_) :: "memory"); if (ssec_on && MK_TSEC == (k) && wave == MK_TWAVE) *ssec_acc += t_ - ssec_t; ssec_t = t_; } while (0)
#define SSEC_PARM , unsigned long long* ssec_acc = nullptr, bool ssec_on = false
#define SSEC_ARG , &sec_acc, sec_on
#define SSEC_INIT unsigned long long ssec_t; asm volatile("s_memrealtime %0\n\ts_waitcnt lgkmcnt(0)" : "=s"(ssec_t) :: "memory")
#define SEC() do { unsigned long long t_; asm volatile("s_memrealtime %0\n\ts_waitcnt lgkmcnt(0)" : "=s"(t_) :: "memory"); if (sec_on && sec_n == MK_TSEC) sec_acc += t_ - sec_t; sec_t = t_; ++sec_n; } while (0)
#else
#define SECARG
#define SECPARM
#define SEC_BEGIN(kind) do { } while (0)
#define SEC() do { } while (0)
#define SSEC(k) do { } while (0)
#define SSEC_PARM
#define SSEC_ARG
#define SSEC_INIT do { } while (0)
#endif
typedef float f32x16 __attribute__((ext_vector_type(16)));
typedef short s16x4 __attribute__((ext_vector_type(4)));
constexpr int SHM_T = 16384;
constexpr int A_V = 0, A_K = 4 * SHM_T;
constexpr int A_KC = 0, A_VC = 4 * SHM_T;
constexpr int A_WS = 131072 + 1024;
constexpr int A_IMP = A_WS + 2048;
constexpr int A_SEL = A_IMP + 16384;
constexpr int A_END = A_SEL + 512;
constexpr float C2 = QSCALE * 1.4426950408889634f;
constexpr float THR_RAW = 8.f / QSCALE;
#define KSWZ(row, colB) ((row) * 256 + ((colB) ^ (((row) & 7) << 4)))
__device__ __forceinline__ int crow(int r, int hi) { return (r & 3) + 8 * (r >> 2) + 4 * hi; }
__device__ __forceinline__ unsigned cvtpk(float lo, float hi) { unsigned r; asm volatile("v_cvt_pk_bf16_f32 %0, %1, %2" : "=v"(r) : "v"(lo), "v"(hi)); return r; }
__device__ __forceinline__ int v_st(int k, int c) { const int kk = (k & ~0xC) | ((k & 4) << 1) | ((k & 8) >> 1); return ((kk >> 3) * 4 + (c >> 5)) * 512 + ((kk & 7) * 32 + (c & 31)) * 2; }
__device__ __forceinline__ int v_rd_base(int lane) { return ((lane & 3) << 3) | (((lane >> 2) & 3) << 6) | (((lane >> 4) & 1) << 5) | (((lane >> 5) & 1) << 8); }
constexpr int v_rd_off(int d0, int ks, int half) { return d0 * 512 + ks * 4096 + half * 2048; }
template <int OFF> __device__ __forceinline__ s16x4 tr_read(int vb) {
    s16x4 r; asm volatile("ds_read_b64_tr_b16 %0, %1 offset:%2" : "=&v"(r) : "v"(vb), "i"(OFF) : "memory"); return r;
}
struct VFrag { s16x4 l0, h0, l1, h1, l2, h2, l3, h3; };
template <int D0> __device__ __forceinline__ void v_reads(VFrag& f, int vb) {
    f.l0 = tr_read<v_rd_off(D0, 0, 0)>(vb); f.h0 = tr_read<v_rd_off(D0, 0, 1)>(vb); f.l1 = tr_read<v_rd_off(D0, 1, 0)>(vb); f.h1 = tr_read<v_rd_off(D0, 1, 1)>(vb);
    f.l2 = tr_read<v_rd_off(D0, 2, 0)>(vb); f.h2 = tr_read<v_rd_off(D0, 2, 1)>(vb); f.l3 = tr_read<v_rd_off(D0, 3, 0)>(vb); f.h3 = tr_read<v_rd_off(D0, 3, 1)>(vb);
}
#define ATT_PK(Lx, Hx) (bf16x8){Lx[0], Lx[1], Lx[2], Lx[3], Hx[0], Hx[1], Hx[2], Hx[3]}
__device__ __forceinline__ void pv_mma(f32x16& od, const VFrag& f, bf16x8 pa0, bf16x8 pa1, bf16x8 pa2, bf16x8 pa3) {
    od = __builtin_amdgcn_mfma_f32_32x32x16_bf16(pa0, ATT_PK(f.l0, f.h0), od, 0, 0, 0);
    od = __builtin_amdgcn_mfma_f32_32x32x16_bf16(pa1, ATT_PK(f.l1, f.h1), od, 0, 0, 0);
    od = __builtin_amdgcn_mfma_f32_32x32x16_bf16(pa2, ATT_PK(f.l2, f.h2), od, 0, 0, 0);
    od = __builtin_amdgcn_mfma_f32_32x32x16_bf16(pa3, ATT_PK(f.l3, f.h3), od, 0, 0, 0);
}
__device__ __forceinline__ void pv_d0(f32x16 (&o)[4], int vb, bf16x8 pa0, bf16x8 pa1, bf16x8 pa2, bf16x8 pa3) {
    VFrag fa, fb;
    v_reads<0>(fa, vb); v_reads<1>(fb, vb);
    asm volatile("s_waitcnt lgkmcnt(8)" ::: "memory"); __builtin_amdgcn_sched_barrier(0);
    __builtin_amdgcn_s_setprio(1);
    pv_mma(o[0], fa, pa0, pa1, pa2, pa3); __builtin_amdgcn_sched_barrier(0);
    v_reads<2>(fa, vb);
    asm volatile("s_waitcnt lgkmcnt(8)" ::: "memory"); __builtin_amdgcn_sched_barrier(0);
    pv_mma(o[1], fb, pa0, pa1, pa2, pa3); __builtin_amdgcn_sched_barrier(0);
    v_reads<3>(fb, vb);
    asm volatile("s_waitcnt lgkmcnt(8)" ::: "memory"); __builtin_amdgcn_sched_barrier(0);
    pv_mma(o[2], fa, pa0, pa1, pa2, pa3); __builtin_amdgcn_sched_barrier(0);
    asm volatile("s_waitcnt lgkmcnt(0)" ::: "memory"); __builtin_amdgcn_sched_barrier(0);
    pv_mma(o[3], fb, pa0, pa1, pa2, pa3);
    __builtin_amdgcn_s_setprio(0);
}
#undef ATT_PK
__device__ __forceinline__ void pv_d0_lean(f32x16 (&o)[4], int vb, bf16x8 pa0, bf16x8 pa1, bf16x8 pa2, bf16x8 pa3) {
    VFrag f;
    v_reads<0>(f, vb); asm volatile("s_waitcnt lgkmcnt(0)" ::: "memory"); __builtin_amdgcn_sched_barrier(0); pv_mma(o[0], f, pa0, pa1, pa2, pa3); __builtin_amdgcn_sched_barrier(0);
    v_reads<1>(f, vb); asm volatile("s_waitcnt lgkmcnt(0)" ::: "memory"); __builtin_amdgcn_sched_barrier(0); pv_mma(o[1], f, pa0, pa1, pa2, pa3); __builtin_amdgcn_sched_barrier(0);
    v_reads<2>(f, vb); asm volatile("s_waitcnt lgkmcnt(0)" ::: "memory"); __builtin_amdgcn_sched_barrier(0); pv_mma(o[2], f, pa0, pa1, pa2, pa3); __builtin_amdgcn_sched_barrier(0);
    v_reads<3>(f, vb); asm volatile("s_waitcnt lgkmcnt(0)" ::: "memory"); __builtin_amdgcn_sched_barrier(0); pv_mma(o[3], f, pa0, pa1, pa2, pa3);
}
#define ATT_KRD(B, d0) do { const int cb_ = ((d0) * 16 + hi * 8) * 2; B##0 = *(const LAS bf16x8*)(Ks + KSWZ(r32, cb_)); B##1 = *(const LAS bf16x8*)(Ks + KSWZ(32 + r32, cb_)); } while (0)
#define ATT_KMM(B, d0) do { p0 = __builtin_amdgcn_mfma_f32_32x32x16_bf16(B##0, qr[d0], p0, 0, 0, 0); p1 = __builtin_amdgcn_mfma_f32_32x32x16_bf16(B##1, qr[d0], p1, 0, 0, 0); } while (0)
__device__ __forceinline__ void qkt(f32x16& p0, f32x16& p1, const LAS unsigned char* Ks, const bf16x8 (&qr)[8], int r32, int hi) {
    bf16x8 a0, a1, b0, b1, c0, c1, e0, e1;
    ATT_KRD(a, 0); ATT_KRD(b, 1); ATT_KRD(c, 2); ATT_KRD(e, 3);
#pragma unroll
    for (int r = 0; r < 16; ++r) { p0[r] = 0.f; p1[r] = 0.f; }
    __builtin_amdgcn_sched_barrier(0);
    __builtin_amdgcn_s_setprio(1);
    ATT_KMM(a, 0); ATT_KMM(b, 1); __builtin_amdgcn_sched_barrier(0);
    ATT_KRD(a, 4); ATT_KRD(b, 5); __builtin_amdgcn_sched_barrier(0);
    ATT_KMM(c, 2); ATT_KMM(e, 3); __builtin_amdgcn_sched_barrier(0);
    ATT_KRD(c, 6); ATT_KRD(e, 7); __builtin_amdgcn_sched_barrier(0);
    ATT_KMM(a, 4); ATT_KMM(b, 5); __builtin_amdgcn_sched_barrier(0);
    ATT_KMM(c, 6); ATT_KMM(e, 7);
    __builtin_amdgcn_s_setprio(0);
}
#undef ATT_KRD
#undef ATT_KMM
__device__ __forceinline__ float xhalf_max(float v) { auto rr = __builtin_amdgcn_permlane32_swap(__float_as_uint(v), __float_as_uint(v), false, false); return fmaxf(__uint_as_float(rr[0]), __uint_as_float(rr[1])); }
__device__ __forceinline__ float xhalf_sum(float v) { auto rr = __builtin_amdgcn_permlane32_swap(__float_as_uint(v), __float_as_uint(v), false, false); return __uint_as_float(rr[0]) + __uint_as_float(rr[1]); }
__device__ __forceinline__ bf16x8 pks(unsigned a0, unsigned a1, unsigned b0, unsigned b1) {
    auto r0 = __builtin_amdgcn_permlane32_swap(a0, b0, false, false); auto r1 = __builtin_amdgcn_permlane32_swap(a1, b1, false, false);
    v4u w = {r0[0], r1[0], r0[1], r1[1]}; return __builtin_bit_cast(bf16x8, w);
}
__device__ __forceinline__ void softmax_tile(f32x16& p0, f32x16& p1, float& m_reg, float& l_reg, float& alpha, bf16x8& pa0, bf16x8& pa1, bf16x8& pa2, bf16x8& pa3, bool rowon = true) {
    float pmax = fmaxf(p0[0], p1[0]);
#pragma unroll
    for (int r = 1; r < 16; ++r) pmax = fmaxf(fmaxf(pmax, p0[r]), p1[r]);
    pmax = xhalf_max(pmax);
    pmax = rowon ? pmax : -INFINITY;
    float mn;
    if (__all(pmax - m_reg <= THR_RAW)) { mn = m_reg; alpha = 1.f; }
    else { mn = fmaxf(m_reg, pmax); alpha = __builtin_amdgcn_exp2f((m_reg - mn) * C2); m_reg = mn; }
    const float mnC = rowon ? -mn * C2 : -INFINITY;
    float ps = 0.f;
#pragma unroll
    for (int r = 0; r < 16; ++r) { p0[r] = __builtin_amdgcn_exp2f(fmaf(p0[r], C2, mnC)); p1[r] = __builtin_amdgcn_exp2f(fmaf(p1[r], C2, mnC)); ps += p0[r] + p1[r]; }
    ps = xhalf_sum(ps);
    l_reg = l_reg * alpha + ps;
    pa0 = pks(cvtpk(p0[0], p0[1]), cvtpk(p0[2], p0[3]), cvtpk(p0[4], p0[5]), cvtpk(p0[6], p0[7]));
    pa1 = pks(cvtpk(p0[8], p0[9]), cvtpk(p0[10], p0[11]), cvtpk(p0[12], p0[13]), cvtpk(p0[14], p0[15]));
    pa2 = pks(cvtpk(p1[0], p1[1]), cvtpk(p1[2], p1[3]), cvtpk(p1[4], p1[5]), cvtpk(p1[6], p1[7]));
    pa3 = pks(cvtpk(p1[8], p1[9]), cvtpk(p1[10], p1[11]), cvtpk(p1[12], p1[13]), cvtpk(p1[14], p1[15]));
}
struct MaskBand { int qi, W, amin, amax;
    __device__ __forceinline__ bool interior(int t) const { return (t * 64 + 63 <= amin) && (t * 64 >= amax - W); }
    __device__ __forceinline__ bool rowon(int) const { return true; }
    __device__ __forceinline__ void operator()(f32x16& p0, f32x16& p1, int t, int hi) const {
        const int kb = t * 64 + 4 * hi;
#pragma unroll
        for (int r = 0; r < 16; ++r) { const int k = kb + (r & 3) + 8 * (r >> 2);
            p0[r] = ((unsigned)(qi - k) <= (unsigned)W) ? p0[r] : -INFINITY; p1[r] = ((unsigned)(qi - k - 32) <= (unsigned)W) ? p1[r] : -INFINITY; }
    } };
struct NeedBand { int a, W;
    __device__ __forceinline__ bool operator()(int t) const { return (t * 64 + 63 >= a - W) && (t * 64 <= a + 31); } };
struct NeedAll { __device__ __forceinline__ bool operator()(int) const { return true; } };
struct MaskSel { unsigned mlo, mhi; int s, qb;
    __device__ __forceinline__ bool interior(int t) const { return t < qb; }
    __device__ __forceinline__ bool rowon(int t) const { return t >= qb || ((t < 32 ? (mlo >> t) : (mhi >> (t - 32))) & 1u) != 0u; }
    __device__ __forceinline__ void operator()(f32x16& p0, f32x16& p1, int t, int hi) const {
        const bool bit = ((t < 32 ? (mlo >> t) : (mhi >> (t - 32))) & 1u) != 0u;
        const int lim = (bit ? s : -1) - (t * 64 + 4 * hi);
#pragma unroll
        for (int r = 0; r < 16; ++r) { const int c = (r & 3) + 8 * (r >> 2);
            p0[r] = (c <= lim) ? p0[r] : -INFINITY; p1[r] = (c + 32 <= lim) ? p1[r] : -INFINITY; }
    } };
struct NeedSel { unsigned mlo, mhi;
    __device__ __forceinline__ bool operator()(int t) const { const bool bit = ((t < 32 ? (mlo >> t) : (mhi >> (t - 32))) & 1u) != 0u; return __any(bit) != 0; } };

struct NoPre { __device__ __forceinline__ void operator()() const {} };
template <class Mask, class Need, int PRE = 0, class Pre = NoPre>
__device__ __forceinline__ void attn_stream(LAS unsigned char* L, const bf16* Kg, const bf16* Vg, size_t stride, int t_lo, int t_hi, const bf16x8 (&qr)[8],
                                            const Mask& mask, const Need& need, f32x16 (&o)[4], float& m_reg, float& l_reg, int tid, int lane, int wave, const Pre& pre = Pre() SSEC_PARM) {
    SSEC_INIT;
    asm volatile("" : "+v"(tid), "+v"(lane));
    const bool late = wave >= 4;
    const bf16* kp; const bf16* vp;
    { const int krow = 4 * wave + (lane >> 4), kch = (lane & 15) ^ (krow & 7);
      const int vsub = 2 * wave + (lane >> 5), vkk = 8 * (vsub >> 2) + ((lane & 31) >> 2), vk = (vkk & ~0xC) | ((vkk & 4) << 1) | ((vkk & 8) >> 1);
      kp = Kg + ((size_t)t_lo * 64 + krow) * stride + kch * 8;
      vp = Vg + ((size_t)t_lo * 64 + vk) * stride + (vsub & 3) * 32 + (lane & 3) * 8; }
    const size_t s32 = 32 * stride, s64 = 64 * stride;
#define ATT_DMA(kslot, vslot) do { \
        __builtin_amdgcn_global_load_lds((const unsigned*)kp, (LAS unsigned*)(L + A_K + (kslot) * SHM_T + wave * 1024), 16, 0, 0); \
        __builtin_amdgcn_global_load_lds((const unsigned*)(kp + s32), (LAS unsigned*)(L + A_K + (kslot) * SHM_T + 8192 + wave * 1024), 16, 0, 0); \
        __builtin_amdgcn_global_load_lds((const unsigned*)vp, (LAS unsigned*)(L + A_V + (vslot) * SHM_T + wave * 1024), 16, 0, 0); \
        __builtin_amdgcn_global_load_lds((const unsigned*)(vp + s32), (LAS unsigned*)(L + A_V + (vslot) * SHM_T + 8192 + wave * 1024), 16, 0, 0); \
        kp += s64; vp += s64; } while (0)
#define ATT_RESC() do { if (__any(alpha < 1.f)) { if (hi == 0) al_l[r32] = alpha; asm volatile("s_waitcnt lgkmcnt(0)" ::: "memory"); \
        _Pragma("unroll") for (int d = 0; d < 4; ++d) _Pragma("unroll") for (int r = 0; r < 16; ++r) o[d][r] *= al_l[crow(r, hi)]; } } while (0)
    ATT_DMA(0, 0);
    if (t_lo + 1 < t_hi) ATT_DMA(1, 1);
    pre();
    asm volatile("" : "+v"(lane));
    const int r32 = lane & 31, hi = lane >> 5;
    LAS float* al_l = (LAS float*)(L + A_WS + wave * 256) + 32;
    const int vb0 = (int)(unsigned)(uintptr_t)(L + A_V) + v_rd_base(lane);
    int ks = 0, vs = 0, vsp = 0; bool pend = false;
    bf16x8 pa0, pa1, pa2, pa3;
    for (int t = t_lo; t < t_hi; ++t) {
        if (PRE > 0 && t - t_lo < 2 && t + 1 < t_hi) asm volatile("s_waitcnt vmcnt(%0)" :: "n"(4 + PRE) : "memory");
        else if (t + 1 < t_hi) asm volatile("s_waitcnt vmcnt(4)" ::: "memory"); else asm volatile("s_waitcnt vmcnt(0)" ::: "memory");
        __builtin_amdgcn_s_barrier();
        asm volatile("" ::: "memory");
        SSEC(10);
        if (t + 2 < t_hi) { const int k2 = ks >= 1 ? ks - 1 : 2, v2 = vs >= 2 ? vs - 2 : vs + 2; ATT_DMA(k2, v2); }
        SSEC(11);
        if (pend) { pv_d0(o, vb0 + vsp * SHM_T, pa0, pa1, pa2, pa3); pend = false; }
        SSEC(12);
        if (need(t)) {
            f32x16 p0, p1; qkt(p0, p1, L + A_K + ks * SHM_T, qr, r32, hi);
            SSEC(13);
            if (!mask.interior(t)) mask(p0, p1, t, hi);
            float alpha;
            softmax_tile(p0, p1, m_reg, l_reg, alpha, pa0, pa1, pa2, pa3, mask.rowon(t));
            ATT_RESC();
            SSEC(14);
            if (late) { pend = true; vsp = vs; }
            else pv_d0(o, vb0 + vs * SHM_T, pa0, pa1, pa2, pa3);
        }
        SSEC(15);
        ks = ks == 2 ? 0 : ks + 1; vs = (vs + 1) & 3;
    }
    if (pend) pv_d0(o, vb0 + vsp * SHM_T, pa0, pa1, pa2, pa3);
#undef ATT_DMA
#undef ATT_RESC
    asm volatile("s_waitcnt lgkmcnt(0)" ::: "memory");
    __builtin_amdgcn_s_barrier();
}
__device__ __forceinline__ int st_img(int wave) { return wave < 4 ? 2 * SHM_T + wave * 8192 : A_K + 2 * SHM_T + (wave - 4) * 8192; }
constexpr int ST_VMOPS = 8;
template <class RowPtr>
__device__ __forceinline__ void store_tile(LAS unsigned char* L, const f32x16 (&o)[4], const LAS float* sc_l, const RowPtr& rowptr, int lane, int wave) {
    const int r32 = lane & 31, hi = lane >> 5, odd = lane & 1;
    LAS unsigned char* img = L + st_img(wave);
#pragma unroll
    for (int rp = 0; rp < 8; ++rp) {
        const int r = 2 * rp;
        const float s0 = sc_l[crow(r, hi)], s1 = sc_l[crow(r + 1, hi)];
        const int row = crow(r + odd, hi);
#pragma unroll
        for (int d0 = 0; d0 < 4; ++d0) {
            const float a = o[d0][r] * s0, b = o[d0][r + 1] * s1;
            const float send = odd ? a : b;
            const float recv = __uint_as_float((unsigned)__builtin_amdgcn_mov_dpp((int)__float_as_uint(send), 0xB1, 0xF, 0xF, true));
            const unsigned w = cvtpk(odd ? recv : a, odd ? b : recv);
            *(LAS unsigned*)(img + row * 256 + (((32 * d0 + (r32 & ~1)) * 2) ^ ((row & 7) << 4))) = w;
        }
    }
    asm volatile("s_waitcnt lgkmcnt(0)" ::: "memory");
#pragma unroll
    for (int i = 0; i < 8; ++i) {
        const int row = 4 * i + (lane >> 4), ch = lane & 15;
        const v4u v = *(const LAS v4u*)(img + row * 256 + ((ch * 16) ^ ((row & 7) << 4)));
        *(v4u*)(rowptr(row) + ch * 8) = v;
    }
}
constexpr int STD_VMOPS = 32;
template <class RowPtr>
__device__ __forceinline__ void store_tile_direct(const f32x16 (&o)[4], const LAS float* sc_l, const RowPtr& rowptr, int lane) {
    const int r32 = lane & 31, hi = lane >> 5, odd = lane & 1;
#pragma unroll
    for (int rp = 0; rp < 8; ++rp) {
        const int r = 2 * rp;
        const float s0 = sc_l[crow(r, hi)], s1 = sc_l[crow(r + 1, hi)];
        bf16* prow = rowptr(crow(r + odd, hi)) + (r32 & ~1);
#pragma unroll
        for (int d0 = 0; d0 < 4; ++d0) {
            const float a = o[d0][r] * s0, b = o[d0][r + 1] * s1;
            const float send = odd ? a : b;
            const float recv = __uint_as_float((unsigned)__builtin_amdgcn_mov_dpp((int)__float_as_uint(send), 0xB1, 0xF, 0xF, true));
            *(unsigned*)(prow + 32 * d0) = cvtpk(odd ? recv : a, odd ? b : recv);
        }
    }
}
__device__ __forceinline__ float sigmoidf_(float v) { return 1.f / (1.f + __expf(-v)); }

__device__ __forceinline__ void dilated_unit(LAS unsigned char* L, const bf16* proj, bf16* outA, float* lse, int u, int tid, int lane, int wave SECPARM) {
    SEC_BEGIN(0);
    const int r32 = lane & 31, hi = lane >> 5;
    const int cfg = u >> 10, r = u & 1023, sh = 2 * cfg, dil = 1 << sh;
    const int b = r >> 8, h = (r >> 4) & 15, rb = r & 15, res = rb & (dil - 1), blk = rb >> sh;
    const int i0 = blk * 256, a = i0 + 32 * wave, qi = a + r32;
    const bf16* base = proj + (size_t)(b * SEQ + res) * LDP + h * 128;
    const size_t stride = (size_t)dil * LDP;
    const bf16* qrow = base + OFF_QA + (size_t)qi * stride + hi * 8;
    bf16x8 qr[8];
#pragma unroll
    for (int d0 = 0; d0 < 8; ++d0) qr[d0] = *(const bf16x8*)(qrow + d0 * 16);
    f32x16 o[4];
#pragma unroll
    for (int d = 0; d < 4; ++d)
#pragma unroll
        for (int e = 0; e < 16; ++e) o[d][e] = 0.f;
    float m_reg = -1e30f, l_reg = 0.f;
    const int t_lo = (i0 >= 128) ? (i0 - 128) >> 6 : 0, t_hi = (i0 >> 6) + 4;
    SEC();
    attn_stream(L, base + OFF_KA, base + OFF_VA, stride, t_lo, t_hi, qr, MaskBand{qi, 128, a, a + 31}, NeedBand{a, 128}, o, m_reg, l_reg, tid, lane, wave, NoPre() SSEC_ARG);
    SEC();
    LAS float* sc_l = (LAS float*)(L + A_WS + wave * 256);
    const int tok = qi * dil + res;
    if (hi == 0) { sc_l[r32] = 1.f / l_reg; lse[((size_t)cfg * T + (size_t)b * SEQ + tok) * 16 + h] = m_reg * QSCALE + __logf(l_reg); }
    asm volatile("s_waitcnt lgkmcnt(0)" ::: "memory");
    bf16* obase = outA + (size_t)cfg * T * 2048 + (size_t)(b * SEQ + res) * 2048 + h * 128;
    const size_t ostride = (size_t)dil * 2048;
    store_tile(L, o, sc_l, [&](int row) { return obase + (size_t)(a + row) * ostride; }, lane, wave);
    SEC();
}
__device__ __forceinline__ void window_unit(LAS unsigned char* L, const bf16* proj, bf16* outB, int u, int tid, int lane, int wave SECPARM) {
    SEC_BEGIN(1);
    const int r32 = lane & 31, hi = lane >> 5;
    const int b = u >> 8, g = (u >> 6) & 3, qb = u & 63, q0 = qb * 64;
    const int head = r32 >> 3, s = q0 + 8 * wave + (r32 & 7);
    const bf16* prow = proj + (size_t)(b * SEQ + s) * LDP;
    const bf16* qrow = prow + OFF_QB + (g * 4 + head) * 128 + hi * 8;
    bf16x8 qr[8];
#pragma unroll
    for (int d0 = 0; d0 < 8; ++d0) qr[d0] = *(const bf16x8*)(qrow + d0 * 16);
    f32x16 o[4];
#pragma unroll
    for (int d = 0; d < 4; ++d)
#pragma unroll
        for (int e = 0; e < 16; ++e) o[d][e] = 0.f;
    float m_reg = -1e30f, l_reg = 0.f;
    const bf16* kvb = proj + (size_t)(b * SEQ) * LDP + g * 128;
    attn_stream(L, kvb + OFF_KW, kvb + OFF_VW, (size_t)LDP, qb >= 8 ? qb - 8 : 0, qb + 1, qr, MaskBand{s, WIN - 1, q0 + 8 * wave, q0 + 8 * wave + 7}, NeedAll{}, o, m_reg, l_reg, tid, lane, wave);
    LAS float* sc_l = (LAS float*)(L + A_WS + wave * 256);
    if (hi == 0) sc_l[r32] = 1.f / l_reg;
    asm volatile("s_waitcnt lgkmcnt(0)" ::: "memory");
    bf16* obase = outB + (size_t)(b * SEQ + q0 + 8 * wave) * 2048 + g * 512;
    store_tile(L, o, sc_l, [&](int row) { return obase + (size_t)(row & 7) * 2048 + (row >> 3) * 128; }, lane, wave);
}
__device__ __forceinline__ bf16x8 hfrag(int c0, int j) {
    bf16x8 f; const int d = c0 - 4 * j;
#pragma unroll
    for (int jj = 0; jj < 8; ++jj) f[jj] = ((unsigned)(d + jj + 1) <= 4u) ? (short)0x3F80 : (short)0;
    return f;
}
__device__ __forceinline__ void nsa_unit(LAS unsigned char* L, const bf16* proj, const bf16* kc, const bf16* vc, bf16* outC, bf16* outS, int b, int g, int qb, int tid, int lane, int wave SECPARM) {
    SEC_BEGIN(2);
    asm volatile("" : "+v"(tid), "+v"(lane));
    const int r32 = lane & 31, hi = lane >> 5;
    const int q0 = qb * 64, head = r32 >> 3, s = q0 + 8 * wave + (r32 & 7);
    const bf16* prow = proj + (size_t)(b * SEQ + s) * LDP;
    const bf16* qrow = prow + OFF_QB + (g * 4 + head) * 128 + hi * 8;
    bf16x8 qr[8];
#pragma unroll
    for (int d0 = 0; d0 < 8; ++d0) qr[d0] = *(const bf16x8*)(qrow + d0 * 16);
    const int ntc = (qb >> 4) + 1;
    {
        int tid_ = tid; asm volatile("" : "+v"(tid_));
        const int sr = tid_ >> 4, sc = (tid_ & 15) * 8;
        const bf16* kcb = kc + (size_t)(b * GB + g) * 256 * 128 + (size_t)sr * 128 + sc; const bf16* vcb = vc + (size_t)(b * GB + g) * 256 * 128 + (size_t)sr * 128 + sc;
#pragma unroll
        for (int tc = 0; tc < 4; ++tc) if (tc < ntc) {
            const bf16x8 k0 = *(const bf16x8*)(kcb + tc * 8192), k1 = *(const bf16x8*)(kcb + tc * 8192 + 4096), v0 = *(const bf16x8*)(vcb + tc * 8192), v1 = *(const bf16x8*)(vcb + tc * 8192 + 4096);
            *(LAS bf16x8*)(L + A_KC + tc * SHM_T + KSWZ(sr, sc * 2)) = k0; *(LAS bf16x8*)(L + A_KC + tc * SHM_T + KSWZ(32 + sr, sc * 2)) = k1;
            *(LAS bf16x8*)(L + A_VC + tc * SHM_T + v_st(sr, sc)) = v0; *(LAS bf16x8*)(L + A_VC + tc * SHM_T + v_st(32 + sr, sc)) = v1;
        }
    }
    __syncthreads();
    LAS float* impw = (LAS float*)(L + A_IMP) + wave * 512;
    LAS float* sc_l = (LAS float*)(L + A_WS + wave * 256);
    f32x16 o[4];
#pragma unroll
    for (int e = 0; e < 16; ++e) { o[0][e] = 0.f; o[1][e] = 0.f; o[2][e] = 0.f; o[3][e] = 0.f; }
    float m = -1e30f, l = 0.f;
    f32x16 imp0, imp1;
#pragma unroll
    for (int e = 0; e < 16; ++e) { imp0[e] = 0.f; imp1[e] = 0.f; }
    {
        const int vbc = (int)(unsigned)(uintptr_t)(L + A_VC) + v_rd_base(lane);
        LAS float* al_c = (LAS float*)(L + A_WS + wave * 256) + 32;
#pragma unroll 1
        for (int tc = 0; tc < ntc; ++tc) {
            f32x16 p0, p1; qkt(p0, p1, L + A_KC + tc * SHM_T, qr, r32, hi);
            const int lim = ((s - 31) >> 4) - (tc * 64 + 4 * hi);
#pragma unroll
            for (int r = 0; r < 16; ++r) { const int cc = (r & 3) + 8 * (r >> 2);
                p0[r] = (cc <= lim) ? p0[r] : -INFINITY; p1[r] = (cc + 32 <= lim) ? p1[r] : -INFINITY; }
            float alpha; bf16x8 pa0, pa1, pa2, pa3;
            softmax_tile(p0, p1, m, l, alpha, pa0, pa1, pa2, pa3);
            if (__any(alpha < 1.f)) { if (hi == 0) al_c[r32] = alpha; asm volatile("s_waitcnt lgkmcnt(0)" ::: "memory");
#pragma unroll
                for (int d = 0; d < 4; ++d)
#pragma unroll
                    for (int r = 0; r < 16; ++r) o[d][r] *= al_c[crow(r, hi)];
#pragma unroll
                for (int r = 0; r < 16; ++r) { imp0[r] *= al_c[crow(r, hi)]; imp1[r] *= al_c[crow(r, hi)]; } }
            pv_d0_lean(o, vbc + tc * SHM_T, pa0, pa1, pa2, pa3);
            { int jv = r32; asm volatile("" : "+v"(jv));
              const int c0 = tc * 64 + 8 * hi;
              if (tc <= 1) { imp0 = __builtin_amdgcn_mfma_f32_32x32x16_bf16(pa0, hfrag(c0, jv), imp0, 0, 0, 0); imp0 = __builtin_amdgcn_mfma_f32_32x32x16_bf16(pa1, hfrag(c0 + 16, jv), imp0, 0, 0, 0);
                             imp0 = __builtin_amdgcn_mfma_f32_32x32x16_bf16(pa2, hfrag(c0 + 32, jv), imp0, 0, 0, 0); imp0 = __builtin_amdgcn_mfma_f32_32x32x16_bf16(pa3, hfrag(c0 + 48, jv), imp0, 0, 0, 0); }
              if (tc >= 1) { imp1 = __builtin_amdgcn_mfma_f32_32x32x16_bf16(pa0, hfrag(c0, 32 + jv), imp1, 0, 0, 0); imp1 = __builtin_amdgcn_mfma_f32_32x32x16_bf16(pa1, hfrag(c0 + 16, 32 + jv), imp1, 0, 0, 0);
                             imp1 = __builtin_amdgcn_mfma_f32_32x32x16_bf16(pa2, hfrag(c0 + 32, 32 + jv), imp1, 0, 0, 0); imp1 = __builtin_amdgcn_mfma_f32_32x32x16_bf16(pa3, hfrag(c0 + 48, 32 + jv), imp1, 0, 0, 0); } }
        }
    }
    const float inv_l = l > 0.f ? 1.f / l : 0.f, mC = -m * C2;
    SEC();
    {
        LAS float* il_c = (LAS float*)(L + A_WS + wave * 256);
        if (hi == 0) il_c[r32] = inv_l;
        asm volatile("s_waitcnt lgkmcnt(0)" ::: "memory");
        LAS float* impw0 = (LAS float*)(L + A_IMP) + wave * 512;
#pragma unroll
        for (int e = 0; e < 4; ++e) {
            const float i0 = il_c[crow(e, hi)], i1 = il_c[crow(4 + e, hi)], i2 = il_c[crow(8 + e, hi)], i3 = il_c[crow(12 + e, hi)];
            impw0[(e + 4 * hi) * 64 + r32] = (imp0[e] * i0 + imp0[4 + e] * i1) + (imp0[8 + e] * i2 + imp0[12 + e] * i3);
            impw0[(e + 4 * hi) * 64 + 32 + r32] = (imp1[e] * i0 + imp1[4 + e] * i1) + (imp1[8 + e] * i2 + imp1[12 + e] * i3);
        }
        asm volatile("s_waitcnt lgkmcnt(0)" ::: "memory");
    }
    SEC();
    LAS unsigned* selw = (LAS unsigned*)(L + A_SEL) + wave * 16;
    {
        unsigned key[8], T[8];
#pragma unroll
        for (int qi = 0; qi < 8; ++qi) {
            const int sq = q0 + 8 * wave + qi, j = lane;
            const float iv = impw[qi * 64 + lane];
            const bool forced = (j == 0) || (j == qb) || (j == qb - 1);
            const bool valid = (j * 64 <= sq);
            const float score = forced ? 1e6f : (valid ? iv : -INFINITY);
            key[qi] = (score == -INFINITY) ? 0u : (__float_as_uint(fmaxf(score, 0.f)) + 1u); T[qi] = 0u;
        }
#define SEL_LEVEL4(A, BIT) do { unsigned c0_, c1_, c2_, c3_, n0_, n1_, n2_, n3_; unsigned long long m0_, m1_, m2_, m3_; \
            asm volatile("s_or_b32 %4, %0, %16\n\ts_or_b32 %5, %1, %16\n\ts_or_b32 %6, %2, %16\n\ts_or_b32 %7, %3, %16\n\t" \
                         "v_cmp_le_u32_e64 %8, %4, %17\n\tv_cmp_le_u32_e64 %9, %5, %18\n\tv_cmp_le_u32_e64 %10, %6, %19\n\tv_cmp_le_u32_e64 %11, %7, %20\n\t" \
                         "s_bcnt1_i32_b64 %12, %8\n\ts_bcnt1_i32_b64 %13, %9\n\ts_bcnt1_i32_b64 %14, %10\n\ts_bcnt1_i32_b64 %15, %11\n\t" \
                         "s_cmp_ge_u32 %12, 16\n\ts_cselect_b32 %0, %4, %0\n\ts_cmp_ge_u32 %13, 16\n\ts_cselect_b32 %1, %5, %1\n\t" \
                         "s_cmp_ge_u32 %14, 16\n\ts_cselect_b32 %2, %6, %2\n\ts_cmp_ge_u32 %15, 16\n\ts_cselect_b32 %3, %7, %3" \
                         : "+s"(T[A]), "+s"(T[A + 1]), "+s"(T[A + 2]), "+s"(T[A + 3]), "=&s"(c0_), "=&s"(c1_), "=&s"(c2_), "=&s"(c3_), \
                           "=&s"(m0_), "=&s"(m1_), "=&s"(m2_), "=&s"(m3_), "=&s"(n0_), "=&s"(n1_), "=&s"(n2_), "=&s"(n3_) \
                         : "n"(BIT), "v"(key[A]), "v"(key[A + 1]), "v"(key[A + 2]), "v"(key[A + 3]) : "scc"); } while (0)
        static_assert(NSEL == 16, "the level macro compares the count with 16");
#pragma unroll
        for (int bb = 30; bb >= 0; --bb) { SEL_LEVEL4(0, 1u << bb); SEL_LEVEL4(4, 1u << bb); }
#undef SEL_LEVEL4
#pragma unroll
        for (int qi = 0; qi < 8; ++qi) {
            const unsigned long long gt = __ballot(key[qi] > T[qi]), eq = __ballot(key[qi] == T[qi]);
            const int need = NSEL - (int)__popcll(gt);
            const int below = (int)__builtin_amdgcn_mbcnt_hi((unsigned)(eq >> 32), __builtin_amdgcn_mbcnt_lo((unsigned)eq, 0u));
            const bool sel = (key[qi] > T[qi]) || (key[qi] == T[qi] && T[qi] != 0u && below < need);
            const unsigned long long mk = __ballot(sel);
            if (lane == 0) { selw[2 * qi] = (unsigned)mk; selw[2 * qi + 1] = (unsigned)(mk >> 32); }
        }
    }
    asm volatile("s_waitcnt lgkmcnt(0)" ::: "memory");
    const unsigned mlo = selw[2 * (r32 & 7)], mhi = selw[2 * (r32 & 7) + 1];
    SEC();
    SEC();
    asm volatile("s_waitcnt lgkmcnt(0)" ::: "memory");
    __builtin_amdgcn_s_barrier();
    asm volatile("" ::: "memory");
    float m_reg = -1e30f, l_reg = 0.f;
    const bf16* kvb = proj + (size_t)(b * SEQ) * LDP + g * 128;
    bf16* obaseC = outC + (size_t)(b * SEQ + q0 + 8 * wave) * 2048 + g * 512;
    auto pre = [&]() {
        if (hi == 0) sc_l[r32] = inv_l;
        asm volatile("s_waitcnt lgkmcnt(0)" ::: "memory");
        store_tile_direct(o, sc_l, [&](int row) { return obaseC + (size_t)(row & 7) * 2048 + (row >> 3) * 128; }, lane);
#pragma unroll
        for (int d = 0; d < 4; ++d)
#pragma unroll
            for (int e = 0; e < 16; ++e) o[d][e] = 0.f;
    };
    attn_stream<MaskSel, NeedAll, STD_VMOPS>(L, kvb + OFF_KS, kvb + OFF_VS, (size_t)LDP, 0, qb + 1, qr, MaskSel{mlo, mhi, s, qb}, NeedAll{}, o, m_reg, l_reg, tid, lane, wave, pre SSEC_ARG);
    SEC();
    if (hi == 0) sc_l[r32] = 1.f / l_reg;
    asm volatile("s_waitcnt lgkmcnt(0)" ::: "memory");
    {
        bf16* obase = outS + (size_t)(b * SEQ + q0 + 8 * wave) * 2048 + g * 512;
        store_tile_direct(o, sc_l, [&](int row) { return obase + (size_t)(row & 7) * 2048 + (row >> 3) * 128; }, lane);
    }
#ifdef MK_DUMMY_STREAM
    SEC();
    {
#pragma unroll
        for (int d = 0; d < 4; ++d)
#pragma unroll
            for (int e = 0; e < 16; ++e) o[d][e] = 0.f;
        float m2 = -1e30f, l2 = 0.f;
        attn_stream(L, kvb + OFF_KS, kvb + OFF_VS, (size_t)0, 0, qb + 1, qr, MaskSel{mlo, mhi, s, qb}, NeedAll{}, o, m2, l2, tid, lane, wave);
        asm volatile("" :: "v"(o[0][0]), "v"(o[1][0]), "v"(o[2][0]), "v"(o[3][0]), "v"(l2));
    }
    SEC();
#else
    SEC();
#endif
}
template <int AR, int BR, class APtr, class BPtr>
__device__ __forceinline__ void skinny_gemm(LAS unsigned char* L, int NS, const APtr& aptr, const BPtr& bptr, f32x16 (&acc)[(AR / 32) * (BR / 32)], int lane, int wave) {
    constexpr int ROWS = AR + BR, CHB = ROWS * 128, STB = 2 * CHB, NG = ROWS / 8, NIW = 2 * NG / 8;
    static_assert((2 * NG) % 8 == 0 && 3 * STB <= 131072, "stage geometry");
    asm volatile("" : "+v"(lane));
    const int lr = lane >> 3, cs = ((lane & 7) ^ lr) * 8;
#define SG_DMA(s_, bufoff_) do { _Pragma("unroll") for (int i_ = 0; i_ < NIW; ++i_) { const int j_ = wave + 8 * i_, q_ = j_ / NG, rg_ = j_ % NG, kc_ = 2 * (s_) + q_; \
        const bf16* src_ = (rg_ < AR / 8) ? aptr(8 * rg_ + lr, kc_) : bptr(8 * rg_ + lr - AR, kc_); \
        __builtin_amdgcn_global_load_lds((const unsigned*)(src_ + cs), (LAS unsigned*)(L + (bufoff_) + q_ * CHB + rg_ * 1024), 16, 0, 0); } } while (0)
    SG_DMA(0, 0);
    SG_DMA(1, STB);
    const int r32 = lane & 31, hi = lane >> 5;
    const int rd = (wave >> 2) * CHB + r32 * 128 + (((2 * (wave & 3) + hi) ^ (r32 & 7)) * 16);
    int cur = 0, nxt2 = 2 * STB;
#pragma unroll 1
    for (int s = 0; s < NS; ++s) {
        if (s + 1 < NS) asm volatile("s_waitcnt vmcnt(%0)" :: "n"(NIW) : "memory"); else asm volatile("s_waitcnt vmcnt(0)" ::: "memory");
        __builtin_amdgcn_s_barrier();
        asm volatile("" ::: "memory");
        if (s + 2 < NS) SG_DMA(s + 2, nxt2);
        const LAS unsigned char* cb = L + cur + rd;
        bf16x8 af[AR / 32], bfr[BR / 32];
#pragma unroll
        for (int i = 0; i < AR / 32; ++i) af[i] = *(const LAS bf16x8*)(cb + i * 4096);
#pragma unroll
        for (int j = 0; j < BR / 32; ++j) bfr[j] = *(const LAS bf16x8*)(cb + AR * 128 + j * 4096);
#pragma unroll
        for (int i = 0; i < AR / 32; ++i)
#pragma unroll
            for (int j = 0; j < BR / 32; ++j) acc[i * (BR / 32) + j] = __builtin_amdgcn_mfma_f32_32x32x16_bf16(af[i], bfr[j], acc[i * (BR / 32) + j], 0, 0, 0);
        nxt2 = cur; cur = cur + STB; cur = cur == 3 * STB ? 0 : cur;
    }
#undef SG_DMA
    asm volatile("s_waitcnt lgkmcnt(0)" ::: "memory");
    __builtin_amdgcn_s_barrier();
    asm volatile("" ::: "memory");
}
struct CmpA { const bf16* base; int tok0;
    __device__ __forceinline__ const bf16* operator()(int r, int kc) const { int tok = tok0 + 16 * r + (kc >> 1); tok = tok < SEQ ? tok : SEQ - 1; return base + (size_t)tok * LDP + (kc & 1) * 64; } };
struct RowK { const bf16* base; size_t ld;
    __device__ __forceinline__ const bf16* operator()(int r, int kc) const { return base + (size_t)r * ld + kc * 64; } };
__device__ __forceinline__ void compress_unit(LAS unsigned char* L, const bf16* proj, int coloff, const bf16* W1T, const float* bias1, const float* w2, bf16* outkc,
                                              int b, int g, int cblk, int tid, int lane, int wave) {
    const int r32 = lane & 31, hi = lane >> 5;
    f32x16 acc[4];
#pragma unroll
    for (int j = 0; j < 4; ++j)
#pragma unroll
        for (int e = 0; e < 16; ++e) acc[j][e] = 0.f;
    skinny_gemm<32, 128>(L, 32, CmpA{proj + (size_t)(b * SEQ) * LDP + coloff + g * 128, 16 * 32 * cblk}, RowK{W1T, 4096}, acc, lane, wave);
#if defined(MK_CMP2X) && MK_CMP2X == 1
    { f32x16 acc2[4];
#pragma unroll
      for (int j = 0; j < 4; ++j)
#pragma unroll
          for (int e = 0; e < 16; ++e) acc2[j][e] = 0.f;
      skinny_gemm<32, 128>(L, 32, CmpA{proj + (size_t)(b * SEQ) * LDP + coloff + g * 128, 16 * 32 * cblk}, RowK{W1T, 4096}, acc2, lane, wave);
      asm volatile("" :: "v"(acc2[0][0]), "v"(acc2[1][0]), "v"(acc2[2][0]), "v"(acc2[3][0])); }
#endif
#if defined(MK_CMP2X) && MK_CMP2X == 2
#pragma unroll 1
    for (int rep_ = 0; rep_ < 2; ++rep_) {
#else
    {
#endif
    LAS float* part = (LAS float*)L + wave * 4096;
    const int j2 = tid & 127, cg = tid >> 7;
#pragma unroll
    for (int j = 0; j < 4; ++j)
#pragma unroll
        for (int r = 0; r < 16; ++r) part[crow(r, hi) * 128 + 32 * j + r32] = acc[j][r];
    __syncthreads();
    f32x4 wv[8];
#pragma unroll
    for (int i = 0; i < 8; ++i) wv[i] = *(const f32x4*)(w2 + 4 * (tid + 512 * i));
    float hv[8];
#pragma unroll
    for (int i = 0; i < 8; ++i) { const int e = tid + 512 * i; const LAS float* pp = (const LAS float*)L + e;
        const float v = (((pp[0] + pp[4096]) + (pp[2 * 4096] + pp[3 * 4096])) + ((pp[4 * 4096] + pp[5 * 4096]) + (pp[6 * 4096] + pp[7 * 4096])))
                      + (((bias1[e & 127] + bias1[256 + (e & 127)]) + (bias1[512 + (e & 127)] + bias1[768 + (e & 127)])) + ((bias1[1024 + (e & 127)] + bias1[1280 + (e & 127)]) + (bias1[1536 + (e & 127)] + bias1[1792 + (e & 127)])));
        const float uu = 0.7978845608028654f * (v + 0.044715f * v * v * v); hv[i] = 0.5f * v * (1.f + tanhf(uu)); }
    __syncthreads();
    LAS float* hid = (LAS float*)L;
#pragma unroll
    for (int i = 0; i < 8; ++i) hid[tid + 512 * i] = hv[i];
    LAS float* w2s = (LAS float*)L + 16384;
#pragma unroll
    for (int i = 0; i < 8; ++i) *(LAS f32x4*)(w2s + 4 * (tid + 512 * i)) = wv[i];
    __syncthreads();
    float oacc[8];
#pragma unroll
    for (int k = 0; k < 8; ++k) oacc[k] = 0.f;
#pragma unroll 4
    for (int j4 = 0; j4 < 32; ++j4) {
        const float w0 = w2s[(4 * j4) * 128 + j2], w1 = w2s[(4 * j4 + 1) * 128 + j2], w2_ = w2s[(4 * j4 + 2) * 128 + j2], w3 = w2s[(4 * j4 + 3) * 128 + j2];
#pragma unroll
        for (int k = 0; k < 8; ++k) { const f32x4 h4 = *(const LAS f32x4*)(hid + (cg * 8 + k) * 128 + 4 * j4);
            oacc[k] += (h4[0] * w0 + h4[1] * w1) + (h4[2] * w2_ + h4[3] * w3); } }
#pragma unroll
    for (int k = 0; k < 8; ++k) { const int c = 32 * cblk + cg * 8 + k; outkc[((size_t)(b * GB + g) * 256 + c) * 128 + j2] = (c < NC) ? (bf16)f2bf(oacc[k]) : (bf16)0; }
    __syncthreads();
    }
}
__device__ __forceinline__ void gate_unit(LAS unsigned char* L, const bf16* h, const bf16* Wg, const float* rowsq0, float* gates, int row0, int tid, int lane, int wave) {
    const int r32 = lane & 31, hi = lane >> 5;
    f32x16 acc[4];
#pragma unroll
    for (int j = 0; j < 4; ++j)
#pragma unroll
        for (int e = 0; e < 16; ++e) acc[j][e] = 0.f;
    skinny_gemm<64, 64>(L, 32, RowK{h + (size_t)row0 * D_MODEL, (size_t)D_MODEL}, RowK{Wg, (size_t)D_MODEL}, acc, lane, wave);
    LAS float* part = (LAS float*)L + wave * 4096;
#pragma unroll
    for (int i = 0; i < 2; ++i)
#pragma unroll
        for (int j = 0; j < 2; ++j)
#pragma unroll
            for (int r = 0; r < 16; ++r) part[(32 * i + crow(r, hi)) * 64 + 32 * j + r32] = acc[2 * i + j][r];
    __syncthreads();
    float rq[6];
#pragma unroll
    for (int i = 0; i < 6; ++i) rq[i] = rowsq0[row0 + (tid + 512 * i) / 48];
#pragma unroll
    for (int i = 0; i < 6; ++i) { const int e = tid + 512 * i, row = e / 48, col = e % 48;
        const LAS float* p = (const LAS float*)L + row * 64 + col;
        const float v = ((p[0] + p[4096]) + (p[2 * 4096] + p[3 * 4096])) + ((p[4 * 4096] + p[5 * 4096]) + (p[6 * 4096] + p[7 * 4096]));
        gates[(size_t)(row0 + row) * 48 + col] = sigmoidf_(v / sqrtf(rq[i] * (1.f / 4096.f) + EPS)); }
    __syncthreads();
}
}
__device__ __forceinline__ float wave_sum(float v) {
#pragma unroll
    for (int o = 1; o < 64; o <<= 1) v += __shfl_xor(v, o);
    return v;
}
__device__ __forceinline__ float wave_max(float v) {
#pragma unroll
    for (int o = 1; o < 64; o <<= 1) v = fmaxf(v, __shfl_xor(v, o));
    return v;
}
__device__ __forceinline__ void p0_transpose_item(const float* W, int N, int nvalid, bf16* WT, size_t ldt, int k0, int n0, int drow0, LAS float* scr, int lane, const float* kgain = nullptr, float fp8scale = 0.f) {
    const int rr = lane >> 3, c4 = lane & 7, nn = n0 + 4 * c4; const bool ok = nn < nvalid;
    const GAS f32x4* src = (const GAS f32x4*)(W + (size_t)(k0 + rr) * N + nn);
    f32x4 v[16];
#pragma unroll
    for (int i = 0; i < 16; ++i) v[i] = ok ? __builtin_nontemporal_load(src + (size_t)i * 2 * N) : (f32x4){0.f, 0.f, 0.f, 0.f};
    const int c = lane & 7;
#pragma unroll
    for (int h = 0; h < 2; ++h) {
#pragma unroll
        for (int i = 0; i < 8; ++i) { LAS float* d = scr + (8 * i + rr) * 33 + 4 * c4; const float gk = kgain ? kgain[k0 + 64 * h + 8 * i + rr] : 1.f; d[0] = v[8 * h + i].x * gk; d[1] = v[8 * h + i].y * gk; d[2] = v[8 * h + i].z * gk; d[3] = v[8 * h + i].w * gk; }
        LDS_WAIT(); asm volatile("" ::: "memory");
#pragma unroll
        for (int j = 0; j < 4; ++j) { const int n = (lane >> 3) + 8 * j; const LAS float* s = scr + (8 * c) * 33 + n;
            if (fp8scale != 0.f) {
                int w0 = __builtin_amdgcn_cvt_pk_fp8_f32(s[0 * 33] * fp8scale, s[1 * 33] * fp8scale, 0, false); w0 = __builtin_amdgcn_cvt_pk_fp8_f32(s[2 * 33] * fp8scale, s[3 * 33] * fp8scale, w0, true);
                int w1 = __builtin_amdgcn_cvt_pk_fp8_f32(s[4 * 33] * fp8scale, s[5 * 33] * fp8scale, 0, false); w1 = __builtin_amdgcn_cvt_pk_fp8_f32(s[6 * 33] * fp8scale, s[7 * 33] * fp8scale, w1, true);
                *(GAS v2u*)((GAS unsigned char*)WT + (size_t)(drow0 + n) * ldt + k0 + 64 * h + 8 * c) = (v2u){(unsigned)w0, (unsigned)w1};
            } else {
            v4u o; o.x = pk2(s[0 * 33], s[1 * 33]); o.y = pk2(s[2 * 33], s[3 * 33]); o.z = pk2(s[4 * 33], s[5 * 33]); o.w = pk2(s[6 * 33], s[7 * 33]);
            *(GAS v4u*)(WT + (size_t)(drow0 + n) * ldt + k0 + 64 * h + 8 * c) = o; } }
        LDS_WAIT(); asm volatile("" ::: "memory");
    }
}
__device__ __forceinline__ void row_load(f32x4 (&v)[16], const float* xrow, int lane) {
    const GAS f32x4* xr = (const GAS f32x4*)xrow + lane;
#pragma unroll
    for (int j = 0; j < 16; ++j) v[j] = __builtin_nontemporal_load(xr + 64 * j);
}
__device__ __forceinline__ void row_finish(const f32x4 (&v)[16], bf16* orow, float* sumsq, int lane) {
    float s = 0.f;
#pragma unroll
    for (int j = 0; j < 16; ++j) s += (v[j].x * v[j].x + v[j].y * v[j].y) + (v[j].z * v[j].z + v[j].w * v[j].w);
    s = wave_sum(s);
    if (lane == 0) *sumsq = s;
    GAS v2u* o8 = (GAS v2u*)orow + lane;
#pragma unroll
    for (int j = 0; j < 16; ++j) { v2u w; w.x = pk2(v[j].x, v[j].y); w.y = pk2(v[j].z, v[j].w); o8[64 * j] = w; }
}
__device__ __forceinline__ void rms_row_inplace(float* xrow, const float* g, int lane) {
    GAS f32x4* xr = (GAS f32x4*)xrow + lane; const GAS f32x4* gr = (const GAS f32x4*)g + lane;
    f32x4 v[16]; float s = 0.f;
#pragma unroll
    for (int j = 0; j < 16; ++j) { v[j] = xr[64 * j]; s += (v[j].x * v[j].x + v[j].y * v[j].y) + (v[j].z * v[j].z + v[j].w * v[j].w); }
    const float rs = 1.f / sqrtf(wave_sum(s) * (1.f / 4096.f) + EPS);
#pragma unroll
    for (int j = 0; j < 16; ++j) { const f32x4 gg = gr[64 * j]; xr[64 * j] = v[j] * rs * gg; }
}

struct Args { const float* in[17]; float* out; unsigned char* ws; float inv[16]; int ph_lo, ph_hi, li, pad; };
constexpr int N_PHASES = 10;
__global__ void __launch_bounds__(NWAVES * 64, 2) mega(Args args) {
    extern __shared__ __attribute__((aligned(16))) unsigned char lds[];
    LAS unsigned char* L = (LAS unsigned char*)lds;
    volatile LAS unsigned* MISC = (volatile LAS unsigned*)(L + MISC_OFF);
    const int tid = threadIdx.x, lane = tid & 63, wave = __builtin_amdgcn_readfirstlane(tid >> 6);
    const int G = gridDim.x;
    unsigned char* ws = args.ws;
    gu32* ctl = (gu32*)(ws + WS_CTL);
    const float* x = args.in[0]; const float* norm_attn = args.in[1]; const float* w_in = args.in[2];
    const float* w_out = args.in[11]; const float* norm_ffn = args.in[12]; const float* w_gate = args.in[13]; const float* w_up = args.in[14]; const float* w_down = args.in[15];
    const float* norm_final = args.in[16];
    float* out = args.out;
    bf16* Win_t = (bf16*)(ws + WS_WIN); bf16* Wout_t = (bf16*)(ws + WS_WOUT); bf16* Wgu_t = (bf16*)(ws + WS_WGU); bf16* Wdn_t = (bf16*)(ws + WS_WDN);
    bf16* bufA = (bf16*)(ws + WS_BUFA); bf16* proj = (bf16*)(ws + WS_PROJ); bf16* mixed = proj; bf16* act = proj;
    float* cs = (float*)(ws + WS_CS);
    const float* ck_pe = args.in[3]; const float* ck_w1 = args.in[4]; const float* ck_w2 = args.in[5];
    const float* cv_pe = args.in[6]; const float* cv_w1 = args.in[7]; const float* cv_w2 = args.in[8];
    const float* out_norm_a = args.in[9]; const float* out_norm_b = args.in[10];
    bf16* kcb = (bf16*)(ws + WS_KCB); bf16* vcb = (bf16*)(ws + WS_KCB + 1 * MiB);
    bf16* ckW1T = (bf16*)(ws + WS_W1T); bf16* cvW1T = (bf16*)(ws + WS_W1T + 1 * MiB);
    float* bias1 = (float*)(ws + WS_BIAS1); float* lse = (float*)(ws + WS_LSE);
    bf16* partA = (bf16*)out;
    bf16* partC = (bf16*)out + (size_t)3 * T * 2048;
    bf16* partS = (bf16*)(ws + WS_PART); bf16* partW = partS + (size_t)T * 2048;
    unsigned char* x1f8 = ws + WS_PART;
    float* rowsq = (float*)(ws + WS_ROWSQ);
    float* gates = (float*)(ws + WS_GATES);
    for (int u = tid; u < (LDS_BYTES - LDSCTL_OFF) / 4; u += NWAVES * 64) ((LAS unsigned*)(L + LDSCTL_OFF))[u] = 0u;
    __syncthreads();
    const int lo = args.ph_lo, hi = args.ph_hi;
    const bool one_launch = (hi - lo) > 1;
    XcdBarrier bar; bar.bar = (unsigned*)(ctl + CW_BAR) + args.li * XCD_BAR_WORDS; bar.x = 0; bar.st = nullptr;
    if (one_launch) bar = xcd_barrier_post((unsigned*)(ctl + CW_BAR) + args.li * XCD_BAR_WORDS, MISC + 8);
#ifndef MK_PH
#define MK_PH 0x3ff
#endif
#define IN(k) ((((MK_PH) >> (k)) & 1) && lo <= (k) && (k) < hi)
#ifdef MK_TPROBE
    unsigned long long ts_a = 0, ts_b = 0, sec_acc = 0; int ts_n = 0;
#define TS() do { unsigned long long t_; asm volatile("s_memrealtime %0\n\ts_waitcnt lgkmcnt(0)" : "=s"(t_) :: "memory"); if (ts_n == MK_TPROBE) ts_a = t_; if (ts_n == MK_TPROBE_END) ts_b = t_; ++ts_n; } while (0)
#else
#define TS() do { } while (0)
#endif
    TS();
#define BOTH(k) (IN(k) && IN((k) + 1))
    const int gw = blockIdx.x * NWAVES + wave, NGW = G * NWAVES;

    if (IN(0)) {
        LAS float* scr = (LAS float*)(L + RING_OFF + wave * 16384);
        constexpr int I_IN = 32 * 360, I_OUT = 32 * 128, I_G = 32 * 344, I_D = 86 * 128, I_W1 = 32 * 4;
        constexpr int NITEMS = I_IN + I_OUT + 2 * I_G + I_D + 2 * I_W1;
        for (int it = gw; it < NITEMS; it += NGW) {
            int r = it;
            if (r < I_IN) { const int kb = r / 360, nb = r % 360; p0_transpose_item(w_in, D_IN, D_IN, Win_t, 4096, 128 * kb, 32 * nb, 32 * nb, scr, lane, norm_attn); continue; } r -= I_IN;
            if (r < I_OUT) { const int kb = r / 128, nb = r % 128; p0_transpose_item(w_out, 4096, 4096, Wout_t, 4096, 128 * kb, 32 * nb, 32 * nb, scr, lane); continue; } r -= I_OUT;
            if (r < I_G) { const int kb = r / 344, nb = r % 344, n0 = 32 * nb; p0_transpose_item(w_gate, D_FF, D_FF, Wgu_t, 4096, 128 * kb, n0, 256 * (n0 >> 7) + (n0 & 127), scr, lane, norm_ffn, WGU_SCALE); continue; } r -= I_G;
            if (r < I_G) { const int kb = r / 344, nb = r % 344, n0 = 32 * nb; p0_transpose_item(w_up, D_FF, D_FF, Wgu_t, 4096, 128 * kb, n0, 256 * (n0 >> 7) + 128 + (n0 & 127), scr, lane, norm_ffn, WGU_SCALE); continue; } r -= I_G;
            if (r < I_D) { const int kb = r / 128, nb = r % 128; p0_transpose_item(w_down, 4096, 4096, Wdn_t, D_FF, 128 * kb, 32 * nb, 32 * nb, scr, lane, nullptr, WDN_SCALE); continue; } r -= I_D;
            if (r < I_W1) { const int kb = r / 4, nb = r % 4; p0_transpose_item(ck_w1, 128, 128, ckW1T, 4096, 128 * kb, 32 * nb, 32 * nb, scr, lane); continue; } r -= I_W1;
            { const int kb = r / 4, nb = r % 4; p0_transpose_item(cv_w1, 128, 128, cvW1T, 4096, 128 * kb, 32 * nb, 32 * nb, scr, lane); }
        }
#ifdef MK_P0SPLIT
        TS();
#endif
        for (int o = gw; o < 2048; o += NGW) {
            const int oo = o & 255, sl = o >> 8, which = oo >> 7, j = oo & 127; const float* pe = which ? cv_pe : ck_pe; const float* w1 = which ? cv_w1 : ck_w1;
            float a = 0.f;
#pragma unroll
            for (int q = 0; q < 8; ++q) { const int i = sl * 512 + q * 64 + lane; a += pe[i] * w1[(size_t)i * 128 + j]; }
            a = wave_sum(a);
            if (lane == 0) bias1[o] = a;
        }
        for (int idx = blockIdx.x * (NWAVES * 64) + tid; idx < SEQ * 16; idx += G * NWAVES * 64) {
            const int s = idx >> 4, i = idx & 15; const float ang = (float)s * args.inv[i]; const double a = (double)ang;
            cs[2 * idx] = (float)cos(a); cs[2 * idx + 1] = (float)sin(a);
        }
        {
            f32x4 va[16], vb[16];
            row_load(va, x + (size_t)gw * D_MODEL, lane);
#pragma unroll 1
            for (int m = gw; m < T; m += 2 * NGW) {
                row_load(vb, x + (size_t)(m + NGW) * D_MODEL, lane);
                row_finish(va, bufA + (size_t)m * D_MODEL, rowsq + 2 * T + m, lane);
                if (m + 2 * NGW < T) row_load(va, x + (size_t)(m + 2 * NGW) * D_MODEL, lane);
                row_finish(vb, bufA + (size_t)(m + NGW) * D_MODEL, rowsq + 2 * T + m + NGW, lane);
            }
        }
        for (int i = blockIdx.x * (NWAVES * 64) + tid; i < 2 * T; i += G * NWAVES * 64) rowsq[i] = 0.f;
        if (BOTH(0)) xcd_barrier(bar);
        TS();
    }
    if (IN(1)) {
        pg8::Gemm g{bufA, Win_t, T, OFF_GL, D_MODEL}; pg8::StaticOrder S; S.init(T, OFF_GL, G, (int)blockIdx.x, P1_WGM);
        pg8::EpiProj E{proj, LDP, cs, rowsq + 2 * T, 1.f / 4096.f, EPS};
        pg8::gemm_phase<pg8::EpiProj, pg8::StaticOrder, true, true>(L + RING_OFF, g, S, E);
        if (BOTH(1)) xcd_barrier(bar);
        TS();
    }
    if (IN(2)) {
        for (int cu = blockIdx.x; cu < 256; cu += G) { const int which = cu >> 7, r = cu & 127;
            att::compress_unit(L, proj, which ? OFF_VC : OFF_KC, which ? cvW1T : ckW1T, bias1 + which * 128, which ? cv_w2 : ck_w2, which ? vcb : kcb, r >> 5, (r >> 3) & 3, r & 7, tid, lane, wave); }
        TS();
        for (int u = blockIdx.x; u < T / 64; u += G) att::gate_unit(L, bufA, Win_t + (size_t)OFF_GL * D_MODEL, rowsq + 2 * T, gates, 64 * u, tid, lane, wave);
        TS();
        {
            constexpr int NSTAT = MK_DYN ? 12 : 16;
            int u = blockIdx.x, k = 0; unsigned nx = 0;
            while (u < 4096) {
                if (NSTAT < 16 && k >= NSTAT - 1 && tid == 0) nx = (unsigned)(NSTAT * 256) + __hip_atomic_fetch_add((unsigned*)ctl + CW_Q2, 1u, RLX_AGENT);
                if (u < 1024) att::window_unit(L, proj, partW, u, tid, lane, wave SECARG);
                else att::dilated_unit(L, proj, partA, lse, u - 1024, tid, lane, wave SECARG);
                if (++k < NSTAT) u += 256;
                else if (NSTAT == 16) u = 4096;
                else { if (tid == 0) MISC[10] = nx; __syncthreads(); u = __builtin_amdgcn_readfirstlane((int)MISC[10]); }
            }
        }
        TS();
        TS();
        if (BOTH(2)) xcd_barrier(bar);
        TS();
    }
    if (IN(3)) {
        {
            unsigned nx = 0;
            constexpr int NR3 = MK_DYN ? 2 : 4;
            for (int rd = 0; rd < NR3; ++rd) {
                const int idx = (rd & 1) ? rd * 256 + (255 - (int)blockIdx.x) : rd * 256 + (int)blockIdx.x;
                if (NR3 < 4 && rd == NR3 - 1 && tid == 0) nx = (unsigned)(NR3 * 256) + __hip_atomic_fetch_add((unsigned*)ctl + CW_Q3, 1u, RLX_AGENT);
                const int qb = 63 - (idx >> 4), bg = idx & 15;
                att::nsa_unit(L, proj, kcb, vcb, partC, partS, bg >> 2, bg & 3, qb, tid, lane, wave SECARG);
            }
            if (tid == 0) MISC[10] = nx;
            __syncthreads();
            int idx = NR3 < 4 ? __builtin_amdgcn_readfirstlane((int)MISC[10]) : 1024;
            while (idx < 1024) {
                if (tid == 0) nx = (unsigned)(NR3 * 256) + __hip_atomic_fetch_add((unsigned*)ctl + CW_Q3, 1u, RLX_AGENT);
                const int qb = 63 - (idx >> 4), bg = idx & 15;
                att::nsa_unit(L, proj, kcb, vcb, partC, partS, bg >> 2, bg & 3, qb, tid, lane, wave SECARG);
                if (tid == 0) MISC[10] = nx;
                __syncthreads();
                idx = __builtin_amdgcn_readfirstlane((int)MISC[10]);
            }
        }
        TS();
        if (BOTH(3)) xcd_barrier(bar);
        TS();
    }
    if (IN(4)) {
        {
            const int grp = gw & 1, MS = NGW >> 1;
            const float* gn = grp ? out_norm_b : out_norm_a;
            const bf16* s0 = grp ? partC : partA; const bf16* s1 = grp ? partS : partA + (size_t)T * 2048; const bf16* s2 = grp ? partW : partA + (size_t)2 * T * 2048;
#define P4_LOAD(D, SC, m_) do { _Pragma("unroll") for (int k = 0; k < 4; ++k) { const int ch = lane + 64 * k, head = ch >> 4; const size_t off = (size_t)(m_) * 2048 + 8 * ch; \
                D[0][k] = *(const v4u*)(s0 + off); D[1][k] = *(const v4u*)(s1 + off); D[2][k] = *(const v4u*)(s2 + off); \
                if (grp == 0) { SC[0][k] = lse[((size_t)0 * T + (m_)) * 16 + head]; SC[1][k] = lse[((size_t)1 * T + (m_)) * 16 + head]; SC[2][k] = lse[((size_t)2 * T + (m_)) * 16 + head]; } \
                else { SC[0][k] = gates[(size_t)(m_) * 48 + head * 3]; SC[1][k] = gates[(size_t)(m_) * 48 + head * 3 + 1]; SC[2][k] = gates[(size_t)(m_) * 48 + head * 3 + 2]; } } } while (0)
#define P4_FINISH(D, SC, m_) do { float ov[32]; float ss = 0.f; \
            _Pragma("unroll") for (int k = 0; k < 4; ++k) { float w0 = SC[0][k], w1 = SC[1][k], w2 = SC[2][k]; \
                if (grp == 0) { const float mx = fmaxf(w0, fmaxf(w1, w2)); const float e0 = __expf(w0 - mx), e1 = __expf(w1 - mx), e2 = __expf(w2 - mx); const float inv = 1.f / (e0 + e1 + e2); w0 = e0 * inv; w1 = e1 * inv; w2 = e2 * inv; } \
                _Pragma("unroll") for (int e = 0; e < 4; ++e) { \
                    const float alo = w0 * __uint_as_float(D[0][k][e] << 16) + w1 * __uint_as_float(D[1][k][e] << 16) + w2 * __uint_as_float(D[2][k][e] << 16); \
                    const float ahi = w0 * __uint_as_float(D[0][k][e] & 0xffff0000u) + w1 * __uint_as_float(D[1][k][e] & 0xffff0000u) + w2 * __uint_as_float(D[2][k][e] & 0xffff0000u); \
                    ov[8 * k + 2 * e] = alo; ov[8 * k + 2 * e + 1] = ahi; ss += alo * alo + ahi * ahi; } } \
            const float rs = 1.f / sqrtf(wave_sum(ss) * (1.f / 2048.f) + EPS); \
            f32x4 gn0 = *(const f32x4*)(gn + 8 * lane), gn1 = *(const f32x4*)(gn + 8 * lane + 4);     \
            _Pragma("unroll") for (int k = 0; k < 4; ++k) { const int ch = lane + 64 * k; const f32x4 g0 = gn0, g1 = gn1; if (k < 3) { gn0 = *(const f32x4*)(gn + 8 * (ch + 64)); gn1 = *(const f32x4*)(gn + 8 * (ch + 64) + 4); } v4u w; \
                w.x = pk2(ov[8 * k + 0] * rs * g0.x, ov[8 * k + 1] * rs * g0.y); w.y = pk2(ov[8 * k + 2] * rs * g0.z, ov[8 * k + 3] * rs * g0.w); \
                w.z = pk2(ov[8 * k + 4] * rs * g1.x, ov[8 * k + 5] * rs * g1.y); w.w = pk2(ov[8 * k + 6] * rs * g1.z, ov[8 * k + 7] * rs * g1.w); \
                *(v4u*)(mixed + (size_t)(m_) * D_MODEL + grp * 2048 + 8 * ch) = w; } } while (0)
            v4u da[3][4], db[3][4]; float sa[3][4], sb[3][4];
            P4_LOAD(da, sa, gw >> 1);
#pragma unroll 1
            for (int m = gw >> 1; m < T; m += 2 * MS) {
                P4_LOAD(db, sb, m + MS);
                P4_FINISH(da, sa, m);
                if (m + 2 * MS < T) P4_LOAD(da, sa, m + 2 * MS);
                P4_FINISH(db, sb, m + MS);
            }
#undef P4_LOAD
#undef P4_FINISH
        }
        if (BOTH(4)) xcd_barrier(bar);
        TS();
    }

    if (IN(5)) {
        pg8::Gemm g{mixed, Wout_t, T, D_MODEL, D_MODEL}; pg8::StaticOrder S; S.init(T, D_MODEL, G, (int)blockIdx.x, P5_WGM);
        pg8::EpiResid<true> E{bufA, bufA, rowsq, x1f8, D_MODEL, 1.f};
        pg8::gemm_phase<pg8::EpiResid<true>, pg8::StaticOrder, true, true>(L + RING_OFF, g, S, E);
        if (IN(7)) xcd_barrier(bar);
        TS();
    }
    if (IN(7)) {
        pg8::Gemm g{(const bf16*)x1f8, Wgu_t, T, NGU, D_MODEL / 2}; pg8::StaticOrder S; S.init(T, NGU, G, (int)blockIdx.x, P7_WGM);
        pg8::EpiSwiglu<true> E{act, D_FF, rowsq, 1.f / 4096.f, EPS, 1.f / WGU_SCALE};
        pg8::gemm_phase<pg8::EpiSwiglu<true>, pg8::StaticOrder, true, true, true>(L + RING_OFF, g, S, E);
        if (BOTH(7)) xcd_barrier(bar);
        TS();
    }
    if (IN(8)) {
        pg8::Gemm g{act, Wdn_t, T, D_MODEL, D_FF / 2}; pg8::StaticOrder S; S.init(T, D_MODEL, G, (int)blockIdx.x, P8_WGM);
        pg8::EpiResid<true> E{bufA, bufA, rowsq + T, nullptr, D_MODEL, 1.f / WDN_SCALE};
        pg8::gemm_phase<pg8::EpiResid<true>, pg8::StaticOrder, true, P8_SP2, true>(L + RING_OFF, g, S, E);
        if (BOTH(8)) xcd_barrier(bar);
        TS();
    }
    if (IN(9)) {
        const GAS f32x4* gr = (const GAS f32x4*)norm_final + lane;
        f32x4 gg[16];
#pragma unroll
        for (int j = 0; j < 16; ++j) gg[j] = gr[64 * j];
#define P9_LOAD(V, RS, m_) do { const GAS v2u* xr_ = (const GAS v2u*)(bufA + (size_t)(m_) * D_MODEL) + lane; RS = rowsq[T + (m_)]; _Pragma("unroll") for (int j = 0; j < 16; ++j) V[j] = xr_[64 * j]; } while (0)
#define P9_FINISH(V, RS, m_) do { const float rs_ = 1.f / sqrtf(RS * (1.f / 4096.f) + EPS); GAS f32x4* orow_ = (GAS f32x4*)(out + (size_t)(m_) * D_MODEL) + lane; \
            _Pragma("unroll") for (int j = 0; j < 16; ++j) orow_[64 * j] = (f32x4){__uint_as_float(V[j].x << 16) * rs_ * gg[j].x, __uint_as_float(V[j].x & 0xffff0000u) * rs_ * gg[j].y, \
                                                                                  __uint_as_float(V[j].y << 16) * rs_ * gg[j].z, __uint_as_float(V[j].y & 0xffff0000u) * rs_ * gg[j].w}; } while (0)
        v2u va[16], vb[16]; float ra, rb;
        P9_LOAD(va, ra, gw);
#pragma unroll 1
        for (int m = gw; m < T; m += 2 * NGW) {
            P9_LOAD(vb, rb, m + NGW);
            P9_FINISH(va, ra, m);
            if (m + 2 * NGW < T) P9_LOAD(va, ra, m + 2 * NGW);
            P9_FINISH(vb, rb, m + NGW);
        }
#undef P9_LOAD
#undef P9_FINISH
    }
    TS();
#ifdef MK_TPROBE
    if (blockIdx.x == MK_TBLOCK) {
        unsigned long long d = 4ull * (MK_TSEC >= 0 ? sec_acc : (ts_b - ts_a)); if (d > 2000000ull) d = 2000000ull;
        unsigned long long t0_; asm volatile("s_memrealtime %0\n\ts_waitcnt lgkmcnt(0)" : "=s"(t0_) :: "memory");
        for (;;) { unsigned long long t1_; asm volatile("s_memrealtime %0\n\ts_waitcnt lgkmcnt(0)" : "=s"(t1_) :: "memory"); if (t1_ - t0_ >= d) break; __builtin_amdgcn_s_sleep(8); }
    }
#endif
#undef IN
#undef BOTH
}

extern "C" void kernel_launch(void* const* d_in, const int* in_sizes, int n_in, void* d_out, int out_size, void* d_ws, size_t ws_size, hipStream_t stream) {
    static int grid = 0;
    if (grid == 0) {
        if (n_in != 17 || out_size != T * D_MODEL || ws_size < WS_END) { fprintf(stderr, "kernel_launch: unexpected shapes (n_in %d out %d ws %zu); nothing launched\n", n_in, out_size, ws_size); grid = -1; return; }
        int dev = 0, cus = 0, per_cu = 0;
        if (hipGetDevice(&dev) != hipSuccess || hipDeviceGetAttribute(&cus, hipDeviceAttributeMultiprocessorCount, dev) != hipSuccess) { grid = -1; return; }
        if (hipFuncSetAttribute((const void*)mega, hipFuncAttributeMaxDynamicSharedMemorySize, LDS_BYTES) != hipSuccess) { fprintf(stderr, "kernel_launch: hipFuncSetAttribute failed\n"); grid = -1; return; }
        if (hipOccupancyMaxActiveBlocksPerMultiprocessor(&per_cu, (const void*)mega, NWAVES * 64, LDS_BYTES) != hipSuccess || per_cu < 1)
            fprintf(stderr, "kernel_launch: note: occupancy query reports %d workgroups per CU\n", per_cu);
        (void)hipGetLastError();
        grid = cus;
    }
    if (grid < 0) return;
    if (hipMemsetAsync((char*)d_ws + WS_CTL, 0, CTL_ZERO_BYTES, stream) != hipSuccess) return;
    Args a{};
    for (int i = 0; i < 17; ++i) a.in[i] = (const float*)d_in[i];
    a.out = (float*)d_out; a.ws = (unsigned char*)d_ws;
    for (int i = 0; i < 16; ++i) a.inv[i] = (float)pow(500000.0, -(double)(2 * i) / 32.0);
    unsigned char* ws = (unsigned char*)d_ws;
    int n_launch = 0;
    auto launch = [&](int lo, int hi) { a.ph_lo = lo; a.ph_hi = hi; a.li = n_launch++; hipLaunchKernelGGL(mega, dim3(grid), dim3(NWAVES * 64), LDS_BYTES, stream, a); };
#if MK_BUILD == 2
    for (int ph = 0; ph < N_PHASES; ++ph) launch(ph, ph + 1);
#elif MK_BUILD == 3
    launch(0, N_PHASES);
#else
#if MK_PROBE == 0
    launch(0, N_PHASES); launch(0, 1);
#elif MK_PROBE == 7
    launch(0, N_PHASES); launch(7, 8);
#else
    launch(0, MK_PROBE + 1); launch(MK_PROBE, MK_PROBE + 1); launch(MK_PROBE + 1, N_PHASES);
#endif
#endif
    const hipError_t le = hipPeekAtLastError();
    if (le != hipSuccess) fprintf(stderr, "kernel_launch: launch failed: %s\n", hipGetErrorName(le));
}
```
